# Optimizing an MI355X kernel written in HIP

```python
import math
import jax, jax.numpy as jnp
from jax import lax
import numpy as np

D_MODEL = 1024
BATCH = 16
SEQ = 4096
DEPTH = 2

GRID_W = 64
CTX_LEN = 256
EPS = 1e-6

MLA_WIDTH = D_MODEL // 2
POOL_WIDTH = D_MODEL // 4
HY_WIDTH = D_MODEL // 4

MLA_HEADS = 8
MLA_V = MLA_WIDTH // MLA_HEADS
MLA_NOPE = 64
MLA_ROPE = 32
MLA_Q_RANK = D_MODEL // 4
MLA_KV_RANK = D_MODEL // 8
MLA_SCALE = (MLA_NOPE + MLA_ROPE) ** -0.5
ROPE_BASE = 10000.0
Q_BLOCK = 128

POOL_WINDOWS = (2, 4, 8, 16)
POOL_GROUP = POOL_WIDTH // len(POOL_WINDOWS)

HY_ORDER = 2
HY_EMB = 33
HY_FFN = 64
HY_DECAY_TARGET = 1e-2
HY_DECAY_SHORT_PCT = 0.3
HY_DECAY_LONG_PCT = 1.5

D_FF = 4 * D_MODEL

COL_KV = 0
COL_KR = COL_KV + MLA_KV_RANK
COL_Q = COL_KR + MLA_ROPE
COL_POOL = COL_Q + MLA_Q_RANK
COL_HY = COL_POOL + POOL_WIDTH
N_IN = COL_HY + (HY_ORDER + 1) * HY_WIDTH

kernel_name = "hybrid_mla_pool_hyena_dit_prefix"


def rmsnorm(x, g):
    x32 = x.astype(jnp.float32)
    y = x32 * lax.rsqrt(jnp.mean(x32 * x32, axis=-1, keepdims=True) + EPS)
    return (y * g.astype(jnp.float32)).astype(x.dtype)


def modulate(x, g, shift, scale):
    return rmsnorm(x, g) * (1 + scale) + shift


def adaln(cond, w, b):
    return jnp.split(jax.nn.silu(cond) @ w + b, 6, axis=-1)


def axial_rope_tables(n_tokens, dtype):
    n_rows = n_tokens // GRID_W
    r, cidx = jnp.meshgrid(jnp.arange(n_rows), jnp.arange(GRID_W), indexing="ij")
    r = r.reshape(-1).astype(jnp.float32)
    cidx = cidx.reshape(-1).astype(jnp.float32)
    n_freq = MLA_ROPE // 4
    inv = ROPE_BASE ** (-jnp.arange(n_freq, dtype=jnp.float32) / n_freq)
    ang = jnp.stack([r[:, None] * inv, cidx[:, None] * inv], axis=1)
    return jnp.cos(ang).astype(dtype), jnp.sin(ang).astype(dtype)


def apply_rope(x, cos, sin):
    xr = x.reshape(x.shape[:-1] + (2, 2, MLA_ROPE // 4))
    x1 = xr[..., 0, :]
    x2 = xr[..., 1, :]
    out = jnp.stack([x1 * cos - x2 * sin, x2 * cos + x1 * sin], axis=-2)
    return out.reshape(x.shape)


def mla_kv(p_kv, g_kv, w_kv_up):
    kv = rmsnorm(p_kv, g_kv) @ w_kv_up
    kv = kv.reshape(kv.shape[:-1] + (MLA_HEADS, MLA_NOPE + MLA_V))
    return kv[..., :MLA_NOPE], kv[..., MLA_NOPE:]


def mla_q(p_q, g_q, w_q_up):
    q = rmsnorm(p_q, g_q) @ w_q_up
    q = q.reshape(q.shape[:-1] + (MLA_HEADS, MLA_NOPE + MLA_ROPE))
    return q[..., :MLA_NOPE], q[..., MLA_NOPE:]


def attend(qn, qr, kn, kr, v):
    s = jnp.einsum("bqhd,bkhd->bhqk", qn, kn) + jnp.einsum("bqhr,bkr->bhqk", qr, kr)
    p = jax.nn.softmax(s.astype(jnp.float32) * MLA_SCALE, axis=-1).astype(v.dtype)
    return jnp.einsum("bhqk,bkhd->bqhd", p, v)


def blocked_attend(qn, qr, kn, kr, v):
    b, n = qn.shape[:2]
    nb = n // Q_BLOCK

    def split(t):
        return t.reshape((b, nb, Q_BLOCK) + t.shape[2:]).swapaxes(0, 1)

    out = lax.map(lambda qs: attend(qs[0], qs[1], kn, kr, v), (split(qn), split(qr)))
    return out.swapaxes(0, 1).reshape(b, n, MLA_HEADS * MLA_V)


def pool_mixer(u, pool_w, pool_scale):
    n = u.shape[1]
    t = jnp.arange(n)
    cs = jnp.pad(jnp.cumsum(u.astype(jnp.float32), axis=1), ((0, 0), (1, 0), (0, 0)))
    outs = []
    for g, w in enumerate(POOL_WINDOWS):
        lo = jnp.clip(t - w // 2, 0, n)
        hi = jnp.clip(t + w // 2, 0, n)
        sl = slice(g * POOL_GROUP, (g + 1) * POOL_GROUP)
        csg = cs[..., sl]
        mean = (csg[:, hi] - csg[:, lo]) / (hi - lo).astype(jnp.float32)[:, None]
        outs.append((mean.astype(u.dtype) - u[..., sl]) @ pool_w[g])
    return jnp.concatenate(outs, axis=-1) * pool_scale


def short_conv(u, w, b):
    n = u.shape[1]
    up = jnp.pad(u, ((0, 0), (1, 1), (0, 0)))
    return up[:, :n] * w[0] + up[:, 1:n + 1] * w[1] + up[:, 2:] * w[2] + b


def hyena_filter_spectra(n, p):
    f32 = jnp.float32
    t = jnp.linspace(0.0, 1.0, n, dtype=f32)[:, None]
    bands = (HY_EMB - 1) // 2
    freqs = jnp.linspace(1e-4, bands - 1, bands, dtype=f32)[None, :]
    wpos = 2.0 * math.pi * jnp.arange(n, dtype=f32)[:, None] / n
    z = jnp.concatenate([t, jnp.cos(freqs * wpos), -jnp.sin(freqs * wpos)], axis=-1)
    h = jnp.sin(p["hy_f_freq1"].astype(f32) * (z @ p["hy_f_w1"].astype(f32) + p["hy_f_b1"].astype(f32)))
    h = jnp.sin(p["hy_f_freq2"].astype(f32) * (h @ p["hy_f_w2"].astype(f32) + p["hy_f_b2"].astype(f32)))
    h = (h @ p["hy_f_w3"].astype(f32)).reshape(n, HY_ORDER, 2, HY_WIDTH)
    deltas = jnp.abs(jnp.linspace(math.log(HY_DECAY_TARGET) / HY_DECAY_LONG_PCT,
                                  math.log(HY_DECAY_TARGET) / HY_DECAY_SHORT_PCT, HY_WIDTH, dtype=f32))
    h = h * jnp.exp(-t[:, :, None] * deltas)[:, :, None, :]
    fwd = h[:, :, 0]
    bwd = h[1:, :, 1][::-1]
    circ = jnp.concatenate([fwd, jnp.zeros((1, HY_ORDER, HY_WIDTH), f32), bwd], axis=0)
    circ = circ / jnp.sum(jnp.abs(circ), axis=0, keepdims=True)
    return jnp.fft.rfft(circ, axis=0)


def fftconv(u, spec, bias):
    n = u.shape[1]
    u32 = u.astype(jnp.float32)
    y = jnp.fft.irfft(jnp.fft.rfft(u32, n=2 * n, axis=1) * spec, n=2 * n, axis=1)[:, :n]
    return (y + u32 * bias.astype(jnp.float32)).astype(u.dtype)


def hyena_mixer(u, p):
    uc = short_conv(u, p["hy_conv_w"], p["hy_conv_b"])
    v, x1, x2 = jnp.split(uc, 3, axis=-1)
    spec = hyena_filter_spectra(u.shape[1], p)
    z = x1 * fftconv(v, spec[:, 0], p["hy_bias"][0])
    return x2 * fftconv(z, spec[:, 1], p["hy_bias"][1])


def merge_groups(proj, attn, p):
    pool = pool_mixer(proj[..., COL_POOL:COL_HY], p["pool_w"], p["pool_scale"])
    hy = hyena_mixer(proj[..., COL_HY:], p)
    g = p["g_out"]
    parts = [rmsnorm(attn, g[:MLA_WIDTH]),
             rmsnorm(pool, g[MLA_WIDTH:MLA_WIDTH + POOL_WIDTH]),
             rmsnorm(hy, g[MLA_WIDTH + POOL_WIDTH:])]
    return jnp.concatenate(parts, axis=-1) @ p["w_out"]


def sq_relu_mlp(h, w1, w2):
    return jnp.square(jax.nn.relu(h @ w1)) @ w2


def hybrid_layer(x, xc, c, c_ctx, p, last):
    sh1, sc1, g1, sh2, sc2, g2 = [m[:, None, :] for m in adaln(c, p["w_mod"], p["b_mod"])]
    csh1, csc1, cg1, csh2, csc2, cg2 = adaln(c_ctx, p["w_mod"], p["b_mod"])
    h = modulate(x, p["g_mix"], sh1, sc1)
    hc = modulate(xc, p["g_mix"], csh1, csc1)
    proj = h @ p["w_in"]
    proj_c = hc @ (p["w_in"][:, :COL_Q] if last else p["w_in"])
    cos, sin = axial_rope_tables(x.shape[1], x.dtype)
    kn_c, v_c = mla_kv(proj_c[..., COL_KV:COL_KR], p["g_kv"], p["w_kv_up"])
    kr_c = proj_c[..., COL_KR:COL_Q]
    kn_l, v_l = mla_kv(proj[..., COL_KV:COL_KR], p["g_kv"], p["w_kv_up"])
    kr_l = apply_rope(proj[..., COL_KR:COL_Q], cos, sin)
    qn, qr = mla_q(proj[..., COL_Q:COL_POOL], p["g_q"], p["w_q_up"])
    qr = apply_rope(qr, cos[:, None], sin[:, None])
    attn = blocked_attend(qn, qr,
                          jnp.concatenate([kn_c, kn_l], axis=1),
                          jnp.concatenate([kr_c, kr_l], axis=1),
                          jnp.concatenate([v_c, v_l], axis=1))
    x = x + g1 * merge_groups(proj, attn, p)
    x = x + g2 * sq_relu_mlp(modulate(x, p["g_mlp"], sh2, sc2), p["w_mlp1"], p["w_mlp2"])
    if last:
        return x, xc
    qn_c, qr_c = mla_q(proj_c[..., COL_Q:COL_POOL], p["g_q"], p["w_q_up"])
    attn_c = attend(qn_c, qr_c, kn_c, kr_c, v_c).reshape(xc.shape[0], xc.shape[1], MLA_WIDTH)
    xc = xc + cg1 * merge_groups(proj_c, attn_c, p)
    xc = xc + cg2 * sq_relu_mlp(modulate(xc, p["g_mlp"], csh2, csc2), p["w_mlp1"], p["w_mlp2"])
    return x, xc


def setup_inputs(seed: int = 0) -> dict:
    key = jax.random.key(seed)
    ks = iter(jax.random.split(key, 40))

    def nrm(shape, scale=1.0):
        return jax.random.normal(next(ks), shape, jnp.float32) * scale

    def gain(shape):
        return 1.0 + nrm(shape, 0.05)

    L = DEPTH
    return {
        "x": nrm((BATCH, SEQ, D_MODEL)),
        "c": nrm((BATCH, D_MODEL)),
        "ctx": nrm((BATCH, CTX_LEN, D_MODEL)),
        "c_ctx": nrm((D_MODEL,)),
        "w_mod": nrm((L, D_MODEL, 6 * D_MODEL), 0.5 * D_MODEL ** -0.5),
        "b_mod": nrm((L, 6 * D_MODEL), 0.02),
        "g_mix": gain((L, D_MODEL)),
        "g_mlp": gain((L, D_MODEL)),
        "w_in": nrm((L, D_MODEL, N_IN), D_MODEL ** -0.5),
        "g_q": gain((L, MLA_Q_RANK)),
        "w_q_up": nrm((L, MLA_Q_RANK, MLA_HEADS * (MLA_NOPE + MLA_ROPE)), MLA_Q_RANK ** -0.5),
        "g_kv": gain((L, MLA_KV_RANK)),
        "w_kv_up": nrm((L, MLA_KV_RANK, MLA_HEADS * (MLA_NOPE + MLA_V)), MLA_KV_RANK ** -0.5),
        "pool_w": nrm((L, len(POOL_WINDOWS), POOL_GROUP, POOL_GROUP), POOL_GROUP ** -0.5),
        "pool_scale": 1.0 + nrm((L, POOL_WIDTH), 0.1),
        "hy_conv_w": nrm((L, 3, (HY_ORDER + 1) * HY_WIDTH), 3 ** -0.5),
        "hy_conv_b": nrm((L, (HY_ORDER + 1) * HY_WIDTH), 0.02),
        "hy_f_w1": nrm((L, HY_EMB, HY_FFN), HY_EMB ** -0.5),
        "hy_f_b1": nrm((L, HY_FFN), 0.02),
        "hy_f_freq1": 1.0 + nrm((L, HY_FFN), 0.05),
        "hy_f_w2": nrm((L, HY_FFN, HY_FFN), HY_FFN ** -0.5),
        "hy_f_b2": nrm((L, HY_FFN), 0.02),
        "hy_f_freq2": 1.0 + nrm((L, HY_FFN), 0.05),
        "hy_f_w3": nrm((L, HY_FFN, HY_ORDER * 2 * HY_WIDTH), HY_FFN ** -0.5),
        "hy_bias": nrm((L, HY_ORDER, HY_WIDTH), 0.5),
        "g_out": gain((L, D_MODEL)),
        "w_out": nrm((L, D_MODEL, D_MODEL), D_MODEL ** -0.5),
        "w_mlp1": nrm((L, D_MODEL, D_FF), D_MODEL ** -0.5),
        "w_mlp2": nrm((L, D_FF, D_MODEL), D_FF ** -0.5),
        "g_final": gain((D_MODEL,)),
    }


def reference(x, c, ctx, c_ctx, w_mod, b_mod, g_mix, g_mlp, w_in, g_q, w_q_up, g_kv, w_kv_up,
              pool_w, pool_scale, hy_conv_w, hy_conv_b, hy_f_w1, hy_f_b1, hy_f_freq1, hy_f_w2,
              hy_f_b2, hy_f_freq2, hy_f_w3, hy_bias, g_out, w_out, w_mlp1, w_mlp2, g_final):
    xc = ctx
    for l in range(DEPTH):
        p = {
            "w_mod": w_mod[l], "b_mod": b_mod[l], "g_mix": g_mix[l], "g_mlp": g_mlp[l],
            "w_in": w_in[l], "g_q": g_q[l], "w_q_up": w_q_up[l], "g_kv": g_kv[l],
            "w_kv_up": w_kv_up[l], "pool_w": pool_w[l], "pool_scale": pool_scale[l],
            "hy_conv_w": hy_conv_w[l], "hy_conv_b": hy_conv_b[l], "hy_f_w1": hy_f_w1[l],
            "hy_f_b1": hy_f_b1[l], "hy_f_freq1": hy_f_freq1[l], "hy_f_w2": hy_f_w2[l],
            "hy_f_b2": hy_f_b2[l], "hy_f_freq2": hy_f_freq2[l], "hy_f_w3": hy_f_w3[l],
            "hy_bias": hy_bias[l], "g_out": g_out[l], "w_out": w_out[l],
            "w_mlp1": w_mlp1[l], "w_mlp2": w_mlp2[l],
        }
        x, xc = hybrid_layer(x, xc, c, c_ctx, p, last=(l == DEPTH - 1))
    return rmsnorm(x, g_final)
```

```cpp
#include <hip/hip_runtime.h>
#include <hip/hip_cooperative_groups.h>
#include <cstdio>
#include <cstdint>
namespace cg = cooperative_groups;

#define DI __device__ __forceinline__
#define LAS __attribute__((address_space(3)))
typedef unsigned short bf16_t;
typedef short bf16x8 __attribute__((ext_vector_type(8)));
typedef short s16x4 __attribute__((ext_vector_type(4)));
typedef float f32x4 __attribute__((ext_vector_type(4)));
typedef float f32x2 __attribute__((ext_vector_type(2)));
typedef float f32x16 __attribute__((ext_vector_type(16)));
typedef unsigned u32x4 __attribute__((ext_vector_type(4)));
typedef unsigned u32x2 __attribute__((ext_vector_type(2)));
typedef __bf16 bf16x2_t __attribute__((ext_vector_type(2)));

DI unsigned pk2(float lo, float hi) { f32x2 v = {lo, hi}; bf16x2_t b = __builtin_convertvector(v, bf16x2_t); return __builtin_bit_cast(unsigned, b); }
DI float bflo(unsigned w) { return __uint_as_float(w << 16); }
DI float bfhi(unsigned w) { return __uint_as_float(w & 0xffff0000u); }
DI float bf2f(bf16_t v) { return __uint_as_float(((unsigned)v) << 16); }
DI bf16_t f2bf(float f) { return (bf16_t)(pk2(f, 0.f) & 0xffffu); }
DI float xshfl(float v, int o, int lane) { return __int_as_float(__builtin_amdgcn_ds_bpermute((lane ^ o) << 2, __float_as_int(v))); }
DI float wave_sum(float v, int lane) {
#pragma unroll
    for (int o = 1; o < 64; o <<= 1) v += xshfl(v, o, lane);
    return v;
}
#define LDS_WAIT() asm volatile("s_waitcnt lgkmcnt(0)" ::: "memory")

constexpr int NB = 16, SEQ = 4096, CTXL = 256, DM = 1024, RL = NB * SEQ, RC = NB * CTXL, RT = RL + RC, NKEY = SEQ + CTXL;
constexpr int NIN = 1440, NINP = 1536, DFF = 4096;
constexpr int COL_KR = 128, COL_Q = 160, COL_POOL = 416, COL_HY = 672;
constexpr float EPS = 1e-6f;
constexpr float QSCALE = 0.10206207261596575f * 1.4426950408889634f;

constexpr size_t al256(size_t x) { return (x + 255) & ~(size_t)255; }
constexpr size_t SZ_WIN = (size_t)NINP * 1024 * 2, SZ_WQ = 768 * 256 * 2, SZ_WKN = 512 * 256 * 2, SZ_WV = 512 * 256 * 2, SZ_WPOOL = 256 * 256 * 2,
                 SZ_WOUT = 1024 * 1024 * 2, SZ_WM1 = (size_t)4096 * 1024 * 2, SZ_WM2 = (size_t)4096 * 1024 * 2;
constexpr size_t WO_IN = 0, WO_Q = WO_IN + SZ_WIN, WO_KN = WO_Q + SZ_WQ, WO_V = WO_KN + SZ_WKN, WO_POOL = WO_V + SZ_WV, WO_OUT = WO_POOL + SZ_WPOOL,
                 WO_M1 = WO_OUT + SZ_WOUT, WO_M2 = WO_M1 + SZ_WM1, SZ_WLAYER = WO_M2 + SZ_WM2;
constexpr size_t OFF_W = 0;
constexpr size_t OFF_MOD = al256(OFF_W + 2 * SZ_WLAYER);
constexpr size_t OFF_ROPE = al256(OFF_MOD + (size_t)2 * 17 * 6144 * 4);
constexpr size_t OFF_HL = al256(OFF_ROPE + 64 * 8 * 8);
constexpr size_t OFF_HC = al256(OFF_HL + (size_t)2 * 1024 * 4096 * 4);
constexpr size_t OFF_XC = al256(OFF_HC + (size_t)1024 * 256 * 4);
constexpr size_t OFF_XR = al256(OFF_XC + (size_t)RC * 1024 * 4);
constexpr size_t OFF_HBUF = OFF_XR;
constexpr size_t OFF_BIG = al256(OFF_HBUF + (size_t)RT * 1024 * 2);
constexpr size_t SZ_PROJ = (size_t)RT * NIN * 2, SZ_NQ = (size_t)RT * 384 * 2, SZ_R256 = (size_t)RT * 256 * 2;
constexpr size_t SZ_K = (size_t)NB * 8 * NKEY * 96 * 2, SZ_VT = (size_t)NB * 8 * 64 * NKEY * 2, SZ_XT = (size_t)256 * NB * NKEY * 2;
constexpr size_t SZ_QL = (size_t)NB * 8 * SEQ * 96 * 2, SZ_QC = (size_t)NB * 8 * CTXL * 96 * 2, SZ_ATT = (size_t)RT * 512 * 2;
constexpr size_t OFF_PROJ = OFF_BIG;
constexpr size_t OFF_QL = OFF_PROJ, OFF_QC = OFF_QL + SZ_QL, OFF_ATT = OFF_QC + SZ_QC;
static_assert(SZ_QL + SZ_QC + SZ_ATT <= SZ_PROJ, "overlay 1");
constexpr size_t OFF_NQ = al256(OFF_PROJ + SZ_PROJ);
constexpr size_t OFF_POOLA = OFF_NQ + SZ_NQ;
constexpr size_t OFF_ZT = OFF_NQ, OFF_HYT = OFF_ZT + SZ_XT;
static_assert(2 * SZ_XT <= SZ_NQ + SZ_R256, "overlay 2");
constexpr size_t OFF_K = al256(OFF_POOLA + SZ_R256);
constexpr size_t OFF_VT = al256(OFF_K + SZ_K);
constexpr size_t OFF_POOLO = al256(OFF_VT + SZ_VT);
constexpr size_t OFF_VXT = al256(OFF_POOLO + SZ_R256);
constexpr size_t OFF_BIG_END = al256(OFF_VXT + 3 * SZ_XT);
constexpr size_t OFF_ACT = OFF_BIG;
constexpr size_t SZ_ACT = (size_t)RT * DFF * 2;
static_assert(OFF_ACT + SZ_ACT <= OFF_BIG_END, "act overlay");
constexpr size_t OFF_HBUF2 = OFF_BIG_END;
constexpr size_t OFF_SS = al256(OFF_HBUF2 + (size_t)RT * 1024 * 2);
constexpr size_t OFF_SHW = al256(OFF_SS + (size_t)4 * RT * 4);
constexpr size_t OFF_BAR = al256(OFF_SHW + (size_t)2 * 2 * 17 * 4096 * 4);
constexpr size_t OFF_PART = al256(OFF_BAR + 3456 * 4);
constexpr size_t WS_END = al256(OFF_PART + (size_t)4 * RC * 1024 * 4);
static_assert(WS_END <= ((size_t)1 << 30), "workspace");

constexpr int LDS_BYTES = 131072 + 16;

struct Params {
    const float *x, *c, *ctx, *c_ctx, *w_mod, *b_mod, *g_mix, *g_mlp, *w_in, *g_q, *w_q_up, *g_kv, *w_kv_up, *pool_w, *pool_scale, *hy_conv_w, *hy_conv_b,
        *hy_f_w1, *hy_f_b1, *hy_f_freq1, *hy_f_w2, *hy_f_b2, *hy_f_freq2, *hy_f_w3, *hy_bias, *g_out, *w_out, *w_mlp1, *w_mlp2, *g_final;
    float* out; unsigned char* ws;
};

namespace pg8 {
#define PG8_LAS __attribute__((address_space(3)))
constexpr int BM = 256, BK = 64, HALF = 128, HTB = HALF * BK * 2, STAGE_BYTES = 8 * HTB, NXCD = 8, WGM = 8;
DI int lds_byte(int r, int c) { const int st = (r >> 4) * 2 + (c >> 5), rr = r & 15, cc = c & 31, ob = rr * 64 + cc * 2; return st * 1024 + (ob ^ (((ob >> 9) & 1) << 5)); }
DI void stage_rc(int b, int& R, int& C) { const int st = b / 1024, sb = b % 1024, swz = sb ^ (((sb >> 9) & 1) << 5); R = (st >> 1) * 16 + swz / 64; C = (st & 1) * 32 + (swz % 64) / 2; }
DI int perm32(int rho) { const int n = rho >> 4, i = rho & 15; return 8 * (i >> 2) + 4 * n + (i & 3); }
struct Unit { int pm, pn; };
struct Gemm { const bf16_t* A; const bf16_t* Bt; int M, N, K, lda, ldb; int mt; size_t kso; };
DI void unit_ptrs(const Gemm& g, const Unit& u, size_t tstepA, size_t tstepB, const char*& a, const char*& b) {
    int pm = u.pm; size_t ko = 0;
    if (g.mt) { const int ks = pm / g.mt; pm -= ks * g.mt; ko = (size_t)ks * g.kso; }
    a = (const char*)g.A + (size_t)pm * tstepA + ko; b = (const char*)g.Bt + (size_t)u.pn * tstepB + ko;
}
struct StaticOrder {
    int nM, nN, nwg, G, c;
    DI void init(int M, int N, int G_, int c_) { nM = M / BM; nN = N / BM; nwg = nM * nN; G = G_; c = c_; }
    DI bool next(int i, Unit& u) const {
        const long L = (long)i * G + c; if (L >= nwg) return false;
        int wgid = (int)L; { const int q = nwg / NXCD, r = nwg % NXCD, xcd = wgid % NXCD, off = wgid / NXCD; wgid = (xcd < r ? xcd * (q + 1) : r * (q + 1) + (xcd - r) * q) + off; }
        const int nig = WGM * nN, gid = wgid / nig, fm = gid * WGM, gsz = (nM - fm) < WGM ? (nM - fm) : WGM;
        u.pm = fm + ((wgid % nig) % gsz); u.pn = (wgid % nig) / gsz; return true;
    }
};
template <class Epi>
DI void gemm_phase(PG8_LAS unsigned char* lds, const int tid, const Gemm g, const StaticOrder& S, const Epi& E) {
    const int wid = __builtin_amdgcn_readfirstlane(tid >> 6), lane = tid & 63, wr = wid >> 2, wc = wid & 3, fr = lane & 15, fq = lane >> 4;
    const int K = g.K, nt = K / BK;
    unsigned voffA[2], voffB[2];
#pragma unroll
    for (int i = 0; i < 2; ++i) { int R, C; stage_rc(tid * 16 + i * 8192, R, C); const int Rb = Epi::PERM ? ((R & ~31) + perm32(R & 31)) : R;
        voffA[i] = (unsigned)(R * g.lda + C) * 2u; voffB[i] = (unsigned)(Rb * g.ldb + C) * 2u; }
    const size_t kstep = (size_t)(BK * 2);
    const size_t hstepA = (size_t)HALF * g.lda * 2, hstepB = (size_t)HALF * g.ldb * 2;
    const size_t tstepA = 2 * hstepA, tstepB = 2 * hstepB;
    const unsigned ldsw = (unsigned)wid * 1024u;
    const int aoff = lds_byte(wr * 64 + fr, fq * 8), boff = lds_byte(wc * 32 + fr, fq * 8);
#define PG8_SA(b, h) (((b) * 2 + (h)) * HTB)
#define PG8_SB(b, h) ((4 + (b) * 2 + (h)) * HTB)
#define PG8_STAGE(bufoff, gbase, voff) do { _Pragma("unroll") for (int _i = 0; _i < 2; ++_i) \
        __builtin_amdgcn_global_load_lds((const unsigned*)((const char*)(gbase) + (voff)[_i]), (PG8_LAS unsigned*)(lds + (bufoff) + ldsw + _i * 8192), 16, 0, 0); } while (0)
#define PG8_LDA(dst, b, h) do { _Pragma("unroll") for (int m = 0; m < 4; ++m) _Pragma("unroll") for (int k = 0; k < 2; ++k) dst[m][k] = *(const PG8_LAS bf16x8*)(lds + PG8_SA(b, h) + aoff + m * 2048 + k * 1024); } while (0)
#define PG8_LDB(dst, b, h) do { _Pragma("unroll") for (int n = 0; n < 2; ++n) _Pragma("unroll") for (int k = 0; k < 2; ++k) dst[n][k] = *(const PG8_LAS bf16x8*)(lds + PG8_SB(b, h) + boff + n * 2048 + k * 1024); } while (0)
#define PG8_MMA(ai, bj, At, Bt) do { __builtin_amdgcn_s_setprio(1); _Pragma("unroll") for (int m = 0; m < 4; ++m) _Pragma("unroll") for (int n = 0; n < 2; ++n) _Pragma("unroll") for (int k = 0; k < 2; ++k) \
        acc[ai][bj][m][n] = __builtin_amdgcn_mfma_f32_16x16x32_bf16(Bt[n][k], At[m][k], acc[ai][bj][m][n], 0, 0, 0); __builtin_amdgcn_s_setprio(0); } while (0)
#define PG8_WAIT_V(n) asm volatile("s_waitcnt vmcnt(" #n ")" ::: "memory")
#define PG8_WAIT_L(n) asm volatile("s_waitcnt lgkmcnt(" #n ")" ::: "memory")
#define PG8_BAR __builtin_amdgcn_s_barrier()
#define PG8_SCHED __builtin_amdgcn_sched_barrier(0)
    Unit cur, nxt; int ui = 0;
    if (!S.next(0, cur)) return;
    f32x4 acc[2][2][4][2];
#pragma unroll
    for (int a = 0; a < 2; ++a)
#pragma unroll
        for (int b = 0; b < 2; ++b)
#pragma unroll
            for (int m = 0; m < 4; ++m)
#pragma unroll
                for (int n = 0; n < 2; ++n) acc[a][b][m][n] = (f32x4){0.f, 0.f, 0.f, 0.f};
    bf16x8 At[4][2], B0[2][2], B1[2][2];
    const char* cA; const char* cB; unit_ptrs(g, cur, tstepA, tstepB, cA, cB);
    PG8_STAGE(PG8_SB(0, 0), cB, voffB); PG8_STAGE(PG8_SA(0, 0), cA, voffA); PG8_STAGE(PG8_SB(0, 1), cB + hstepB, voffB); PG8_STAGE(PG8_SA(0, 1), cA + hstepA, voffA);
    if (wr == 1) PG8_BAR;
    PG8_WAIT_V(4); PG8_BAR;
    PG8_STAGE(PG8_SB(1, 0), cB + kstep, voffB); PG8_STAGE(PG8_SA(1, 0), cA + kstep, voffA); PG8_STAGE(PG8_SB(1, 1), cB + hstepB + kstep, voffB);
    PG8_WAIT_V(6); PG8_BAR;
    for (;;) {
        const bool has_next = S.next(ui + 1, nxt);
        const char* nA = cA; const char* nB = cB; if (has_next) unit_ptrs(g, nxt, tstepA, tstepB, nA, nB);
        for (int t = 0; t < nt; t += 2) {
            const bool last = (t == nt - 2);
            const char* a1 = cA + (size_t)(t + 1) * kstep;
            const char* a2 = last ? nA : cA + (size_t)(t + 2) * kstep; const char* b2 = last ? nB : cB + (size_t)(t + 2) * kstep;
            const char* a3 = a2 + kstep; const char* b3 = b2 + kstep;
            PG8_LDB(B0, 0, 0); PG8_SCHED; PG8_LDA(At, 0, 0); PG8_STAGE(PG8_SA(1, 1), a1 + hstepA, voffA);
            PG8_WAIT_L(8); PG8_BAR; PG8_WAIT_L(0); PG8_MMA(0, 0, At, B0); PG8_BAR; PG8_SCHED;
            PG8_LDB(B1, 0, 1); PG8_STAGE(PG8_SB(0, 0), b2, voffB);
            PG8_BAR; PG8_WAIT_L(0); PG8_MMA(0, 1, At, B1); PG8_BAR;
            PG8_LDA(At, 0, 1); PG8_STAGE(PG8_SA(0, 0), a2, voffA);
            PG8_BAR; PG8_WAIT_L(0); PG8_MMA(1, 0, At, B0); PG8_BAR; PG8_SCHED;
            PG8_STAGE(PG8_SB(0, 1), b2 + hstepB, voffB);
            PG8_WAIT_V(6); PG8_BAR; PG8_MMA(1, 1, At, B1); PG8_BAR;
            PG8_LDB(B0, 1, 0); PG8_SCHED; PG8_LDA(At, 1, 0); PG8_STAGE(PG8_SA(0, 1), a2 + hstepA, voffA);
            PG8_WAIT_L(8); PG8_BAR; PG8_WAIT_L(0); PG8_MMA(0, 0, At, B0); PG8_BAR; PG8_SCHED;
            PG8_LDB(B1, 1, 1); PG8_STAGE(PG8_SB(1, 0), b3, voffB);
            PG8_BAR; PG8_WAIT_L(0); PG8_MMA(0, 1, At, B1); PG8_BAR;
            PG8_LDA(At, 1, 1); PG8_STAGE(PG8_SA(1, 0), a3, voffA);
            PG8_BAR; PG8_WAIT_L(0); PG8_MMA(1, 0, At, B0); PG8_BAR; PG8_SCHED;
            PG8_STAGE(PG8_SB(1, 1), b3 + hstepB, voffB);
            PG8_WAIT_V(6); PG8_BAR; PG8_MMA(1, 1, At, B1); PG8_BAR;
        }
        E(acc, cur, wr, wc, fr, fq);
        if (!has_next) break;
#pragma unroll
        for (int a = 0; a < 2; ++a)
#pragma unroll
            for (int b = 0; b < 2; ++b)
#pragma unroll
                for (int m = 0; m < 4; ++m)
#pragma unroll
                    for (int n = 0; n < 2; ++n) acc[a][b][m][n] = (f32x4){0.f, 0.f, 0.f, 0.f};
        cur = nxt; cA = nA; cB = nB; ++ui;
    }
    PG8_WAIT_V(0);
    if (wr == 0) PG8_BAR;
    PG8_BAR;
#undef PG8_SA
#undef PG8_SB
#undef PG8_STAGE
#undef PG8_LDA
#undef PG8_LDB
#undef PG8_MMA
#undef PG8_WAIT_V
#undef PG8_WAIT_L
#undef PG8_BAR
#undef PG8_SCHED
}
}
using pg8::Unit;
typedef const f32x4 (&AccRef)[2][2][4][2];

template <int ACT> struct EpiBf16 {
    static constexpr bool PERM = true;
    bf16_t* O; int ldc, ncols;
    DI void operator()(AccRef acc, const Unit& u, int wr, int wc, int fr_, int fq_) const {
        int fr = fr_, fq = fq_; asm volatile("" : "+v"(fr), "+v"(fq));
        const int row0 = u.pm * 256 + wr * 64 + fr, col0 = u.pn * 256 + wc * 32 + 8 * fq;
#pragma unroll
        for (int ai = 0; ai < 2; ++ai)
#pragma unroll
            for (int m = 0; m < 4; ++m) { bf16_t* rowp = O + (size_t)(row0 + ai * 128 + m * 16) * ldc + col0;
#pragma unroll
                for (int bj = 0; bj < 2; ++bj) { f32x4 v0 = acc[ai][bj][m][0], v1 = acc[ai][bj][m][1];
                    if (ACT == 1) {
#pragma unroll
                        for (int j = 0; j < 4; ++j) { const float a = fmaxf(v0[j], 0.f), b = fmaxf(v1[j], 0.f); v0[j] = a * a; v1[j] = b * b; } }
                    u32x4 w; w.x = pk2(v0[0], v0[1]); w.y = pk2(v0[2], v0[3]); w.z = pk2(v1[0], v1[1]); w.w = pk2(v1[2], v1[3]);
                    if (col0 + bj * 128 < ncols) *(u32x4*)(rowp + bj * 128) = w; } }
    }
};
template <bool FUSE> struct EpiResid {
    static constexpr bool PERM = false;
    const float* srcL; float* dstL; const float* srcC; float* dstC; const float* gate;
    bf16_t* A2; float* ss; const float* gain; const float* scl;
    DI void operator()(AccRef acc, const Unit& u, int wr, int wc, int fr_, int fq_) const {
        int fr = fr_, fq = fq_; asm volatile("" : "+v"(fr), "+v"(fq));
        const int row0 = u.pm * 256 + wr * 64 + fr, col0 = u.pn * 256 + wc * 32 + 4 * fq, ln = fq * 16 + fr;
        const bool isctx = (u.pm * 256) >= RL;
        const int mrt = isctx ? 16 : ((u.pm * 256) >> 12);
        const float* sbase = isctx ? srcC - (size_t)RL * 1024 : srcL; float* dbase = isctx ? dstC - (size_t)RL * 1024 : dstL;
        const float* gp = gate + (size_t)mrt * 6144;
        f32x4 gv[2][2], gs[2][2];
#pragma unroll
        for (int bj = 0; bj < 2; ++bj)
#pragma unroll
            for (int n = 0; n < 2; ++n) { const int c = col0 + bj * 128 + n * 16; gv[bj][n] = *(const f32x4*)(gp + c);
                if (FUSE) gs[bj][n] = *(const f32x4*)(gain + c) * (*(const f32x4*)(scl + (size_t)mrt * 6144 + c) + 1.0f); }
#pragma unroll
        for (int ai = 0; ai < 2; ++ai)
#pragma unroll
          for (int mp = 0; mp < 2; ++mp) {
            f32x4 xv[2][2][2];
#pragma unroll
            for (int mm = 0; mm < 2; ++mm)
#pragma unroll
                for (int bj = 0; bj < 2; ++bj)
#pragma unroll
                    for (int n = 0; n < 2; ++n) xv[mm][bj][n] = *(const f32x4*)(sbase + (size_t)(row0 + ai * 128 + (2 * mp + mm) * 16) * 1024 + col0 + bj * 128 + n * 16);
#pragma unroll
            for (int mm = 0; mm < 2; ++mm) { const int m = 2 * mp + mm; const int r = row0 + ai * 128 + m * 16;
                float part = 0.f;
#pragma unroll
                for (int bj = 0; bj < 2; ++bj)
#pragma unroll
                    for (int n = 0; n < 2; ++n) { const int c = col0 + bj * 128 + n * 16;
                        const f32x4 xn = xv[mm][bj][n] + gv[bj][n] * acc[ai][bj][m][n];
                        *(f32x4*)(dbase + (size_t)r * 1024 + c) = xn;
                        if (FUSE) { const f32x4 an = xn * gs[bj][n]; u32x2 w; w.x = pk2(an[0], an[1]); w.y = pk2(an[2], an[3]); *(u32x2*)(A2 + (size_t)r * 1024 + c) = w;
                            part += (xn[0] * xn[0] + xn[1] * xn[1]) + (xn[2] * xn[2] + xn[3] * xn[3]); } }
                if (FUSE) { part += xshfl(part, 16, ln); part += xshfl(part, 32, ln);
                    if (fq == 0) (void)__hip_atomic_fetch_add((__attribute__((address_space(1))) float*)(ss + r), part, __ATOMIC_RELAXED, __HIP_MEMORY_SCOPE_AGENT); } }
          }
    }
};
template <bool SRC_F32, bool FUSE> struct EpiResid2 {
    static constexpr bool PERM = true;
    const float* srcL; const float* srcC; bf16_t* xr; const float* gate;
    bf16_t* A2; float* ss; const float* gain; const float* scl;
    DI void operator()(AccRef acc, const Unit& u, int wr, int wc, int fr_, int fq_) const {
        int fr = fr_, fq = fq_; asm volatile("" : "+v"(fr), "+v"(fq));
        typedef __attribute__((address_space(1))) float gfloat; typedef __attribute__((address_space(1))) unsigned short gbf16;
        typedef __attribute__((address_space(1))) f32x4 gf32x4; typedef __attribute__((address_space(1))) u32x4 gu32x4;
        const int row0 = u.pm * 256 + wr * 64 + fr, col0 = u.pn * 256 + wc * 32 + 8 * fq, ln = fq * 16 + fr;
        const bool isctx = (u.pm * 256) >= RL;
        const int mrt = isctx ? 16 : ((u.pm * 256) >> 12);
        const gfloat* __restrict__ sbase = (const gfloat*)(isctx ? srcC - (size_t)RL * 1024 : srcL);
        gbf16* __restrict__ xb = (gbf16*)xr; gbf16* __restrict__ a2 = (gbf16*)A2;
        const gfloat* __restrict__ gp = (const gfloat*)(gate + (size_t)mrt * 6144);
        f32x4 gv[2][2], gs[2][2];
#pragma unroll
        for (int bj = 0; bj < 2; ++bj)
#pragma unroll
            for (int hf = 0; hf < 2; ++hf) { const int c = col0 + bj * 128 + 4 * hf; gv[bj][hf] = *(const gf32x4*)(gp + c);
                if (FUSE) gs[bj][hf] = *(const gf32x4*)((const gfloat*)gain + c) * (*(const gf32x4*)((const gfloat*)scl + (size_t)mrt * 6144 + c) + 1.0f); }
#pragma unroll
        for (int ai = 0; ai < 2; ++ai) {
            constexpr int NB_ = SRC_F32 ? 2 : 1, RB_ = SRC_F32 ? 2 : 4;
#pragma unroll
          for (int mp = 0; mp < NB_; ++mp) {
            f32x4 xf[SRC_F32 ? 2 : 1][2][2]; u32x4 xw[SRC_F32 ? 1 : 4][2];
#pragma unroll
            for (int mm = 0; mm < RB_; ++mm)
#pragma unroll
                for (int bj = 0; bj < 2; ++bj) { const size_t off = (size_t)(row0 + ai * 128 + (RB_ * mp + mm) * 16) * 1024 + col0 + bj * 128;
                    if (SRC_F32) { xf[mm][bj][0] = *(const gf32x4*)(sbase + off); xf[mm][bj][1] = *(const gf32x4*)(sbase + off + 4); }
                    else xw[mm][bj] = *(const gu32x4*)(xb + off); }
#pragma unroll
            for (int mm = 0; mm < RB_; ++mm) { const int m = RB_ * mp + mm; const int r = row0 + ai * 128 + m * 16;
                float part = 0.f;
#pragma unroll
                for (int bj = 0; bj < 2; ++bj) { const size_t off = (size_t)r * 1024 + col0 + bj * 128;
                    f32x4 x0, x1;
                    if (SRC_F32) { x0 = xf[mm][bj][0]; x1 = xf[mm][bj][1]; }
                    else { const u32x4 w = xw[mm][bj]; x0 = (f32x4){bflo(w.x), bfhi(w.x), bflo(w.y), bfhi(w.y)}; x1 = (f32x4){bflo(w.z), bfhi(w.z), bflo(w.w), bfhi(w.w)}; }
                    const f32x4 n0 = x0 + gv[bj][0] * acc[ai][bj][m][0], n1 = x1 + gv[bj][1] * acc[ai][bj][m][1];
                    u32x4 o; o.x = pk2(n0[0], n0[1]); o.y = pk2(n0[2], n0[3]); o.z = pk2(n1[0], n1[1]); o.w = pk2(n1[2], n1[3]);
                    *(gu32x4*)(xb + off) = o;
                    if (FUSE) { const f32x4 a0 = n0 * gs[bj][0], a1 = n1 * gs[bj][1];
                        u32x4 w2; w2.x = pk2(a0[0], a0[1]); w2.y = pk2(a0[2], a0[3]); w2.z = pk2(a1[0], a1[1]); w2.w = pk2(a1[2], a1[3]);
                        *(gu32x4*)(a2 + off) = w2;
                        part += ((n0[0] * n0[0] + n0[1] * n0[1]) + (n0[2] * n0[2] + n0[3] * n0[3])) + ((n1[0] * n1[0] + n1[1] * n1[1]) + (n1[2] * n1[2] + n1[3] * n1[3])); } }
                if (FUSE) { part += xshfl(part, 16, ln); part += xshfl(part, 32, ln);
                    if (fq == 0) (void)__hip_atomic_fetch_add((__attribute__((address_space(1))) float*)(ss + r), part, __ATOMIC_RELAXED, __HIP_MEMORY_SCOPE_AGENT); } }
          }
        }
    }
};
template <int ACT> struct EpiNormBf16 {
    static constexpr bool PERM = true;
    bf16_t* O; int ldc, ncols; const float* ss; const float* shw;
    DI void operator()(AccRef acc, const Unit& u, int wr, int wc, int fr_, int fq_) const {
        int fr = fr_, fq = fq_; asm volatile("" : "+v"(fr), "+v"(fq));
        const int row0 = u.pm * 256 + wr * 64 + fr, col0 = u.pn * 256 + wc * 32 + 8 * fq;
        const int mrt = (u.pm * 256 < RL) ? ((u.pm * 256) >> 12) : 16;
        f32x4 sv[2][2];
#pragma unroll
        for (int bj = 0; bj < 2; ++bj) { sv[bj][0] = *(const f32x4*)(shw + (size_t)mrt * 4096 + col0 + bj * 128); sv[bj][1] = *(const f32x4*)(shw + (size_t)mrt * 4096 + col0 + bj * 128 + 4); }
#pragma unroll
        for (int ai = 0; ai < 2; ++ai)
#pragma unroll
            for (int m = 0; m < 4; ++m) { const int r = row0 + ai * 128 + m * 16; bf16_t* rowp = O + (size_t)r * ldc + col0;
                const float rs = rsqrtf(ss[r] * (1.f / 1024.f) + EPS);
#pragma unroll
                for (int bj = 0; bj < 2; ++bj) { f32x4 v0 = acc[ai][bj][m][0] * rs + sv[bj][0], v1 = acc[ai][bj][m][1] * rs + sv[bj][1];
                    if (ACT == 1) {
#pragma unroll
                        for (int jx = 0; jx < 4; ++jx) { const float a = fmaxf(v0[jx], 0.f), b = fmaxf(v1[jx], 0.f); v0[jx] = a * a; v1[jx] = b * b; } }
                    u32x4 w; w.x = pk2(v0[0], v0[1]); w.y = pk2(v0[2], v0[3]); w.z = pk2(v1[0], v1[1]); w.w = pk2(v1[2], v1[3]);
                    if (col0 + bj * 128 < ncols) *(u32x4*)(rowp + bj * 128) = w; } }
    }
};
struct EpiPartial {
    static constexpr bool PERM = false;
    float* part;
    DI void operator()(AccRef acc, const Unit& u, int wr, int wc, int fr_, int fq_) const {
        int fr = fr_, fq = fq_; asm volatile("" : "+v"(fr), "+v"(fq));
        const int ks = u.pm >> 4, pm = u.pm & 15;
        const int row0 = pm * 256 + wr * 64 + fr, col0 = u.pn * 256 + wc * 32 + 4 * fq;
        float* base = part + ((size_t)ks * RC + row0) * 1024 + col0;
#pragma unroll
        for (int ai = 0; ai < 2; ++ai)
#pragma unroll
            for (int m = 0; m < 4; ++m)
#pragma unroll
                for (int bj = 0; bj < 2; ++bj)
#pragma unroll
                    for (int n = 0; n < 2; ++n) *(f32x4*)(base + (size_t)(ai * 128 + m * 16) * 1024 + bj * 128 + n * 16) = acc[ai][bj][m][n];
    }
};
struct EpiQ {
    static constexpr bool PERM = false;
    bf16_t* QL; bf16_t* QC; const f32x2* rope;
    DI void operator()(AccRef acc, const Unit& u, int wr, int wc, int fr_, int fq_) const {
        int fr = fr_, fq = fq_; asm volatile("" : "+v"(fr), "+v"(fq));
        const int row0 = u.pm * 256 + wr * 64 + fr, colb = u.pn * 256 + wc * 32;
        const bool isctx = (u.pm * 256) >= RL;
#pragma unroll
        for (int ai = 0; ai < 2; ++ai)
#pragma unroll
            for (int m = 0; m < 4; ++m) { const int r = row0 + ai * 128 + m * 16;
                int b, t; bf16_t* qb;
                if (!isctx) { b = r >> 12; t = r & 4095; qb = QL + ((size_t)b * 8 * SEQ + t) * 96; }
                else { const int rc = r - RL; b = rc >> 8; t = rc & 255; qb = QC + ((size_t)b * 8 * CTXL + t) * 96; }
                const size_t hstride = (size_t)(isctx ? CTXL : SEQ) * 96;
#pragma unroll
                for (int bj = 0; bj < 2; ++bj)
#pragma unroll
                    for (int n = 0; n < 2; ++n) { const int cg0 = colb + bj * 128 + n * 16;
                        const int h = cg0 / 96, cc0 = cg0 - h * 96;
                        f32x4 v = acc[ai][bj][m][n];
                        const int ln = fq * 16 + fr; f32x4 pv; pv[0] = xshfl(v[0], 32, ln); pv[1] = xshfl(v[1], 32, ln); pv[2] = xshfl(v[2], 32, ln); pv[3] = xshfl(v[3], 32, ln);
                        if (cc0 >= 64 && !isctx) { const int axis = (cc0 - 64) >> 4, half = fq >> 1, f0 = 4 * (fq & 1); const int p = axis ? (t & 63) : (t >> 6);
#pragma unroll
                            for (int i = 0; i < 4; ++i) { const f32x2 cs = rope[p * 8 + f0 + i]; v[i] = half ? (v[i] * cs.x + pv[i] * cs.y) : (v[i] * cs.x - pv[i] * cs.y); } }
                        u32x2 w; w.x = pk2(v[0] * QSCALE, v[1] * QSCALE); w.y = pk2(v[2] * QSCALE, v[3] * QSCALE);
                        *(u32x2*)(qb + (size_t)h * hstride + cc0 + 4 * fq) = w; } }
    }
};
struct EpiKn {
    static constexpr bool PERM = true;
    bf16_t* Kb;
    DI void operator()(AccRef acc, const Unit& u, int wr, int wc, int fr_, int fq_) const {
        int fr = fr_, fq = fq_; asm volatile("" : "+v"(fr), "+v"(fq));
        const int row0 = u.pm * 256 + wr * 64 + fr, col0 = u.pn * 256 + wc * 32 + 8 * fq;
#pragma unroll
        for (int ai = 0; ai < 2; ++ai)
#pragma unroll
            for (int m = 0; m < 4; ++m) { const int r = row0 + ai * 128 + m * 16; int b, pos;
                if (r < RL) { b = r >> 12; pos = CTXL + (r & 4095); } else { const int rc = r - RL; b = rc >> 8; pos = rc & 255; }
#pragma unroll
                for (int bj = 0; bj < 2; ++bj) { const int c = col0 + bj * 128, h = c >> 6, j = c & 63;
                    const f32x4 v0 = acc[ai][bj][m][0], v1 = acc[ai][bj][m][1];
                    u32x4 w; w.x = pk2(v0[0], v0[1]); w.y = pk2(v0[2], v0[3]); w.z = pk2(v1[0], v1[1]); w.w = pk2(v1[2], v1[3]);
                    *(u32x4*)(Kb + ((size_t)(b * 8 + h) * NKEY + pos) * 96 + j) = w; } }
    }
};
struct EpiVT {
    static constexpr bool PERM = true;
    bf16_t* VT;
    DI void operator()(AccRef acc, const Unit& u, int wr, int wc, int fr_, int fq_) const {
        int fr = fr_, fq = fq_; asm volatile("" : "+v"(fr), "+v"(fq));
        const int row0 = u.pm * 256 + wr * 64 + fr, col0 = u.pn * 256 + wc * 32 + 8 * fq;
#pragma unroll
        for (int ai = 0; ai < 2; ++ai)
#pragma unroll
            for (int m = 0; m < 4; ++m) { const int f = row0 + ai * 128 + m * 16, h = f >> 6, dv = f & 63;
#pragma unroll
                for (int bj = 0; bj < 2; ++bj) { const int r = col0 + bj * 128; int b, pos;
                    if (r < RL) { b = r >> 12; pos = CTXL + (r & 4095); } else { const int rc = r - RL; b = rc >> 8; pos = rc & 255; }
                    const f32x4 v0 = acc[ai][bj][m][0], v1 = acc[ai][bj][m][1];
                    const int a = (pos >> 3) & 1; bf16_t* vp = VT + ((size_t)(b * 8 + h) * 64 + dv) * NKEY + (pos & ~15) + 4 * a;
                    u32x2 wl, wh; wl.x = pk2(v0[0], v0[1]); wl.y = pk2(v0[2], v0[3]); wh.x = pk2(v1[0], v1[1]); wh.y = pk2(v1[2], v1[3]);
                    *(u32x2*)vp = wl; *(u32x2*)(vp + 8) = wh; } }
    }
};

#define XB_TMO      128
#define XB_XCNT(j)  (256  + 64 * (j))
#define XB_XSUB(j)  (1280 + 64 * (j))
#define XB_XGEN(j)  (2304 + 64 * (j))
#define XB_TOP      3328
#define XB_TOPGEN   3392
#define XCD_BAR_WORDS 3456
#define XB_SPIN_CAP (1u << 22)
DI unsigned xb_ld(unsigned* p)              { return __hip_atomic_load(p, __ATOMIC_RELAXED, __HIP_MEMORY_SCOPE_AGENT); }
DI unsigned xb_add(unsigned* p, unsigned v) { return __hip_atomic_fetch_add(p, v, __ATOMIC_RELAXED, __HIP_MEMORY_SCOPE_AGENT); }
DI unsigned xb_xcc_id() { return (unsigned)__builtin_amdgcn_s_getreg((3 << 11) | 20) & 0xFu; }
#define XB_SPIN(cond, bar) do { unsigned _sp = 0; while (cond) { __builtin_amdgcn_s_sleep(1); \
    if ((++_sp & 255u) == 0u) { if (xb_ld(&(bar)[XB_TMO])) break; if (_sp > XB_SPIN_CAP) { atomicAdd(&(bar)[XB_TMO], 1u); break; } } } } while (0)
DI void xcd_barrier_post(unsigned* bar, bool t0) { if (t0) (void)xb_add(&bar[XB_XCNT(xb_xcc_id())], 1u); }
DI void xcd_barrier_complete(unsigned* bar, unsigned x, unsigned& nloc, unsigned& nx) {
    const unsigned G = gridDim.x;
    unsigned sum, cnt, mine, sp = 0u;
    for (;;) {
        sum = 0u; cnt = 0u; mine = 0u;
#pragma unroll
        for (unsigned j = 0; j < 16; ++j) { const unsigned c = xb_ld(&bar[XB_XCNT(j)]); sum += c; cnt += (c > 0u) ? 1u : 0u; mine = (j == x) ? c : mine; }
        if (sum == G) break;
        __builtin_amdgcn_s_sleep(1);
        if ((++sp & 255u) == 0u) { if (xb_ld(&bar[XB_TMO])) break; if (sp > XB_SPIN_CAP) { atomicAdd(&bar[XB_TMO], 1u); break; } }
    }
    nloc = mine > 0u ? mine : 1u; nx = cnt > 0u ? cnt : 1u;
}
DI void xcd_barrier(unsigned* bar, volatile LAS unsigned* st, bool t0) {
    asm volatile("s_waitcnt vmcnt(0)" ::: "memory");
    __syncthreads();
    if (t0) {
        const unsigned x = xb_xcc_id();
        __builtin_amdgcn_s_waitcnt(0);
        unsigned nloc = st[0], nx = st[1];
        if (nloc == 0u) { xcd_barrier_complete(bar, x, nloc, nx); st[0] = nloc; st[1] = nx; }
        const unsigned old = xb_add(&bar[XB_XSUB(x)], 1u);
        const unsigned gen = old / nloc;
        if (old + 1u == (gen + 1u) * nloc) {
            __builtin_amdgcn_fence(__ATOMIC_RELEASE, "agent");
            asm volatile("s_waitcnt vmcnt(0)" ::: "memory");
            const unsigned og = xb_add(&bar[XB_TOP], 1u);
            const unsigned tg = og / nx;
            if (og + 1u == (tg + 1u) * nx) xb_add(&bar[XB_TOPGEN], 1u);
            else XB_SPIN(xb_ld(&bar[XB_TOPGEN]) == tg, bar);
            __builtin_amdgcn_fence(__ATOMIC_ACQUIRE, "agent");
            xb_add(&bar[XB_XGEN(x)], 1u);
            asm volatile("s_waitcnt vmcnt(0)" ::: "memory");
        } else {
            XB_SPIN(xb_ld(&bar[XB_XGEN(x)]) == gen, bar);
            __builtin_amdgcn_fence(__ATOMIC_ACQUIRE, "agent");
            asm volatile("s_waitcnt vmcnt(0)" ::: "memory");
        }
    }
    __syncthreads();
}

struct Ctx {
    LAS unsigned char* lds; int tid, lane, wave, G, bid;
};

DI void transpose_item(const float* W, int ldw, int k0, int n0, bf16_t* WT, int ldt, int orow0, LAS float* scr, int lane) {
#pragma unroll 8
    for (int i = 0; i < 32; ++i) { const int kk = 2 * i + (lane >> 5); scr[kk * 33 + (lane & 31)] = W[(size_t)(k0 + kk) * ldw + n0 + (lane & 31)]; }
    LDS_WAIT();
    const int c = lane & 7;
#pragma unroll
    for (int j = 0; j < 4; ++j) { const int n = (lane >> 3) + 8 * j; const LAS float* s = scr + (8 * c) * 33 + n;
        u32x4 o; o.x = pk2(s[0 * 33], s[1 * 33]); o.y = pk2(s[2 * 33], s[3 * 33]); o.z = pk2(s[4 * 33], s[5 * 33]); o.w = pk2(s[6 * 33], s[7 * 33]);
        *(u32x4*)(WT + (size_t)(orow0 + n) * ldt + k0 + 8 * c) = o; }
    LDS_WAIT();
}

DI void setup_adaln(const Params& P, const Ctx& C, int u) {
    const int l = u / 96, j0 = (u % 96) * 64;
    LAS float* sl = (LAS float*)C.lds;
    LAS float* part = sl + 17 * 1024;
    for (int idx = C.tid; idx < 17 * 1024; idx += 512) { const int r = idx >> 10, k = idx & 1023; const float v = (r < 16) ? P.c[r * 1024 + k] : P.c_ctx[k]; sl[idx] = v / (1.f + expf(-v)); }
    __syncthreads();
    const int ks = C.tid >> 6, jj = C.tid & 63;
    float acc[17];
#pragma unroll
    for (int r = 0; r < 17; ++r) acc[r] = 0.f;
    const float* wp = P.w_mod + ((size_t)l * 1024 + ks * 128) * 6144 + j0 + jj;
    for (int k = 0; k < 128; ++k) { const float w = wp[(size_t)k * 6144];
#pragma unroll
        for (int r = 0; r < 17; ++r) acc[r] += sl[r * 1024 + ks * 128 + k] * w; }
#pragma unroll
    for (int r = 0; r < 17; ++r) part[(ks * 17 + r) * 64 + jj] = acc[r];
    __syncthreads();
    float* mod = (float*)(P.ws + OFF_MOD);
    for (int idx = C.tid; idx < 17 * 64; idx += 512) { const int r = idx >> 6, j2 = idx & 63; float s = 0.f;
#pragma unroll
        for (int q = 0; q < 8; ++q) s += part[(q * 17 + r) * 64 + j2];
        mod[((size_t)l * 17 + r) * 6144 + j0 + j2] = s + P.b_mod[l * 6144 + j0 + j2]; }
    __syncthreads();
}

DI void setup_filter(const Params& P, const Ctx& C, int l, int n, int d0, float* H) {
    LAS float* zs = (LAS float*)C.lds;
    LAS float* h1s = zs + 16 * 33;
    LAS float* h2s = h1s + 16 * 64;
    for (int idx = C.tid; idx < 16 * 33; idx += 512) { const int p = idx / 33, e = idx - p * 33; const int d = d0 + p; float v;
        if (e == 0) v = (float)d / (float)(n - 1);
        else { const int k = (e - 1) & 15; const float fr = 1e-4f + (float)k * ((15.0f - 1e-4f) / 15.0f); const float wp = 6.283185307179586f * (float)d / (float)n; const float ang = fr * wp;
            v = (e <= 16) ? cosf(ang) : -sinf(ang); }
        zs[idx] = v; }
    __syncthreads();
    for (int idx = C.tid; idx < 1024; idx += 512) { const int p = idx >> 6, m = idx & 63; float s = P.hy_f_b1[l * 64 + m];
        for (int e = 0; e < 33; ++e) s += zs[p * 33 + e] * P.hy_f_w1[(l * 33 + e) * 64 + m];
        h1s[idx] = sinf(P.hy_f_freq1[l * 64 + m] * s); }
    __syncthreads();
    for (int idx = C.tid; idx < 1024; idx += 512) { const int p = idx >> 6, m = idx & 63; float s = P.hy_f_b2[l * 64 + m];
        for (int e = 0; e < 64; ++e) s += h1s[p * 64 + e] * P.hy_f_w2[(l * 64 + e) * 64 + m];
        h2s[idx] = sinf(P.hy_f_freq2[l * 64 + m] * s); }
    __syncthreads();
    const float la = -3.0701134573253946f, lb = -15.350567286626973f;
#pragma unroll 1
    for (int cc = 0; cc < 2; ++cc) { const int col = C.tid + 512 * cc;
        float acc[16];
#pragma unroll
        for (int p = 0; p < 16; ++p) acc[p] = 0.f;
        for (int e = 0; e < 64; ++e) { const float w = P.hy_f_w3[((size_t)l * 64 + e) * 1024 + col];
#pragma unroll
            for (int p = 0; p < 16; ++p) acc[p] += h2s[p * 64 + e] * w; }
        const int ch = col & 255; const float delta = fabsf(la + (float)ch * ((lb - la) / 255.0f));
        float* hp = H + (size_t)col * n + d0;
#pragma unroll
        for (int q = 0; q < 4; ++q) { f32x4 o;
#pragma unroll
            for (int i = 0; i < 4; ++i) { const int p = 4 * q + i; const float td = (float)(d0 + p) / (float)(n - 1); o[i] = acc[p] * expf(-td * delta); }
            *(f32x4*)(hp + 4 * q) = o; } }
    __syncthreads();
}

DI void phase_setup(const Params& P, const Ctx& C) {
    unsigned char* ws = P.ws;
    for (int u = C.bid; u < 192 + 512 + 16; u += C.G) {
        if (u < 192) setup_adaln(P, C, u);
        else if (u < 192 + 512) { const int v = u - 192, l = v >> 8, blk = v & 255; setup_filter(P, C, l, SEQ, blk * 16, (float*)(ws + OFF_HL) + (size_t)l * 1024 * 4096); }
        else { const int blk = u - 192 - 512; setup_filter(P, C, 0, CTXL, blk * 16, (float*)(ws + OFF_HC)); }
    }
    if (C.bid == 0) { f32x2* rt = (f32x2*)(ws + OFF_ROPE); const int p = C.tid >> 3, f = C.tid & 7; const float inv = exp2f(-(float)f * (13.287712379549449f / 8.0f)); const float a = (float)p * inv; rt[C.tid] = (f32x2){cosf(a), sinf(a)}; }
    LAS float* scr = (LAS float*)(C.lds + C.wave * 8448);
    const int gw = C.bid * 8 + C.wave, NGW = C.G * 8;
    constexpr int I_IN = 16 * 45, I_Q = 4 * 24, I_KV = 2 * 32, I_OUT = 16 * 32, I_M1 = 16 * 128, I_M2 = 64 * 32, I_L = I_IN + I_Q + I_KV + I_OUT + I_M1 + I_M2;
    for (int it = gw; it < 2 * I_L; it += NGW) {
        const int l = it / I_L; int r = it - l * I_L; unsigned char* wl = ws + OFF_W + (size_t)l * SZ_WLAYER;
        if (r < I_IN) { const int kb = r / 45, nb = r % 45; transpose_item(P.w_in + (size_t)l * 1024 * NIN, NIN, kb * 64, nb * 32, (bf16_t*)(wl + WO_IN), 1024, nb * 32, scr, C.lane); continue; } r -= I_IN;
        if (r < I_Q) { const int kb = r / 24, nb = r % 24; transpose_item(P.w_q_up + (size_t)l * 256 * 768, 768, kb * 64, nb * 32, (bf16_t*)(wl + WO_Q), 256, nb * 32, scr, C.lane); continue; } r -= I_Q;
        if (r < I_KV) { const int kb = r / 32, nb = r % 32, n0 = nb * 32, h = n0 >> 7, j0 = n0 & 127;
            bf16_t* dst = (bf16_t*)(wl + (j0 < 64 ? WO_KN : WO_V)); const int orow = h * 64 + (j0 & 63);
            transpose_item(P.w_kv_up + (size_t)l * 128 * 1024, 1024, kb * 64, n0, dst, 256, orow, scr, C.lane); continue; } r -= I_KV;
        if (r < I_OUT) { const int kb = r / 32, nb = r % 32; transpose_item(P.w_out + (size_t)l * 1024 * 1024, 1024, kb * 64, nb * 32, (bf16_t*)(wl + WO_OUT), 1024, nb * 32, scr, C.lane); continue; } r -= I_OUT;
        if (r < I_M1) { const int kb = r / 128, nb = r % 128; transpose_item(P.w_mlp1 + (size_t)l * 1024 * 4096, 4096, kb * 64, nb * 32, (bf16_t*)(wl + WO_M1), 1024, nb * 32, scr, C.lane); continue; } r -= I_M1;
        { const int kb = r / 32, nb = r % 32; transpose_item(P.w_mlp2 + (size_t)l * 4096 * 1024, 1024, kb * 64, nb * 32, (bf16_t*)(wl + WO_M2), 4096, nb * 32, scr, C.lane); }
    }
    const size_t gt = (size_t)C.bid * 512 + C.tid, NGT = (size_t)C.G * 512;
    for (size_t i = gt; i < (size_t)3 * RT; i += NGT) ((float*)(ws + OFF_SS))[RT + i] = 0.f;
    for (int l = 0; l < 2; ++l) { unsigned char* wl = ws + OFF_W + (size_t)l * SZ_WLAYER;
        for (size_t i = gt; i < 12288; i += NGT) *(u32x4*)(wl + WO_IN + (size_t)NIN * 2048 + i * 16) = (u32x4){0u, 0u, 0u, 0u};
        for (size_t i = gt; i < 2 * 512 * 16; i += NGT) { const size_t w = i / (512 * 16), rr = (i / 16) % 512, ch = i % 16;
            *(u32x4*)(wl + (w ? WO_V : WO_KN) + rr * 512 + 256 + ch * 16) = (u32x4){0u, 0u, 0u, 0u}; }
        for (size_t i = gt; i < 65536; i += NGT) { const int n = (int)(i >> 8), k = (int)(i & 255), g = n >> 6;
            const float v = ((k >> 6) == g) ? P.pool_w[((l * 4 + g) * 64 + (k & 63)) * 64 + (n & 63)] * P.pool_scale[l * 256 + n] : 0.f;
            ((bf16_t*)(wl + WO_POOL))[i] = f2bf(v); }
    }
}

DI void shiftw_unit(const Params& P, const Ctx& C, int u) {
    const int l = u / 87, v = u % 87, which = (v >= 23) ? 1 : 0, j0 = (which ? v - 23 : v) * 64, N = which ? DFF : NIN;
    const float* W = which ? P.w_mlp1 + (size_t)l * 1024 * DFF : P.w_in + (size_t)l * 1024 * NIN;
    const float* mod = (const float*)(P.ws + OFF_MOD) + (size_t)l * 17 * 6144 + (which ? 3 : 0) * 1024;
    LAS float* sl = (LAS float*)C.lds;
    LAS float* part = sl + 17 * 1024;
    __syncthreads();
    for (int idx = C.tid; idx < 17 * 1024; idx += 512) { const int r = idx >> 10, k = idx & 1023; sl[idx] = mod[(size_t)r * 6144 + k]; }
    __syncthreads();
    const int ks = C.tid >> 6, jj = C.tid & 63; const bool ok = (j0 + jj) < N;
    float acc[17];
#pragma unroll
    for (int r = 0; r < 17; ++r) acc[r] = 0.f;
    const float* wp = W + (size_t)(ks * 128) * N + j0 + (ok ? jj : 0);
    for (int k = 0; k < 128; ++k) { const float w = wp[(size_t)k * N];
#pragma unroll
        for (int r = 0; r < 17; ++r) acc[r] += sl[r * 1024 + ks * 128 + k] * w; }
#pragma unroll
    for (int r = 0; r < 17; ++r) part[(ks * 17 + r) * 64 + jj] = acc[r];
    __syncthreads();
    float* shw = (float*)(P.ws + OFF_SHW) + (size_t)(l * 2 + which) * 17 * 4096;
    for (int idx = C.tid; idx < 17 * 64; idx += 512) { const int r = idx >> 6, j2 = idx & 63; float sacc = 0.f;
#pragma unroll
        for (int q = 0; q < 8; ++q) sacc += part[(q * 17 + r) * 64 + j2];
        if (j0 + j2 < N) shw[(size_t)r * 4096 + j0 + j2] = sacc; }
}
DI void phase_first(const Params& P, const Ctx& C) {
    const float* mod = (const float*)(P.ws + OFF_MOD);
    const float* gain = P.g_mix;
    bf16_t* hb = (bf16_t*)P.out; float* ss0 = (float*)(P.ws + OFF_SS);
    for (int row = C.bid * 8 + C.wave; row < RT; row += C.G * 8) {
        const float* xr = (row < RL) ? P.x + (size_t)row * 1024 : P.ctx + (size_t)(row - RL) * 1024;
        const int mr = (row < RL) ? (row >> 12) : 16;
        const float* sc = mod + (size_t)mr * 6144 + 1024;
        f32x4 v[4]; float ss = 0.f;
#pragma unroll
        for (int j = 0; j < 4; ++j) { v[j] = *(const f32x4*)(xr + 4 * C.lane + 256 * j); ss += (v[j][0] * v[j][0] + v[j][1] * v[j][1]) + (v[j][2] * v[j][2] + v[j][3] * v[j][3]); }
        ss = wave_sum(ss, C.lane);
        if (C.lane == 0) ss0[row] = ss;
#pragma unroll
        for (int j = 0; j < 4; ++j) { const int c = 4 * C.lane + 256 * j; const f32x4 g = *(const f32x4*)(gain + c), s1 = *(const f32x4*)(sc + c);
            const f32x4 y = v[j] * g * (s1 + 1.0f);
            u32x2 w; w.x = pk2(y[0], y[1]); w.y = pk2(y[2], y[3]);
            *(u32x2*)(hb + (size_t)row * 1024 + c) = w; }
    }
    for (int u = C.bid; u < 174; u += C.G) shiftw_unit(P, C, u);
}

DI float qsum16(float v, int lane) { v += xshfl(v, 1, lane); v += xshfl(v, 2, lane); v += xshfl(v, 4, lane); v += xshfl(v, 8, lane); return v; }
DI void unpack8(const u32x4 w, float (&a)[8]) { a[0] = bflo(w.x); a[1] = bfhi(w.x); a[2] = bflo(w.y); a[3] = bfhi(w.y); a[4] = bflo(w.z); a[5] = bfhi(w.z); a[6] = bflo(w.w); a[7] = bfhi(w.w); }
DI void phase_prep(const Params& P, const Ctx& C, int l) {
    unsigned char* ws = P.ws;
    const bf16_t* proj = (const bf16_t*)(ws + OFF_PROJ);
    bf16_t* NQ = (bf16_t*)(ws + OFF_NQ); bf16_t* Kb = (bf16_t*)(ws + OFF_K); bf16_t* poolA = (bf16_t*)(ws + OFF_POOLA); bf16_t* VXT = (bf16_t*)(ws + OFF_VXT);
    const f32x2* rope = (const f32x2*)(ws + OFF_ROPE);
    const float* gkv = P.g_kv + l * 128; const float* gq = P.g_q + l * 256;
    LAS bf16_t* L = (LAS bf16_t*)C.lds;
    constexpr int LS = 514;
    const int j = C.lane & 15, qw = C.lane >> 4;
    for (int u = C.bid; u < 1280; u += C.G) {
        int row0, b, t0, n, pos_off, ntok; bool isctx;
        if (u < 1024) { row0 = u * 64; b = row0 >> 12; t0 = row0 & 4095; n = SEQ; pos_off = CTXL; isctx = false; ntok = 64; }
        else { const int uc = u - 1024; row0 = RL + uc * 16; b = uc >> 4; t0 = (uc & 15) * 16; n = CTXL; pos_off = 0; isctx = true; ntok = 16; }
        const int lgt = isctx ? 1 : 3;
        const int rowseq = row0 - t0;
#pragma unroll
        for (int itk = 0; itk < 2; ++itk) { const bool act = !isctx || (itk == 0 && C.wave < 4);
            const int tok = !isctx ? (C.wave * 8 + itk * 4 + qw) : (act ? C.wave * 4 + qw : 0), row = row0 + tok, t = t0 + tok;
            const bf16_t* pr = proj + (size_t)row * NIN;
            const u32x4 wkv = *(const u32x4*)(pr + 8 * j), wq0 = *(const u32x4*)(pr + COL_Q + 8 * j), wq1 = *(const u32x4*)(pr + COL_Q + 128 + 8 * j);
            const unsigned wkr = *(const unsigned*)(pr + COL_KR + 2 * j);
            { float a[8]; unpack8(wkv, a); float ss = 0.f;
#pragma unroll
              for (int i = 0; i < 8; ++i) ss += a[i] * a[i];
              const float rs = rsqrtf(qsum16(ss, C.lane) * (1.f / 128.f) + EPS);
              const f32x4 g0 = *(const f32x4*)(gkv + 8 * j), g1 = *(const f32x4*)(gkv + 8 * j + 4);
              u32x4 o; o.x = pk2(a[0] * rs * g0[0], a[1] * rs * g0[1]); o.y = pk2(a[2] * rs * g0[2], a[3] * rs * g0[3]); o.z = pk2(a[4] * rs * g1[0], a[5] * rs * g1[1]); o.w = pk2(a[6] * rs * g1[2], a[7] * rs * g1[3]);
              if (act) *(u32x4*)(NQ + (size_t)row * 384 + 8 * j) = o; }
            { float a[8], c[8]; unpack8(wq0, a); unpack8(wq1, c); float ss = 0.f;
#pragma unroll
              for (int i = 0; i < 8; ++i) ss += a[i] * a[i] + c[i] * c[i];
              const float rs = rsqrtf(qsum16(ss, C.lane) * (1.f / 256.f) + EPS);
              const f32x4 g0 = *(const f32x4*)(gq + 8 * j), g1 = *(const f32x4*)(gq + 8 * j + 4), g2 = *(const f32x4*)(gq + 128 + 8 * j), g3 = *(const f32x4*)(gq + 128 + 8 * j + 4);
              u32x4 o; o.x = pk2(a[0] * rs * g0[0], a[1] * rs * g0[1]); o.y = pk2(a[2] * rs * g0[2], a[3] * rs * g0[3]); o.z = pk2(a[4] * rs * g1[0], a[5] * rs * g1[1]); o.w = pk2(a[6] * rs * g1[2], a[7] * rs * g1[3]);
              if (act) *(u32x4*)(NQ + (size_t)row * 384 + 128 + 8 * j) = o;
              o.x = pk2(c[0] * rs * g2[0], c[1] * rs * g2[1]); o.y = pk2(c[2] * rs * g2[2], c[3] * rs * g2[3]); o.z = pk2(c[4] * rs * g3[0], c[5] * rs * g3[1]); o.w = pk2(c[6] * rs * g3[2], c[7] * rs * g3[3]);
              if (act) *(u32x4*)(NQ + (size_t)row * 384 + 256 + 8 * j) = o; }
            { float x0 = bflo(wkr), x1 = bfhi(wkr); const float p0 = xshfl(x0, 4, C.lane), p1 = xshfl(x1, 4, C.lane);
              if (!isctx) { const int axis = j >> 3, half = (j >> 2) & 1, f = 2 * (j & 3); const int pp = axis ? (t & 63) : (t >> 6); const f32x2 c0 = rope[pp * 8 + f], c1 = rope[pp * 8 + f + 1];
                  x0 = half ? (x0 * c0.x + p0 * c0.y) : (x0 * c0.x - p0 * c0.y); x1 = half ? (x1 * c1.x + p1 * c1.y) : (x1 * c1.x - p1 * c1.y); }
              const unsigned w = pk2(x0, x1);
#pragma unroll
              for (int h = 0; h < 8; ++h) if (act) *(unsigned*)(Kb + ((size_t)(b * 8 + h) * NKEY + pos_off + t) * 96 + 64 + 2 * j) = w; }
        }
        for (int rd = 0; rd < 2; ++rd) {
            const int colbase = COL_POOL + rd * 512;
            __syncthreads();
            { u32x4 v[10];
#pragma unroll
              for (int i = 0; i < 10; ++i) { const int it = C.tid + 512 * i, rr = it >> 6, part = it & 63; const int t = t0 - 8 + rr;
                  v[i] = (u32x4){0u, 0u, 0u, 0u};
                  if (t >= 0 && t < n && rr < ntok + 16) v[i] = *(const u32x4*)(proj + (size_t)(rowseq + t) * NIN + colbase + part * 8); }
#pragma unroll
              for (int i = 0; i < 10; ++i) { const int it = C.tid + 512 * i, rr = it >> 6, part = it & 63;
                  LAS unsigned* d = (LAS unsigned*)(L + rr * LS + part * 8); if (rr < ntok + 16) d[0] = v[i].x; if (rr < ntok + 16) { d[1] = v[i].y; d[2] = v[i].z; d[3] = v[i].w; } } }
            __syncthreads();
            if (rd == 0) {
                for (int it = C.tid; it < ntok * 128; it += 512) { const int tok = it >> 7, cp = it & 127, c = 2 * cp, g = c >> 6, hw = 1 << g;
                    const int t = t0 + tok; const int lo = max(t - hw, 0), hi = min(t + hw, n);
                    float s0 = 0.f, s1 = 0.f;
                    for (int sidx = lo; sidx < hi; ++sidx) { const unsigned w = *(LAS const unsigned*)(L + (sidx - t0 + 8) * LS + c); s0 += bflo(w); s1 += bfhi(w); }
                    const unsigned wc = *(LAS const unsigned*)(L + (tok + 8) * LS + c);
                    const float inv = 1.f / (float)(hi - lo);
                    *(unsigned*)(poolA + (size_t)(row0 + tok) * 256 + c) = pk2(s0 * inv - bflo(wc), s1 * inv - bfhi(wc)); }
            }
            for (int kk = (rd == 0 ? 1 : 0); kk < 2; ++kk) { const int k = rd * 2 + kk - 1;
                const int cb = kk * 256;
                for (int it = C.tid; it < (256 << lgt); it += 512) { const int tg = it & ((1 << lgt) - 1), c = it >> lgt, ch = k * 256 + c;
                    const float w0 = P.hy_conv_w[(l * 3 + 0) * 768 + ch], w1 = P.hy_conv_w[(l * 3 + 1) * 768 + ch], w2 = P.hy_conv_w[(l * 3 + 2) * 768 + ch], bb = P.hy_conv_b[l * 768 + ch];
                    float xv[10];
#pragma unroll
                    for (int i = 0; i < 10; ++i) xv[i] = bf2f(L[(8 * tg + i + 7) * LS + cb + c]);
                    float o[8];
#pragma unroll
                    for (int i = 0; i < 8; ++i) o[i] = xv[i] * w0 + xv[i + 1] * w1 + xv[i + 2] * w2 + bb;
                    u32x4 w; w.x = pk2(o[0], o[1]); w.y = pk2(o[2], o[3]); w.z = pk2(o[4], o[5]); w.w = pk2(o[6], o[7]);
                    *(u32x4*)(VXT + (size_t)k * (SZ_XT / 2) + ((size_t)c * NB + b) * NKEY + pos_off + t0 + 8 * tg) = w; }
            }
        }
        __syncthreads();
    }
}

constexpr int KS_T = 64 * 104, VS_T = 64 * 72;
DI void attn_qk(LAS const bf16_t* Kc, const bf16x8 (&qf)[6], int r, int hh, f32x16& s0, f32x16& s1) {
#pragma unroll
    for (int i = 0; i < 16; ++i) { s0[i] = 0.f; s1[i] = 0.f; }
#pragma unroll
    for (int ks = 0; ks < 6; ++ks) {
        const bf16x8 a0 = *(LAS const bf16x8*)(Kc + r * 104 + 16 * ks + 8 * hh);
        const bf16x8 a1 = *(LAS const bf16x8*)(Kc + (32 + r) * 104 + 16 * ks + 8 * hh);
        s0 = __builtin_amdgcn_mfma_f32_32x32x16_bf16(a0, qf[ks], s0, 0, 0, 0);
        s1 = __builtin_amdgcn_mfma_f32_32x32x16_bf16(a1, qf[ks], s1, 0, 0, 0);
    }
}
struct AttnSt { f32x16 o0, o1; float mref, lsum; };
DI float vmax3(float a, float b, float c) { float d; asm("v_max3_f32 %0, %1, %2, %3" : "=v"(d) : "v"(a), "v"(b), "v"(c)); return d; }
template <bool HAS_NEXT>
DI void attn_tile(LAS const bf16_t* Kn, LAS const bf16_t* Vc, const bf16x8 (&qf)[6], int r, int hh, int lane, f32x16& s0, f32x16& s1, f32x16& n0, f32x16& n1, AttnSt& st, bool first) {
    bf16x8 kf[12], vf[8];
    __builtin_amdgcn_sched_barrier(0);
    if (HAS_NEXT) {
#pragma unroll
        for (int ks = 0; ks < 6; ++ks) { kf[2 * ks] = *(LAS const bf16x8*)(Kn + r * 104 + 16 * ks + 8 * hh); kf[2 * ks + 1] = *(LAS const bf16x8*)(Kn + (32 + r) * 104 + 16 * ks + 8 * hh); }
    }
    if (first) {
        float mx = vmax3(s0[0], s0[1], s0[2]);
#pragma unroll
        for (int i = 3; i < 15; i += 2) mx = vmax3(mx, s0[i], s0[i + 1]);
        mx = vmax3(mx, s0[15], s1[0]);
#pragma unroll
        for (int i = 1; i < 15; i += 2) mx = vmax3(mx, s1[i], s1[i + 1]);
        mx = fmaxf(mx, s1[15]);
        mx = fmaxf(mx, xshfl(mx, 32, lane));
        s0 = s0 - mx; s1 = s1 - mx; st.mref = mx;
    }
    __builtin_amdgcn_sched_barrier(0);
    if (HAS_NEXT) {
        const float nm = -st.mref;
#pragma unroll
        for (int i = 0; i < 16; ++i) { n0[i] = nm; n1[i] = nm; }
#pragma unroll
        for (int ks = 0; ks < 6; ++ks) { n0 = __builtin_amdgcn_mfma_f32_32x32x16_bf16(kf[2 * ks], qf[ks], n0, 0, 0, 0); n1 = __builtin_amdgcn_mfma_f32_32x32x16_bf16(kf[2 * ks + 1], qf[ks], n1, 0, 0, 0); }
    }
#pragma unroll
    for (int sidx = 0; sidx < 4; ++sidx) { vf[2 * sidx] = *(LAS const bf16x8*)(Vc + r * 72 + 16 * sidx + 8 * hh); vf[2 * sidx + 1] = *(LAS const bf16x8*)(Vc + (32 + r) * 72 + 16 * sidx + 8 * hh); }
#pragma unroll
    for (int i = 0; i < 16; ++i) { s0[i] = __builtin_amdgcn_exp2f(s0[i]); s1[i] = __builtin_amdgcn_exp2f(s1[i]); }
    float ps = 0.f;
    { const f32x16 sm = s0 + s1;
#pragma unroll
      for (int i = 0; i < 16; ++i) ps += sm[i]; }
    if (HAS_NEXT) {
#pragma unroll
        for (int i = 0; i < 12; ++i) { __builtin_amdgcn_sched_group_barrier(0x008, 1, 0); __builtin_amdgcn_sched_group_barrier(0x100, 1, 0); __builtin_amdgcn_sched_group_barrier(0x002, 4, 0); }
    }
    __builtin_amdgcn_sched_barrier(0);
    if (__builtin_amdgcn_ballot_w64(!(ps < 1.8446744e19f)) != 0ull) {
        const float sc = 5.421010862427522e-20f;
        s0 = s0 * sc; s1 = s1 * sc; ps *= sc; st.o0 = st.o0 * sc; st.o1 = st.o1 * sc; st.lsum *= sc; st.mref += 64.f;
        if (HAS_NEXT) { n0 = n0 - 64.f; n1 = n1 - 64.f; }
    }
    st.lsum += ps;
    u32x4 pw[4];
#pragma unroll
    for (int st4 = 0; st4 < 2; ++st4) {
        pw[st4].x = pk2(s0[8 * st4 + 0], s0[8 * st4 + 1]); pw[st4].y = pk2(s0[8 * st4 + 2], s0[8 * st4 + 3]); pw[st4].z = pk2(s0[8 * st4 + 4], s0[8 * st4 + 5]); pw[st4].w = pk2(s0[8 * st4 + 6], s0[8 * st4 + 7]);
        pw[2 + st4].x = pk2(s1[8 * st4 + 0], s1[8 * st4 + 1]); pw[2 + st4].y = pk2(s1[8 * st4 + 2], s1[8 * st4 + 3]); pw[2 + st4].z = pk2(s1[8 * st4 + 4], s1[8 * st4 + 5]); pw[2 + st4].w = pk2(s1[8 * st4 + 6], s1[8 * st4 + 7]); }
#pragma unroll
    for (int sidx = 0; sidx < 4; ++sidx) {
        const bf16x8 pf = __builtin_bit_cast(bf16x8, pw[sidx]);
        st.o0 = __builtin_amdgcn_mfma_f32_32x32x16_bf16(vf[2 * sidx], pf, st.o0, 0, 0, 0);
        st.o1 = __builtin_amdgcn_mfma_f32_32x32x16_bf16(vf[2 * sidx + 1], pf, st.o1, 0, 0, 0);
    }
    __builtin_amdgcn_sched_barrier(0);
}
constexpr int AT_NBUF = 5, AT_KB = 64 * 208, AT_VB = 64 * 144, AT_STAGE = AT_KB + AT_VB;
DI void attn_unit(const Ctx& C, const bf16_t* Qp, const bf16_t* Kp, const bf16_t* VTp, int nkeys, bf16_t* outp) {
    const int r = C.lane & 31, hh = C.lane >> 5;
    bf16x8 qf[6];
    { const bf16_t* qrow = Qp + (size_t)(C.wave * 32 + r) * 96 + 8 * hh;
#pragma unroll
      for (int ks = 0; ks < 6; ++ks) qf[ks] = *(const bf16x8*)(qrow + 16 * ks); }
    AttnSt st;
#pragma unroll
    for (int i = 0; i < 16; ++i) { st.o0[i] = 0.f; st.o1[i] = 0.f; }
    st.mref = 0.f; st.lsum = 0.f;
    const char* gb[3]; unsigned gv[3]; unsigned gstep[3]; unsigned lo[3];
#pragma unroll
    for (int k = 0; k < 3; ++k) { int pc = C.wave + 8 * k; if (pc >= 22) pc = C.wave;
        if (pc < 13) { const int q = pc * 64 + C.lane, row = q / 13, part = min(q - row * 13, 11); gb[k] = (const char*)Kp; gv[k] = (unsigned)(row * 192 + part * 16); gstep[k] = 64 * 192; lo[k] = pc * 1024; }
        else { const int q = (pc - 13) * 64 + C.lane, row = q / 9, part = min(q - row * 9, 7); gb[k] = (const char*)VTp; gv[k] = (unsigned)(row * (NKEY * 2) + part * 16); gstep[k] = 128; lo[k] = AT_KB + (pc - 13) * 1024; } }
    const int ntile = nkeys >> 6;
#define AT_ISSUE(tile, buf) do { const int _t = (tile) < ntile ? (tile) : ntile - 1; _Pragma("unroll") for (int _k = 0; _k < 3; ++_k) \
        __builtin_amdgcn_global_load_lds((const unsigned*)((gb[_k] + (size_t)_t * gstep[_k]) + gv[_k]), (LAS unsigned*)(C.lds + (buf) * AT_STAGE + lo[_k]), 16, 0, 0); } while (0)
#define AT_KPTR(buf) ((LAS const bf16_t*)(C.lds + (buf) * AT_STAGE))
#define AT_VPTR(buf) ((LAS const bf16_t*)(C.lds + (buf) * AT_STAGE + AT_KB))
#define AT_SEAM() do { asm volatile("s_waitcnt vmcnt(6)" ::: "memory"); __builtin_amdgcn_s_barrier(); asm volatile("" ::: "memory"); } while (0)
#define AT_NEXT(b) (((b) == AT_NBUF - 1) ? 0 : (b) + 1)
#define AT_PREV(b) (((b) == 0) ? AT_NBUF - 1 : (b) - 1)
    __syncthreads();
    AT_ISSUE(0, 0); AT_ISSUE(1, 1); AT_ISSUE(2, 2); AT_ISSUE(3, 3);
    AT_SEAM();
    f32x16 sa0, sa1, sb0, sb1;
    attn_qk(AT_KPTR(0), qf, r, hh, sa0, sa1);
    int bc = 0, it = 0;
    for (; it + 2 < ntile; it += 2) {
        { const int bn = AT_NEXT(bc); AT_ISSUE(it + 4, AT_PREV(bc));
          attn_tile<true>(AT_KPTR(bn), AT_VPTR(bc), qf, r, hh, C.lane, sa0, sa1, sb0, sb1, st, it == 0);
          AT_SEAM(); bc = bn; }
        { const int bn = AT_NEXT(bc); AT_ISSUE(it + 5, AT_PREV(bc));
          attn_tile<true>(AT_KPTR(bn), AT_VPTR(bc), qf, r, hh, C.lane, sb0, sb1, sa0, sa1, st, false);
          AT_SEAM(); bc = bn; }
    }
    { const int bn = AT_NEXT(bc); AT_ISSUE(ntile, AT_PREV(bc));
      attn_tile<true>(AT_KPTR(bn), AT_VPTR(bc), qf, r, hh, C.lane, sa0, sa1, sb0, sb1, st, false);
      AT_SEAM(); bc = bn; }
    attn_tile<false>(AT_KPTR(0), AT_VPTR(bc), qf, r, hh, C.lane, sb0, sb1, sa0, sa1, st, false);
    asm volatile("s_waitcnt vmcnt(0)" ::: "memory");
#undef AT_ISSUE
#undef AT_KPTR
#undef AT_VPTR
#undef AT_SEAM
#undef AT_NEXT
#undef AT_PREV
    const float ltot = st.lsum + xshfl(st.lsum, 32, C.lane);
    const float inv = 1.f / ltot;
    bf16_t* orow = outp + (size_t)(C.wave * 32 + r) * 512 + 4 * hh;
#pragma unroll
    for (int g = 0; g < 4; ++g) {
        u32x2 w0, w1;
        w0.x = pk2(st.o0[4 * g] * inv, st.o0[4 * g + 1] * inv); w0.y = pk2(st.o0[4 * g + 2] * inv, st.o0[4 * g + 3] * inv);
        w1.x = pk2(st.o1[4 * g] * inv, st.o1[4 * g + 1] * inv); w1.y = pk2(st.o1[4 * g + 2] * inv, st.o1[4 * g + 3] * inv);
        *(u32x2*)(orow + 8 * g) = w0; *(u32x2*)(orow + 32 + 8 * g) = w1;
    }
}

DI void phase_attn(const Params& P, const Ctx& C, int l) {
    unsigned char* ws = P.ws;
    const bf16_t* QL = (const bf16_t*)(ws + OFF_QL); const bf16_t* QC = (const bf16_t*)(ws + OFF_QC);
    const bf16_t* Kb = (const bf16_t*)(ws + OFF_K); const bf16_t* VT = (const bf16_t*)(ws + OFF_VT);
    bf16_t* att = (bf16_t*)(ws + OFF_ATT);
    const int nun = 2048 + (l == 0 ? 128 : 0);
    for (int u = C.bid; u < nun; u += C.G) {
        if (u < 2048) { const int j = u / C.G, w = u - j * C.G;
            const int qb = (w >> 3) & 15, bh = (C.G == 256) ? (j * 16 + (w & 7) * 2 + (w >> 7)) : (u >> 4), b = bh >> 3, h = bh & 7; const int qb2 = (C.G == 256) ? qb : (u & 15);
            attn_unit(C, QL + ((size_t)bh * SEQ + qb2 * 256) * 96, Kb + (size_t)bh * NKEY * 96, VT + (size_t)bh * 64 * NKEY, NKEY,
                      att + ((size_t)b * SEQ + qb2 * 256) * 512 + h * 64); }
        else { const int bh = u - 2048, b = bh >> 3, h = bh & 7;
            attn_unit(C, QC + (size_t)bh * CTXL * 96, Kb + (size_t)bh * NKEY * 96, VT + (size_t)bh * 64 * NKEY, CTXL,
                      att + ((size_t)RL + b * CTXL) * 512 + h * 64); }
    }
    __syncthreads();
}

DI float hval(const float* Hf, const float* Hb, int n, int m) { if (m > 2 * n - 2) return 0.f; const int d = n - 1 - m; return d >= 0 ? Hf[d] : Hb[-d]; }
DI bf16x8 lda_tile(LAS const unsigned char* p) { LAS const unsigned* q = (LAS const unsigned*)p; u32x4 v; v.x = q[0]; v.y = q[1]; v.z = q[2]; v.w = q[3]; return __builtin_bit_cast(bf16x8, v); }

DI void hyena_unit(const Ctx& C, const float* Hf, const float* Hb, int n, const bf16_t* UT, const bf16_t* XT, bf16_t* OT, int pos_off, float bias) {
    LAS bf16_t* R0 = (LAS bf16_t*)C.lds; LAS bf16_t* R1 = R0 + 8192; LAS float* red = (LAS float*)(C.lds + 32768);
    __syncthreads();
    float asum = 0.f;
    for (int m = C.tid; m < 2 * n; m += 512) { const float v0 = hval(Hf, Hb, n, m), v1 = hval(Hf, Hb, n, m + 1); R0[m] = f2bf(v0); R1[m] = f2bf(v1); asum += fabsf(v0); }
    asum = wave_sum(asum, C.lane);
    if (C.lane == 0) red[C.wave] = asum;
    __syncthreads();
    float tot = 0.f;
#pragma unroll
    for (int w = 0; w < 8; ++w) tot += red[w];
    const float invn = 1.f / tot;
    const int i = C.lane & 15, g = C.lane >> 4;
    const int npass = n >> 8, nj = n >> 5;
    for (int pass = C.wave; pass < npass; pass += 8) {
        const int I0 = 16 * pass;
        const int m0 = (n - 1) - 16 * I0 - i + 8 * g;
        LAS const unsigned char* a0 = C.lds + (m0 & 1) * 16384 + (m0 & ~1) * 2;
        f32x4 acc[16]; bf16x8 W[16];
#pragma unroll
        for (int s = 0; s < 16; ++s) { acc[s] = (f32x4){0.f, 0.f, 0.f, 0.f}; W[s] = lda_tile(a0 - 32 * s); }
        const bf16_t* ub = UT + (size_t)i * NKEY + pos_off + 8 * g;
        bf16x8 bq[4];
#pragma unroll
        for (int k = 0; k < 3; ++k) bq[k] = *(const bf16x8*)(ub + 32 * min(k, nj - 1));
        for (int j0 = 0; j0 < nj; j0 += 8) {
#pragma unroll
            for (int u = 0; u < 8; ++u) { const int j = j0 + u;
                acc[14] = __builtin_amdgcn_mfma_f32_16x16x32_bf16(W[(14 - 2 * u + 16) & 15], bq[u & 3], acc[14], 0, 0, 0);
                acc[15] = __builtin_amdgcn_mfma_f32_16x16x32_bf16(W[(15 - 2 * u + 16) & 15], bq[u & 3], acc[15], 0, 0, 0);
                __builtin_amdgcn_sched_barrier(0);
                W[(14 - 2 * u + 16) & 15] = lda_tile(a0 + 64 * (j + 1));
                W[(15 - 2 * u + 16) & 15] = lda_tile(a0 + 64 * (j + 1) - 32);
                bq[(u + 3) & 3] = *(const bf16x8*)(ub + 32 * min(j + 3, nj - 1));
                __builtin_amdgcn_sched_barrier(0);
#pragma unroll
                for (int ii = 0; ii < 14; ++ii) acc[ii] = __builtin_amdgcn_mfma_f32_16x16x32_bf16(W[(ii - 2 * u + 16) & 15], bq[u & 3], acc[ii], 0, 0, 0);
                __builtin_amdgcn_sched_barrier(0); }
        }
#pragma unroll
        for (int ii = 0; ii < 16; ++ii) { const size_t off = (size_t)i * NKEY + pos_off + 16 * (I0 + ii) + 4 * g;
            const u32x2 uu = *(const u32x2*)(UT + off), xx = *(const u32x2*)(XT + off);
            const float y0 = acc[ii][0] * invn + bflo(uu.x) * bias, y1 = acc[ii][1] * invn + bfhi(uu.x) * bias, y2 = acc[ii][2] * invn + bflo(uu.y) * bias, y3 = acc[ii][3] * invn + bfhi(uu.y) * bias;
            u32x2 w; w.x = pk2(bflo(xx.x) * y0, bfhi(xx.x) * y1); w.y = pk2(bflo(xx.y) * y2, bfhi(xx.y) * y3);
            *(u32x2*)(OT + off) = w; }
    }
}

DI void phase_hyena(const Params& P, const Ctx& C, int l, int o) {
    unsigned char* ws = P.ws;
    const bf16_t* VXT = (const bf16_t*)(ws + OFF_VXT); const size_t XS = SZ_XT / 2;
    const bf16_t* UTb = o == 0 ? VXT : (const bf16_t*)(ws + OFF_ZT);
    const bf16_t* XTb = o == 0 ? VXT + XS : VXT + 2 * XS;
    bf16_t* OTb = o == 0 ? (bf16_t*)(ws + OFF_ZT) : (bf16_t*)(ws + OFF_HYT);
    const float* HL = (const float*)(ws + OFF_HL) + (size_t)l * 1024 * 4096; const float* HC = (const float*)(ws + OFF_HC);
    const int nun = 256 + (l == 0 ? 256 : 0);
    for (int u = C.bid; u < nun; u += C.G) {
        const int c = u & 255; const size_t co = (size_t)c * NB * NKEY; const float bias = P.hy_bias[(l * 2 + o) * 256 + c];
        if (u < 256) hyena_unit(C, HL + (size_t)(o * 512 + c) * 4096, HL + (size_t)(o * 512 + 256 + c) * 4096, SEQ, UTb + co, XTb + co, OTb + co, CTXL, bias);
        else hyena_unit(C, HC + (size_t)(o * 512 + c) * 256, HC + (size_t)(o * 512 + 256 + c) * 256, CTXL, UTb + co, XTb + co, OTb + co, 0, bias);
    }
    __syncthreads();
}

DI void phase_merge(const Params& P, const Ctx& C, int l) {
    unsigned char* ws = P.ws;
    const bf16_t* att = (const bf16_t*)(ws + OFF_ATT); const bf16_t* po = (const bf16_t*)(ws + OFF_POOLO); const bf16_t* hyT = (const bf16_t*)(ws + OFF_HYT);
    bf16_t* mb = (bf16_t*)P.out;
    const float* go = P.g_out + l * 1024;
    LAS bf16_t* L = (LAS bf16_t*)C.lds;
    const int nun = (l == 0) ? 1280 : 1024;
    const int j = C.lane & 15, qw = C.lane >> 4;
    for (int u = C.bid; u < nun; u += C.G) {
        int row0, b, t0, pos_off; bool isctx;
        if (u < 1024) { row0 = u * 64; b = row0 >> 12; t0 = row0 & 4095; pos_off = CTXL; isctx = false; }
        else { const int uc = u - 1024; row0 = RL + uc * 16; b = uc >> 4; t0 = (uc & 15) * 16; pos_off = 0; isctx = true; }
        const int nparts = isctx ? 2 : 8;
        __syncthreads();
        { u32x4 v[4];
#pragma unroll
          for (int i = 0; i < 4; ++i) { const int it = C.tid + 512 * i, c = it >> 3, part = it & 7; v[i] = (u32x4){0u, 0u, 0u, 0u}; if (part < nparts) v[i] = *(const u32x4*)(hyT + ((size_t)c * NB + b) * NKEY + pos_off + t0 + part * 8); }
#pragma unroll
          for (int i = 0; i < 4; ++i) { const int it = C.tid + 512 * i, c = it >> 3, part = it & 7; LAS unsigned* d = (LAS unsigned*)(L + c * 66 + part * 8); d[0] = v[i].x; d[1] = v[i].y; d[2] = v[i].z; d[3] = v[i].w; } }
#pragma unroll
        for (int itk = 0; itk < 2; ++itk) { const bool act = !isctx || (itk == 0 && C.wave < 4);
            const int tok = !isctx ? (C.wave * 8 + itk * 4 + qw) : (act ? C.wave * 4 + qw : 0), row = row0 + tok;
            bf16_t* mr = mb + (size_t)row * 1024;
            u32x4 wa[4], wp[2];
#pragma unroll
            for (int q = 0; q < 4; ++q) wa[q] = *(const u32x4*)(att + (size_t)row * 512 + 8 * j + 128 * q);
#pragma unroll
            for (int q = 0; q < 2; ++q) wp[q] = *(const u32x4*)(po + (size_t)row * 256 + 8 * j + 128 * q);
            { float a[4][8]; float ss = 0.f;
#pragma unroll
              for (int q = 0; q < 4; ++q) { unpack8(wa[q], a[q]);
#pragma unroll
                  for (int i = 0; i < 8; ++i) ss += a[q][i] * a[q][i]; }
              const float rs = rsqrtf(qsum16(ss, C.lane) * (1.f / 512.f) + EPS);
#pragma unroll
              for (int q = 0; q < 4; ++q) { const f32x4 g0 = *(const f32x4*)(go + 8 * j + 128 * q), g1 = *(const f32x4*)(go + 8 * j + 128 * q + 4);
                  u32x4 o; o.x = pk2(a[q][0] * rs * g0[0], a[q][1] * rs * g0[1]); o.y = pk2(a[q][2] * rs * g0[2], a[q][3] * rs * g0[3]); o.z = pk2(a[q][4] * rs * g1[0], a[q][5] * rs * g1[1]); o.w = pk2(a[q][6] * rs * g1[2], a[q][7] * rs * g1[3]);
                  if (act) *(u32x4*)(mr + 8 * j + 128 * q) = o; } }
            { float a[2][8]; float ss = 0.f;
#pragma unroll
              for (int q = 0; q < 2; ++q) { unpack8(wp[q], a[q]);
#pragma unroll
                  for (int i = 0; i < 8; ++i) ss += a[q][i] * a[q][i]; }
              const float rs = rsqrtf(qsum16(ss, C.lane) * (1.f / 256.f) + EPS);
#pragma unroll
              for (int q = 0; q < 2; ++q) { const f32x4 g0 = *(const f32x4*)(go + 512 + 8 * j + 128 * q), g1 = *(const f32x4*)(go + 512 + 8 * j + 128 * q + 4);
                  u32x4 o; o.x = pk2(a[q][0] * rs * g0[0], a[q][1] * rs * g0[1]); o.y = pk2(a[q][2] * rs * g0[2], a[q][3] * rs * g0[3]); o.z = pk2(a[q][4] * rs * g1[0], a[q][5] * rs * g1[1]); o.w = pk2(a[q][6] * rs * g1[2], a[q][7] * rs * g1[3]);
                  if (act) *(u32x4*)(mr + 512 + 8 * j + 128 * q) = o; } }
        }
        __syncthreads();
#pragma unroll
        for (int itk = 0; itk < 2; ++itk) { const bool act = !isctx || (itk == 0 && C.wave < 4);
            const int tok = !isctx ? (C.wave * 8 + itk * 4 + qw) : (act ? C.wave * 4 + qw : 0), row = row0 + tok;
            bf16_t* mr = mb + (size_t)row * 1024 + 768;
            float a[8][2]; float ss = 0.f;
#pragma unroll
            for (int i = 0; i < 8; ++i) { const int c = 2 * j + 32 * i; a[i][0] = bf2f(L[c * 66 + tok]); a[i][1] = bf2f(L[(c + 1) * 66 + tok]); ss += a[i][0] * a[i][0] + a[i][1] * a[i][1]; }
            const float rs = rsqrtf(qsum16(ss, C.lane) * (1.f / 256.f) + EPS);
#pragma unroll
            for (int i = 0; i < 8; ++i) { const int c = 2 * j + 32 * i; const f32x2 g = *(const f32x2*)(go + 768 + c); if (act) *(unsigned*)(mr + c) = pk2(a[i][0] * rs * g.x, a[i][1] * rs * g.y); }
        }
    }
    __syncthreads();
}

DI void phase_ctxfin(const Params& P, const Ctx& C) {
    const float* mod0 = (const float*)(P.ws + OFF_MOD); const float* mod1 = mod0 + (size_t)17 * 6144;
    const float* gate = mod0 + (size_t)16 * 6144 + 5 * 1024;
    const float* sc = mod1 + (size_t)16 * 6144 + 1 * 1024;
    const float* gain = P.g_mix + 1024;
    bf16_t* xrb = (bf16_t*)(P.ws + OFF_XR) + (size_t)RL * 1024; const float* part = (const float*)(P.ws + OFF_PART);
    bf16_t* hb = (bf16_t*)P.out; float* ss2 = (float*)(P.ws + OFF_SS) + (size_t)2 * RT;
    for (int row = C.bid * 8 + C.wave; row < RC; row += C.G * 8) {
        bf16_t* xr = xrb + (size_t)row * 1024;
        f32x4 v[4]; float ss = 0.f;
#pragma unroll
        for (int j = 0; j < 4; ++j) { const int c = 4 * C.lane + 256 * j; f32x4 a = *(const f32x4*)(part + (size_t)row * 1024 + c);
#pragma unroll
            for (int ks = 1; ks < 4; ++ks) a = a + *(const f32x4*)(part + ((size_t)ks * RC + row) * 1024 + c);
            const u32x2 xw = *(const u32x2*)(xr + c);
            v[j] = (f32x4){bflo(xw.x), bfhi(xw.x), bflo(xw.y), bfhi(xw.y)} + *(const f32x4*)(gate + c) * a;
            u32x2 o; o.x = pk2(v[j][0], v[j][1]); o.y = pk2(v[j][2], v[j][3]); *(u32x2*)(xr + c) = o;
            ss += (v[j][0] * v[j][0] + v[j][1] * v[j][1]) + (v[j][2] * v[j][2] + v[j][3] * v[j][3]); }
        ss = wave_sum(ss, C.lane);
        if (C.lane == 0) ss2[RL + row] = ss;
#pragma unroll
        for (int j = 0; j < 4; ++j) { const int c = 4 * C.lane + 256 * j; const f32x4 y = v[j] * *(const f32x4*)(gain + c) * (*(const f32x4*)(sc + c) + 1.0f);
            u32x2 w; w.x = pk2(y[0], y[1]); w.y = pk2(y[2], y[3]);
            *(u32x2*)(hb + (size_t)(RL + row) * 1024 + c) = w; }
    }
}

DI void phase_final(const Params& P, const Ctx& C) {
    for (int row = C.bid * 8 + C.wave; row < RL; row += C.G * 8) {
        float* xr = P.out + (size_t)row * 1024; const bf16_t* xb = (const bf16_t*)(P.ws + OFF_XR) + (size_t)row * 1024;
        f32x4 v[4]; float ss = 0.f;
#pragma unroll
        for (int j = 0; j < 4; ++j) { const u32x2 w = *(const u32x2*)(xb + 4 * C.lane + 256 * j); v[j] = (f32x4){bflo(w.x), bfhi(w.x), bflo(w.y), bfhi(w.y)};
            ss += (v[j][0] * v[j][0] + v[j][1] * v[j][1]) + (v[j][2] * v[j][2] + v[j][3] * v[j][3]); }
        const float rs = rsqrtf(wave_sum(ss, C.lane) * (1.f / 1024.f) + EPS);
#pragma unroll
        for (int j = 0; j < 4; ++j) { const f32x4 g = *(const f32x4*)(P.g_final + 4 * C.lane + 256 * j); *(f32x4*)(xr + 4 * C.lane + 256 * j) = v[j] * rs * g; }
    }
}

DI Ctx make_ctx(LAS unsigned char* lds, int wave_s) {
    Ctx C; int bid = blockIdx.x, G = gridDim.x, wv = wave_s;
    int lane; asm volatile("v_mbcnt_lo_u32_b32 %0, -1, 0\n\tv_mbcnt_hi_u32_b32 %0, -1, %0" : "=v"(lane)); asm volatile("" : "+s"(bid)); asm volatile("" : "+s"(G)); asm volatile("" : "+s"(wv));
    C.lds = lds; C.tid = wv * 64 + lane; C.lane = lane; C.wave = wv; C.G = G; C.bid = bid; return C;
}
DI unsigned char* fresh_ws(const Params& P) { unsigned char* w = P.ws; asm volatile("" : "+s"(w)); return w; }

__global__ void __launch_bounds__(512, 2) mega_fwd(Params P) {
    extern __shared__ __attribute__((aligned(16))) unsigned char lds_raw[];
    cg::grid_group grid = cg::this_grid();
    LAS unsigned char* lds = (LAS unsigned char*)lds_raw;
    const int wave_s = __builtin_amdgcn_readfirstlane((int)(threadIdx.x >> 6));
    { const Ctx C = make_ctx(lds, wave_s);
      if (C.bid == 0) for (int i = C.tid; i < XCD_BAR_WORDS; i += 512) ((unsigned*)(P.ws + OFF_BAR))[i] = 0u;
      if (C.tid < 4) ((LAS unsigned*)(lds + 131072))[C.tid] = 0u;
      phase_setup(P, C); }
    grid.sync();
    { const Ctx C = make_ctx(lds, wave_s); xcd_barrier_post((unsigned*)(P.ws + OFF_BAR), C.tid == 0); }
#define GSYNC() do { const Ctx _c = make_ctx(lds, wave_s); xcd_barrier((unsigned*)(fresh_ws(P) + OFF_BAR), (volatile LAS unsigned*)(lds + 131072), _c.tid == 0); } while (0)
    { const Ctx C = make_ctx(lds, wave_s); phase_first(P, C); }
    GSYNC();
#pragma unroll 1
    for (int li = 0; li < 2; ++li) {
        int l = li; asm volatile("" : "+s"(l));
        const bool last = (l == 1);
        const int Mrows = last ? RL : RT;
        { const Ctx C = make_ctx(lds, wave_s); unsigned char* ws = fresh_ws(P); unsigned char* wl = ws + OFF_W + (size_t)l * SZ_WLAYER; pg8::StaticOrder S;
          pg8::Gemm g{(const bf16_t*)P.out, (const bf16_t*)(wl + WO_IN), RT, NINP, 1024, 1024, 1024}; S.init(g.M, g.N, C.G, C.bid);
          EpiNormBf16<0> e{(bf16_t*)(ws + OFF_PROJ), NIN, NIN, (const float*)(ws + OFF_SS) + (size_t)(l == 0 ? 0 : 2) * RT, (const float*)(ws + OFF_SHW) + (size_t)(l * 2 + 0) * 17 * 4096};
          pg8::gemm_phase(C.lds, C.tid, g, S, e); }
        GSYNC();
        { const Ctx C = make_ctx(lds, wave_s); phase_prep(P, C, l); }
        GSYNC();
        { const Ctx C = make_ctx(lds, wave_s); unsigned char* ws = fresh_ws(P); unsigned char* wl = ws + OFF_W + (size_t)l * SZ_WLAYER; pg8::StaticOrder S;
          pg8::Gemm g{(const bf16_t*)(ws + OFF_NQ) + 128, (const bf16_t*)(wl + WO_Q), Mrows, 768, 256, 384, 256}; S.init(g.M, g.N, C.G, C.bid);
          EpiQ e{(bf16_t*)(ws + OFF_QL), (bf16_t*)(ws + OFF_QC), (const f32x2*)(ws + OFF_ROPE)}; pg8::gemm_phase(C.lds, C.tid, g, S, e); }
        __syncthreads();
        { const Ctx C = make_ctx(lds, wave_s); unsigned char* ws = fresh_ws(P); unsigned char* wl = ws + OFF_W + (size_t)l * SZ_WLAYER; pg8::StaticOrder S;
          pg8::Gemm g{(const bf16_t*)(ws + OFF_NQ), (const bf16_t*)(wl + WO_KN), RT, 512, 256, 384, 256}; S.init(g.M, g.N, C.G, C.bid);
          EpiKn e{(bf16_t*)(ws + OFF_K)}; pg8::gemm_phase(C.lds, C.tid, g, S, e); }
        __syncthreads();
        { const Ctx C = make_ctx(lds, wave_s); unsigned char* ws = fresh_ws(P); unsigned char* wl = ws + OFF_W + (size_t)l * SZ_WLAYER; pg8::StaticOrder S;
          pg8::Gemm g{(const bf16_t*)(wl + WO_V), (const bf16_t*)(ws + OFF_NQ), 512, RT, 256, 256, 384}; S.init(g.M, g.N, C.G, C.bid);
          EpiVT e{(bf16_t*)(ws + OFF_VT)}; pg8::gemm_phase(C.lds, C.tid, g, S, e); }
        __syncthreads();
        { const Ctx C = make_ctx(lds, wave_s); unsigned char* ws = fresh_ws(P); unsigned char* wl = ws + OFF_W + (size_t)l * SZ_WLAYER; pg8::StaticOrder S;
          pg8::Gemm g{(const bf16_t*)(ws + OFF_POOLA), (const bf16_t*)(wl + WO_POOL), Mrows, 256, 256, 256, 256}; S.init(g.M, g.N, C.G, C.bid);
          EpiBf16<0> e{(bf16_t*)(ws + OFF_POOLO), 256, 256}; pg8::gemm_phase(C.lds, C.tid, g, S, e); }
        GSYNC();
        { const Ctx C = make_ctx(lds, wave_s); phase_attn(P, C, l); }
        { const Ctx C = make_ctx(lds, wave_s); phase_hyena(P, C, l, 0); }
        GSYNC();
        { const Ctx C = make_ctx(lds, wave_s); phase_hyena(P, C, l, 1); }
        GSYNC();
        { const Ctx C = make_ctx(lds, wave_s); phase_merge(P, C, l); }
        GSYNC();
        { const Ctx C = make_ctx(lds, wave_s); unsigned char* ws = fresh_ws(P); unsigned char* wl = ws + OFF_W + (size_t)l * SZ_WLAYER; pg8::StaticOrder S;
          const float* modl = (const float*)(ws + OFF_MOD) + (size_t)l * 17 * 6144;
          pg8::Gemm g{(const bf16_t*)P.out, (const bf16_t*)(wl + WO_OUT), Mrows, 1024, 1024, 1024, 1024}; S.init(g.M, g.N, C.G, C.bid);
          if (l == 0) { EpiResid2<true, true> e{P.x, P.ctx, (bf16_t*)(ws + OFF_XR), modl + 2 * 1024, (bf16_t*)(ws + OFF_HBUF2), (float*)(ws + OFF_SS) + (size_t)1 * RT, P.g_mlp + l * 1024, modl + 4 * 1024};
            pg8::gemm_phase(C.lds, C.tid, g, S, e); }
          else { EpiResid2<false, true> e{nullptr, nullptr, (bf16_t*)(ws + OFF_XR), modl + 2 * 1024, (bf16_t*)(ws + OFF_HBUF2), (float*)(ws + OFF_SS) + (size_t)3 * RT, P.g_mlp + l * 1024, modl + 4 * 1024};
            pg8::gemm_phase(C.lds, C.tid, g, S, e); } }
        GSYNC();
        { const Ctx C = make_ctx(lds, wave_s); unsigned char* ws = fresh_ws(P); unsigned char* wl = ws + OFF_W + (size_t)l * SZ_WLAYER; pg8::StaticOrder S;
          pg8::Gemm g{(const bf16_t*)(ws + OFF_HBUF2), (const bf16_t*)(wl + WO_M1), Mrows, DFF, 1024, 1024, 1024}; S.init(g.M, g.N, C.G, C.bid);
          EpiNormBf16<1> e{(bf16_t*)(ws + OFF_ACT), DFF, DFF, (const float*)(ws + OFF_SS) + (size_t)(l == 0 ? 1 : 3) * RT, (const float*)(ws + OFF_SHW) + (size_t)(l * 2 + 1) * 17 * 4096};
          pg8::gemm_phase(C.lds, C.tid, g, S, e); }
        GSYNC();
        if (!last) {
          { const Ctx C = make_ctx(lds, wave_s); unsigned char* ws = fresh_ws(P); unsigned char* wl = ws + OFF_W + (size_t)l * SZ_WLAYER; pg8::StaticOrder S;
            const float* modl = (const float*)(ws + OFF_MOD) + (size_t)l * 17 * 6144; const float* modn = modl + (size_t)17 * 6144;
            pg8::Gemm g{(const bf16_t*)(ws + OFF_ACT), (const bf16_t*)(wl + WO_M2), RL, 1024, DFF, DFF, DFF}; S.init(g.M, g.N, C.G, C.bid);
            EpiResid2<false, true> e{nullptr, nullptr, (bf16_t*)(ws + OFF_XR), modl + 5 * 1024,
                             (bf16_t*)P.out, (float*)(ws + OFF_SS) + (size_t)2 * RT, P.g_mix + 1024, modn + 1 * 1024};
            pg8::gemm_phase(C.lds, C.tid, g, S, e); }
          __syncthreads();
          { const Ctx C = make_ctx(lds, wave_s); unsigned char* ws = fresh_ws(P); unsigned char* wl = ws + OFF_W + (size_t)l * SZ_WLAYER; pg8::StaticOrder S;
            pg8::Gemm g{(const bf16_t*)(ws + OFF_ACT) + (size_t)RL * DFF, (const bf16_t*)(wl + WO_M2), 4 * RC, 1024, 1024, DFF, DFF, 16, (size_t)1024 * 2}; S.init(g.M, g.N, C.G, C.bid);
            EpiPartial e{(float*)(ws + OFF_PART)};
            pg8::gemm_phase(C.lds, C.tid, g, S, e); }
          GSYNC();
          { const Ctx C = make_ctx(lds, wave_s); phase_ctxfin(P, C); }
        }
        else { const Ctx C = make_ctx(lds, wave_s); unsigned char* ws = fresh_ws(P); unsigned char* wl = ws + OFF_W + (size_t)l * SZ_WLAYER; pg8::StaticOrder S;
          const float* modl = (const float*)(ws + OFF_MOD) + (size_t)l * 17 * 6144;
          pg8::Gemm g{(const bf16_t*)(ws + OFF_ACT), (const bf16_t*)(wl + WO_M2), Mrows, 1024, DFF, DFF, DFF}; S.init(g.M, g.N, C.G, C.bid);
          EpiResid2<false, false> e{nullptr, nullptr, (bf16_t*)(ws + OFF_XR), modl + 5 * 1024, nullptr, nullptr, nullptr, nullptr};
          pg8::gemm_phase(C.lds, C.tid, g, S, e); }
        GSYNC();
    }
    { const Ctx C = make_ctx(lds, wave_s); phase_final(P, C); }
}

extern "C" void kernel_launch(void* const* d_in, const int* in_sizes, int n_in, void* d_out, int out_size, void* d_ws, size_t ws_size, hipStream_t stream) {
    static int grid = 0;
    if (grid == 0) {
        if (n_in != 30 || ws_size < WS_END) { fprintf(stderr, "kernel_launch: unexpected n_in %d / ws %zu (need %zu)\n", n_in, ws_size, (size_t)WS_END); grid = -1; return; }
        int dev = 0, cus = 0, per_cu = 0;
        (void)hipGetDevice(&dev);
        (void)hipDeviceGetAttribute(&cus, hipDeviceAttributeMultiprocessorCount, dev);
        if (hipFuncSetAttribute((const void*)mega_fwd, hipFuncAttributeMaxDynamicSharedMemorySize, LDS_BYTES) != hipSuccess) fprintf(stderr, "kernel_launch: hipFuncSetAttribute failed\n");
        if (hipOccupancyMaxActiveBlocksPerMultiprocessor(&per_cu, (const void*)mega_fwd, 512, LDS_BYTES) != hipSuccess || per_cu < 1) { fprintf(stderr, "kernel_launch: occupancy query gave %d\n", per_cu); per_cu = 1; }
        (void)hipGetLastError();
        grid = cus * 1;
    }
    if (grid < 0) return;
    Params p{};
    const float** pp = (const float**)&p;
    for (int i = 0; i < 30; ++i) pp[i] = (const float*)d_in[i];
    p.out = (float*)d_out; p.ws = (unsigned char*)d_ws;
    void* args[] = {&p};
    hipError_t e = hipLaunchCooperativeKernel((const void*)mega_fwd, dim3(grid), dim3(512), args, LDS_BYTES, stream);
    if (e != hipSuccess) fprintf(stderr, "cooperative launch failed: %s (grid %d)\n", hipGetErrorString(e), grid);
}
```

```cpp
#include <hip/hip_runtime.h>
#include <hip/hip_cooperative_groups.h>
#include <cstdio>
#include <cstdint>
namespace cg = cooperative_groups;

#define DI __device__ __forceinline__
#define LAS __attribute__((address_space(3)))
typedef unsigned short bf16_t;
typedef short bf16x8 __attribute__((ext_vector_type(8)));
typedef short s16x4 __attribute__((ext_vector_type(4)));
typedef float f32x4 __attribute__((ext_vector_type(4)));
typedef float f32x2 __attribute__((ext_vector_type(2)));
typedef float f32x16 __attribute__((ext_vector_type(16)));
typedef unsigned u32x4 __attribute__((ext_vector_type(4)));
typedef unsigned u32x2 __attribute__((ext_vector_type(2)));
typedef __bf16 bf16x2_t __attribute__((ext_vector_type(2)));

DI unsigned pk2(float lo, float hi) { f32x2 v = {lo, hi}; bf16x2_t b = __builtin_convertvector(v, bf16x2_t); return __builtin_bit_cast(unsigned, b); }
DI float bflo(unsigned w) { return __uint_as_float(w << 16); }
DI float bfhi(unsigned w) { return __uint_as_float(w & 0xffff0000u); }
DI float bf2f(bf16_t v) { return __uint_as_float(((unsigned)v) << 16); }
DI bf16_t f2bf(float f) { return (bf16_t)(pk2(f, 0.f) & 0xffffu); }
DI float xshfl(float v, int o, int lane) { return __int_as_float(__builtin_amdgcn_ds_bpermute((lane ^ o) << 2, __float_as_int(v))); }
DI float wave_sum(float v, int lane) {
#pragma unroll
    for (int o = 1; o < 64; o <<= 1) v += xshfl(v, o, lane);
    return v;
}
#define LDS_WAIT() asm volatile("s_waitcnt lgkmcnt(0)" ::: "memory")

constexpr int NB = 16, SEQ = 4096, CTXL = 256, DM = 1024, RL = NB * SEQ, RC = NB * CTXL, RT = RL + RC, NKEY = SEQ + CTXL;
constexpr int NIN = 1440, NINP = 1536, DFF = 4096;
constexpr int COL_KR = 128, COL_Q = 160, COL_POOL = 416, COL_HY = 672;
constexpr float EPS = 1e-6f;
constexpr float QSCALE = 0.10206207261596575f * 1.4426950408889634f;

constexpr size_t al256(size_t x) { return (x + 255) & ~(size_t)255; }
constexpr size_t SZ_WIN = (size_t)NINP * 1024 * 2, SZ_WQ = 768 * 256 * 2, SZ_WKN = 512 * 256 * 2, SZ_WV = 512 * 256 * 2, SZ_WPOOL = 256 * 256 * 2,
                 SZ_WOUT = 1024 * 1024 * 2, SZ_WM1 = (size_t)4096 * 1024 * 2, SZ_WM2 = (size_t)4096 * 1024 * 2;
constexpr size_t WO_IN = 0, WO_Q = WO_IN + SZ_WIN, WO_KN = WO_Q + SZ_WQ, WO_V = WO_KN + SZ_WKN, WO_POOL = WO_V + SZ_WV, WO_OUT = WO_POOL + SZ_WPOOL,
                 WO_M1 = WO_OUT + SZ_WOUT, WO_M2 = WO_M1 + SZ_WM1, SZ_WLAYER = WO_M2 + SZ_WM2;
constexpr size_t OFF_W = 0;
constexpr size_t OFF_MOD = al256(OFF_W + 2 * SZ_WLAYER);
constexpr size_t OFF_ROPE = al256(OFF_MOD + (size_t)2 * 17 * 6144 * 4);
constexpr size_t OFF_HL = al256(OFF_ROPE + 64 * 8 * 8);
constexpr size_t OFF_HC = al256(OFF_HL + (size_t)2 * 1024 * 4096 * 4);
constexpr size_t OFF_XC = al256(OFF_HC + (size_t)1024 * 256 * 4);
constexpr size_t OFF_XR = al256(OFF_XC + (size_t)RC * 1024 * 4);
constexpr size_t OFF_HBUF = OFF_XR;
constexpr size_t OFF_BIG = al256(OFF_HBUF + (size_t)RT * 1024 * 2);
constexpr size_t SZ_PROJ = (size_t)RT * NIN * 2, SZ_NQ = (size_t)RT * 384 * 2, SZ_R256 = (size_t)RT * 256 * 2;
constexpr size_t SZ_K = (size_t)NB * 8 * NKEY * 96 * 2, SZ_VT = (size_t)NB * 8 * 64 * NKEY * 2, SZ_XT = (size_t)256 * NB * NKEY * 2;
constexpr size_t SZ_QL = (size_t)NB * 8 * SEQ * 96 * 2, SZ_QC = (size_t)NB * 8 * CTXL * 96 * 2, SZ_ATT = (size_t)RT * 512 * 2;
constexpr size_t OFF_PROJ = OFF_BIG;
constexpr size_t OFF_QL = OFF_PROJ, OFF_QC = OFF_QL + SZ_QL, OFF_ATT = OFF_QC + SZ_QC;
static_assert(SZ_QL + SZ_QC + SZ_ATT <= SZ_PROJ, "overlay 1");
constexpr size_t OFF_NQ = al256(OFF_PROJ + SZ_PROJ);
constexpr size_t OFF_POOLA = OFF_NQ + SZ_NQ;
constexpr size_t OFF_ZT = OFF_NQ, OFF_HYT = OFF_ZT + SZ_XT;
static_assert(2 * SZ_XT <= SZ_NQ + SZ_R256, "overlay 2");
constexpr size_t OFF_K = al256(OFF_POOLA + SZ_R256);
constexpr size_t OFF_VT = al256(OFF_K + SZ_K);
constexpr size_t OFF_POOLO = al256(OFF_VT + SZ_VT);
constexpr size_t OFF_VXT = al256(OFF_POOLO + SZ_R256);
constexpr size_t OFF_BIG_END = al256(OFF_VXT + 3 * SZ_XT);
constexpr size_t OFF_ACT = OFF_BIG;
constexpr size_t SZ_ACT = (size_t)RT * DFF * 2;
static_assert(OFF_ACT + SZ_ACT <= OFF_BIG_END, "act overlay");
constexpr size_t OFF_HBUF2 = OFF_BIG_END;
constexpr size_t OFF_SS = al256(OFF_HBUF2 + (size_t)RT * 1024 * 2);
constexpr size_t OFF_SHW = al256(OFF_SS + (size_t)4 * RT * 4);
constexpr size_t OFF_BAR = al256(OFF_SHW + (size_t)2 * 2 * 17 * 4096 * 4);
constexpr size_t OFF_PART = al256(OFF_BAR + 3456 * 4);
constexpr size_t WS_END = al256(OFF_PART + (size_t)4 * RC * 1024 * 4);
static_assert(WS_END <= ((size_t)1 << 30), "workspace");

constexpr int LDS_BYTES = 131072 + 16;

struct Params {
    const float *x, *c, *ctx, *c_ctx, *w_mod, *b_mod, *g_mix, *g_mlp, *w_in, *g_q, *w_q_up, *g_kv, *w_kv_up, *pool_w, *pool_scale, *hy_conv_w, *hy_conv_b,
        *hy_f_w1, *hy_f_b1, *hy_f_freq1, *hy_f_w2, *hy_f_b2, *hy_f_freq2, *hy_f_w3, *hy_bias, *g_out, *w_out, *w_mlp1, *w_mlp2, *g_final;
    float* out; unsigned char* ws;
};

namespace pg8 {
#define PG8_LAS __attribute__((address_space(3)))
constexpr int BM = 256, BK = 64, HALF = 128, HTB = HALF * BK * 2, STAGE_BYTES = 8 * HTB, NXCD = 8, WGM = 8;
DI int lds_byte(int r, int c) { const int st = (r >> 4) * 2 + (c >> 5), rr = r & 15, cc = c & 31, ob = rr * 64 + cc * 2; return st * 1024 + (ob ^ (((ob >> 9) & 1) << 5)); }
DI void stage_rc(int b, int& R, int& C) { const int st = b / 1024, sb = b % 1024, swz = sb ^ (((sb >> 9) & 1) << 5); R = (st >> 1) * 16 + swz / 64; C = (st & 1) * 32 + (swz % 64) / 2; }
DI int perm32(int rho) { const int n = rho >> 4, i = rho & 15; return 8 * (i >> 2) + 4 * n + (i & 3); }
struct Unit { int pm, pn; };
struct Gemm { const bf16_t* A; const bf16_t* Bt; int M, N, K, lda, ldb; int mt; size_t kso; };
DI void unit_ptrs(const Gemm& g, const Unit& u, size_t tstepA, size_t tstepB, const char*& a, const char*& b) {
    int pm = u.pm; size_t ko = 0;
    if (g.mt) { const int ks = pm / g.mt; pm -= ks * g.mt; ko = (size_t)ks * g.kso; }
    a = (const char*)g.A + (size_t)pm * tstepA + ko; b = (const char*)g.Bt + (size_t)u.pn * tstepB + ko;
}
struct StaticOrder {
    int nM, nN, nwg, G, c;
    DI void init(int M, int N, int G_, int c_) { nM = M / BM; nN = N / BM; nwg = nM * nN; G = G_; c = c_; }
    DI bool next(int i, Unit& u) const {
        const long L = (long)i * G + c; if (L >= nwg) return false;
        int wgid = (int)L; { const int q = nwg / NXCD, r = nwg % NXCD, xcd = wgid % NXCD, off = wgid / NXCD; wgid = (xcd < r ? xcd * (q + 1) : r * (q + 1) + (xcd - r) * q) + off; }
        const int nig = WGM * nN, gid = wgid / nig, fm = gid * WGM, gsz = (nM - fm) < WGM ? (nM - fm) : WGM;
        u.pm = fm + ((wgid % nig) % gsz); u.pn = (wgid % nig) / gsz; return true;
    }
};
template <class Epi, bool ALIGN_EPI = true, bool SP2 = true>
DI void gemm_phase(PG8_LAS unsigned char* lds, const int tid, const Gemm g, const StaticOrder& S, const Epi& E) {
    const int wid = __builtin_amdgcn_readfirstlane(tid >> 6), lane = tid & 63, wr = wid >> 2, wc = wid & 3, fr = lane & 15, fq = lane >> 4;
    const int K = g.K, nt = K / BK;
    unsigned voffA[2], voffB[2];
#pragma unroll
    for (int i = 0; i < 2; ++i) { int R, C; stage_rc(tid * 16 + i * 8192, R, C); const int Rb = Epi::PERM ? ((R & ~31) + perm32(R & 31)) : R;
        voffA[i] = (unsigned)(R * g.lda + C) * 2u; voffB[i] = (unsigned)(Rb * g.ldb + C) * 2u; }
    const size_t kstep = (size_t)(BK * 2);
    const size_t hstepA = (size_t)HALF * g.lda * 2, hstepB = (size_t)HALF * g.ldb * 2;
    const size_t tstepA = 2 * hstepA, tstepB = 2 * hstepB;
    const unsigned ldsw = (unsigned)wid * 1024u;
    const int aoff = lds_byte(wr * 64 + fr, fq * 8), boff = lds_byte(wc * 32 + fr, fq * 8);
#define PG8_SA(b, h) (((b) * 2 + (h)) * HTB)
#define PG8_SB(b, h) ((4 + (b) * 2 + (h)) * HTB)
#define PG8_STAGE(bufoff, gbase, voff) do { _Pragma("unroll") for (int _i = 0; _i < 2; ++_i) \
        __builtin_amdgcn_global_load_lds((const unsigned*)((const char*)(gbase) + (voff)[_i]), (PG8_LAS unsigned*)(lds + (bufoff) + ldsw + _i * 8192), 16, 0, 0); } while (0)
#define PG8_LDA(dst, b, h) do { _Pragma("unroll") for (int m = 0; m < 4; ++m) _Pragma("unroll") for (int k = 0; k < 2; ++k) dst[m][k] = *(const PG8_LAS bf16x8*)(lds + PG8_SA(b, h) + aoff + m * 2048 + k * 1024); } while (0)
#define PG8_LDB(dst, b, h) do { _Pragma("unroll") for (int n = 0; n < 2; ++n) _Pragma("unroll") for (int k = 0; k < 2; ++k) dst[n][k] = *(const PG8_LAS bf16x8*)(lds + PG8_SB(b, h) + boff + n * 2048 + k * 1024); } while (0)
#define PG8_MMA(ai, bj, At, Bt) do { __builtin_amdgcn_s_setprio(1); _Pragma("unroll") for (int m = 0; m < 4; ++m) _Pragma("unroll") for (int n = 0; n < 2; ++n) _Pragma("unroll") for (int k = 0; k < 2; ++k) \
        acc[ai][bj][m][n] = __builtin_amdgcn_mfma_f32_16x16x32_bf16(Bt[n][k], At[m][k], acc[ai][bj][m][n], 0, 0, 0); __builtin_amdgcn_s_setprio(0); } while (0)
#define PG8_WAIT_V(n) asm volatile("s_waitcnt vmcnt(" #n ")" ::: "memory")
#define PG8_WAIT_L(n) asm volatile("s_waitcnt lgkmcnt(" #n ")" ::: "memory")
#define PG8_BAR __builtin_amdgcn_s_barrier()
#define PG8_SCHED __builtin_amdgcn_sched_barrier(0)
    Unit cur, nxt; int ui = 0;
    if (!S.next(0, cur)) return;
    f32x4 acc[2][2][4][2];
#pragma unroll
    for (int a = 0; a < 2; ++a)
#pragma unroll
        for (int b = 0; b < 2; ++b)
#pragma unroll
            for (int m = 0; m < 4; ++m)
#pragma unroll
                for (int n = 0; n < 2; ++n) acc[a][b][m][n] = (f32x4){0.f, 0.f, 0.f, 0.f};
    bf16x8 At[4][2], B0[2][2], B1[2][2];
    const char* cA; const char* cB; unit_ptrs(g, cur, tstepA, tstepB, cA, cB);
    if constexpr (SP2) {
        PG8_STAGE(PG8_SB(0, 0), cB, voffB); PG8_STAGE(PG8_SB(0, 1), cB + hstepB, voffB); PG8_STAGE(PG8_SA(0, 0), cA, voffA); PG8_STAGE(PG8_SA(0, 1), cA + hstepA, voffA);
        if (wr == 1) PG8_BAR;
        PG8_WAIT_V(2); PG8_BAR;
        PG8_STAGE(PG8_SB(1, 0), cB + kstep, voffB); PG8_STAGE(PG8_SA(1, 0), cA + kstep, voffA); PG8_STAGE(PG8_SB(1, 1), cB + hstepB + kstep, voffB);
        PG8_WAIT_V(6); PG8_BAR;
    } else {
        PG8_STAGE(PG8_SB(0, 0), cB, voffB); PG8_STAGE(PG8_SA(0, 0), cA, voffA); PG8_STAGE(PG8_SB(0, 1), cB + hstepB, voffB); PG8_STAGE(PG8_SA(0, 1), cA + hstepA, voffA);
        if (wr == 1) PG8_BAR;
        PG8_WAIT_V(4); PG8_BAR;
        PG8_STAGE(PG8_SB(1, 0), cB + kstep, voffB); PG8_STAGE(PG8_SA(1, 0), cA + kstep, voffA); PG8_STAGE(PG8_SB(1, 1), cB + hstepB + kstep, voffB);
        PG8_WAIT_V(6); PG8_BAR;
    }
    for (;;) {
        const bool has_next = S.next(ui + 1, nxt);
        const char* nA = cA; const char* nB = cB; if (has_next) unit_ptrs(g, nxt, tstepA, tstepB, nA, nB);
        for (int t = 0; t < nt; t += 2) {
            const bool last = (t == nt - 2);
            const char* a1 = cA + (size_t)(t + 1) * kstep;
            const char* a2 = last ? nA : cA + (size_t)(t + 2) * kstep; const char* b2 = last ? nB : cB + (size_t)(t + 2) * kstep;
            const char* a3 = a2 + kstep; const char* b3 = b2 + kstep;
            if constexpr (SP2) {
            PG8_LDB(B0, 0, 0); PG8_LDB(B1, 0, 1); PG8_SCHED; PG8_LDA(At, 0, 0); PG8_STAGE(PG8_SA(1, 1), a1 + hstepA, voffA);
            PG8_WAIT_V(8); PG8_WAIT_L(0); PG8_BAR; PG8_MMA(0, 0, At, B0); PG8_MMA(0, 1, At, B1); PG8_BAR; PG8_SCHED;
            PG8_LDA(At, 0, 1); PG8_STAGE(PG8_SB(0, 0), b2, voffB); PG8_STAGE(PG8_SB(0, 1), b2 + hstepB, voffB); PG8_STAGE(PG8_SA(0, 0), a2, voffA);
            PG8_WAIT_V(8); PG8_WAIT_L(0); PG8_BAR; PG8_MMA(1, 0, At, B0); PG8_MMA(1, 1, At, B1); PG8_BAR; PG8_SCHED;
            PG8_LDB(B0, 1, 0); PG8_LDB(B1, 1, 1); PG8_SCHED; PG8_LDA(At, 1, 0); PG8_STAGE(PG8_SA(0, 1), a2 + hstepA, voffA);
            PG8_WAIT_V(8); PG8_WAIT_L(0); PG8_BAR; PG8_MMA(0, 0, At, B0); PG8_MMA(0, 1, At, B1); PG8_BAR; PG8_SCHED;
            PG8_LDA(At, 1, 1); PG8_STAGE(PG8_SB(1, 0), b3, voffB); PG8_STAGE(PG8_SB(1, 1), b3 + hstepB, voffB); PG8_STAGE(PG8_SA(1, 0), a3, voffA);
            PG8_WAIT_V(8); PG8_WAIT_L(0); PG8_BAR; PG8_MMA(1, 0, At, B0); PG8_MMA(1, 1, At, B1); PG8_BAR; PG8_SCHED;
            } else {
            PG8_LDB(B0, 0, 0); PG8_SCHED; PG8_LDA(At, 0, 0); PG8_STAGE(PG8_SA(1, 1), a1 + hstepA, voffA);
            PG8_WAIT_L(8); PG8_BAR; PG8_WAIT_L(0); PG8_MMA(0, 0, At, B0); PG8_BAR; PG8_SCHED;
            PG8_LDB(B1, 0, 1); PG8_STAGE(PG8_SB(0, 0), b2, voffB);
            PG8_BAR; PG8_WAIT_L(0); PG8_MMA(0, 1, At, B1); PG8_BAR;
            PG8_LDA(At, 0, 1); PG8_STAGE(PG8_SA(0, 0), a2, voffA);
            PG8_BAR; PG8_WAIT_L(0); PG8_MMA(1, 0, At, B0); PG8_BAR; PG8_SCHED;
            PG8_STAGE(PG8_SB(0, 1), b2 + hstepB, voffB);
            PG8_WAIT_V(6); PG8_BAR; PG8_MMA(1, 1, At, B1); PG8_BAR;
            PG8_LDB(B0, 1, 0); PG8_SCHED; PG8_LDA(At, 1, 0); PG8_STAGE(PG8_SA(0, 1), a2 + hstepA, voffA);
            PG8_WAIT_L(8); PG8_BAR; PG8_WAIT_L(0); PG8_MMA(0, 0, At, B0); PG8_BAR; PG8_SCHED;
            PG8_LDB(B1, 1, 1); PG8_STAGE(PG8_SB(1, 0), b3, voffB);
            PG8_BAR; PG8_WAIT_L(0); PG8_MMA(0, 1, At, B1); PG8_BAR;
            PG8_LDA(At, 1, 1); PG8_STAGE(PG8_SA(1, 0), a3, voffA);
            PG8_BAR; PG8_WAIT_L(0); PG8_MMA(1, 0, At, B0); PG8_BAR; PG8_SCHED;
            PG8_STAGE(PG8_SB(1, 1), b3 + hstepB, voffB);
            PG8_WAIT_V(6); PG8_BAR; PG8_MMA(1, 1, At, B1); PG8_BAR;
            }
        }
        if constexpr (ALIGN_EPI) { if (wr == 0) PG8_BAR; }
        E(acc, cur, wr, wc, fr, fq);
        if (!has_next) break;
#pragma unroll
        for (int a = 0; a < 2; ++a)
#pragma unroll
            for (int b = 0; b < 2; ++b)
#pragma unroll
                for (int m = 0; m < 4; ++m)
#pragma unroll
                    for (int n = 0; n < 2; ++n) acc[a][b][m][n] = (f32x4){0.f, 0.f, 0.f, 0.f};
        cur = nxt; cA = nA; cB = nB; ++ui;
        if constexpr (ALIGN_EPI) { if (wr == 1) PG8_BAR; }
    }
    PG8_WAIT_V(0);
    if constexpr (!ALIGN_EPI) { if (wr == 0) PG8_BAR; }
    PG8_BAR;
#undef PG8_SA
#undef PG8_SB
#undef PG8_STAGE
#undef PG8_LDA
#undef PG8_LDB
#undef PG8_MMA
#undef PG8_WAIT_V
#undef PG8_WAIT_L
#undef PG8_BAR
#undef PG8_SCHED
}
}
using pg8::Unit;
typedef const f32x4 (&AccRef)[2][2][4][2];

template <int ACT> struct EpiBf16 {
    static constexpr bool PERM = true;
    bf16_t* O; int ldc, ncols;
    DI void operator()(AccRef acc, const Unit& u, int wr, int wc, int fr_, int fq_) const {
        int fr = fr_, fq = fq_; asm volatile("" : "+v"(fr), "+v"(fq));
        const int row0 = u.pm * 256 + wr * 64 + fr, col0 = u.pn * 256 + wc * 32 + 8 * fq;
#pragma unroll
        for (int ai = 0; ai < 2; ++ai)
#pragma unroll
            for (int m = 0; m < 4; ++m) { bf16_t* rowp = O + (size_t)(row0 + ai * 128 + m * 16) * ldc + col0;
#pragma unroll
                for (int bj = 0; bj < 2; ++bj) { f32x4 v0 = acc[ai][bj][m][0], v1 = acc[ai][bj][m][1];
                    if (ACT == 1) {
#pragma unroll
                        for (int j = 0; j < 4; ++j) { const float a = fmaxf(v0[j], 0.f), b = fmaxf(v1[j], 0.f); v0[j] = a * a; v1[j] = b * b; } }
                    u32x4 w; w.x = pk2(v0[0], v0[1]); w.y = pk2(v0[2], v0[3]); w.z = pk2(v1[0], v1[1]); w.w = pk2(v1[2], v1[3]);
                    if (col0 + bj * 128 < ncols) *(u32x4*)(rowp + bj * 128) = w; } }
    }
};
template <bool FUSE> struct EpiResid {
    static constexpr bool PERM = false;
    const float* srcL; float* dstL; const float* srcC; float* dstC; const float* gate;
    bf16_t* A2; float* ss; const float* gain; const float* scl;
    DI void operator()(AccRef acc, const Unit& u, int wr, int wc, int fr_, int fq_) const {
        int fr = fr_, fq = fq_; asm volatile("" : "+v"(fr), "+v"(fq));
        const int row0 = u.pm * 256 + wr * 64 + fr, col0 = u.pn * 256 + wc * 32 + 4 * fq, ln = fq * 16 + fr;
        const bool isctx = (u.pm * 256) >= RL;
        const int mrt = isctx ? 16 : ((u.pm * 256) >> 12);
        const float* sbase = isctx ? srcC - (size_t)RL * 1024 : srcL; float* dbase = isctx ? dstC - (size_t)RL * 1024 : dstL;
        const float* gp = gate + (size_t)mrt * 6144;
        f32x4 gv[2][2], gs[2][2];
#pragma unroll
        for (int bj = 0; bj < 2; ++bj)
#pragma unroll
            for (int n = 0; n < 2; ++n) { const int c = col0 + bj * 128 + n * 16; gv[bj][n] = *(const f32x4*)(gp + c);
                if (FUSE) gs[bj][n] = *(const f32x4*)(gain + c) * (*(const f32x4*)(scl + (size_t)mrt * 6144 + c) + 1.0f); }
#pragma unroll
        for (int ai = 0; ai < 2; ++ai)
#pragma unroll
          for (int mp = 0; mp < 2; ++mp) {
            f32x4 xv[2][2][2];
#pragma unroll
            for (int mm = 0; mm < 2; ++mm)
#pragma unroll
                for (int bj = 0; bj < 2; ++bj)
#pragma unroll
                    for (int n = 0; n < 2; ++n) xv[mm][bj][n] = *(const f32x4*)(sbase + (size_t)(row0 + ai * 128 + (2 * mp + mm) * 16) * 1024 + col0 + bj * 128 + n * 16);
#pragma unroll
            for (int mm = 0; mm < 2; ++mm) { const int m = 2 * mp + mm; const int r = row0 + ai * 128 + m * 16;
                float part = 0.f;
#pragma unroll
                for (int bj = 0; bj < 2; ++bj)
#pragma unroll
                    for (int n = 0; n < 2; ++n) { const int c = col0 + bj * 128 + n * 16;
                        const f32x4 xn = xv[mm][bj][n] + gv[bj][n] * acc[ai][bj][m][n];
                        *(f32x4*)(dbase + (size_t)r * 1024 + c) = xn;
                        if (FUSE) { const f32x4 an = xn * gs[bj][n]; u32x2 w; w.x = pk2(an[0], an[1]); w.y = pk2(an[2], an[3]); *(u32x2*)(A2 + (size_t)r * 1024 + c) = w;
                            part += (xn[0] * xn[0] + xn[1] * xn[1]) + (xn[2] * xn[2] + xn[3] * xn[3]); } }
                if (FUSE) { part += xshfl(part, 16, ln); part += xshfl(part, 32, ln);
                    if (fq == 0) (void)__hip_atomic_fetch_add((__attribute__((address_space(1))) float*)(ss + r), part, __ATOMIC_RELAXED, __HIP_MEMORY_SCOPE_AGENT); } }
          }
    }
};
template <bool SRC_F32, bool FUSE> struct EpiResid2 {
    static constexpr bool PERM = true;
    const float* srcL; const float* srcC; bf16_t* xr; const float* gate;
    bf16_t* A2; float* ss; const float* gain; const float* scl;
    DI void operator()(AccRef acc, const Unit& u, int wr, int wc, int fr_, int fq_) const {
        int fr = fr_, fq = fq_; asm volatile("" : "+v"(fr), "+v"(fq));
        typedef __attribute__((address_space(1))) float gfloat; typedef __attribute__((address_space(1))) unsigned short gbf16;
        typedef __attribute__((address_space(1))) f32x4 gf32x4; typedef __attribute__((address_space(1))) u32x4 gu32x4;
        const int row0 = u.pm * 256 + wr * 64 + fr, col0 = u.pn * 256 + wc * 32 + 8 * fq, ln = fq * 16 + fr;
        const bool isctx = (u.pm * 256) >= RL;
        const int mrt = isctx ? 16 : ((u.pm * 256) >> 12);
        const gfloat* __restrict__ sbase = (const gfloat*)(isctx ? srcC - (size_t)RL * 1024 : srcL);
        gbf16* __restrict__ xb = (gbf16*)xr; gbf16* __restrict__ a2 = (gbf16*)A2;
        const gfloat* __restrict__ gp = (const gfloat*)(gate + (size_t)mrt * 6144);
        f32x4 gv[2][2], gs[2][2];
#pragma unroll
        for (int bj = 0; bj < 2; ++bj)
#pragma unroll
            for (int hf = 0; hf < 2; ++hf) { const int c = col0 + bj * 128 + 4 * hf; gv[bj][hf] = *(const gf32x4*)(gp + c);
                if (FUSE) gs[bj][hf] = *(const gf32x4*)((const gfloat*)gain + c) * (*(const gf32x4*)((const gfloat*)scl + (size_t)mrt * 6144 + c) + 1.0f); }
#pragma unroll
        for (int ai = 0; ai < 2; ++ai) {
            constexpr int NB_ = SRC_F32 ? 2 : 1, RB_ = SRC_F32 ? 2 : 4;
#pragma unroll
          for (int mp = 0; mp < NB_; ++mp) {
            f32x4 xf[SRC_F32 ? 2 : 1][2][2]; u32x4 xw[SRC_F32 ? 1 : 4][2];
#pragma unroll
            for (int mm = 0; mm < RB_; ++mm)
#pragma unroll
                for (int bj = 0; bj < 2; ++bj) { const size_t off = (size_t)(row0 + ai * 128 + (RB_ * mp + mm) * 16) * 1024 + col0 + bj * 128;
                    if (SRC_F32) { xf[mm][bj][0] = *(const gf32x4*)(sbase + off); xf[mm][bj][1] = *(const gf32x4*)(sbase + off + 4); }
                    else xw[mm][bj] = *(const gu32x4*)(xb + off); }
#pragma unroll
            for (int mm = 0; mm < RB_; ++mm) { const int m = RB_ * mp + mm; const int r = row0 + ai * 128 + m * 16;
                float part = 0.f;
#pragma unroll
                for (int bj = 0; bj < 2; ++bj) { const size_t off = (size_t)r * 1024 + col0 + bj * 128;
                    f32x4 x0, x1;
                    if (SRC_F32) { x0 = xf[mm][bj][0]; x1 = xf[mm][bj][1]; }
                    else { const u32x4 w = xw[mm][bj]; x0 = (f32x4){bflo(w.x), bfhi(w.x), bflo(w.y), bfhi(w.y)}; x1 = (f32x4){bflo(w.z), bfhi(w.z), bflo(w.w), bfhi(w.w)}; }
                    const f32x4 n0 = x0 + gv[bj][0] * acc[ai][bj][m][0], n1 = x1 + gv[bj][1] * acc[ai][bj][m][1];
                    u32x4 o; o.x = pk2(n0[0], n0[1]); o.y = pk2(n0[2], n0[3]); o.z = pk2(n1[0], n1[1]); o.w = pk2(n1[2], n1[3]);
                    *(gu32x4*)(xb + off) = o;
                    if (FUSE) { const f32x4 a0 = n0 * gs[bj][0], a1 = n1 * gs[bj][1];
                        u32x4 w2; w2.x = pk2(a0[0], a0[1]); w2.y = pk2(a0[2], a0[3]); w2.z = pk2(a1[0], a1[1]); w2.w = pk2(a1[2], a1[3]);
                        *(gu32x4*)(a2 + off) = w2;
                        part += ((n0[0] * n0[0] + n0[1] * n0[1]) + (n0[2] * n0[2] + n0[3] * n0[3])) + ((n1[0] * n1[0] + n1[1] * n1[1]) + (n1[2] * n1[2] + n1[3] * n1[3])); } }
                if (FUSE) { part += xshfl(part, 16, ln); part += xshfl(part, 32, ln);
                    if (fq == 0) (void)__hip_atomic_fetch_add((__attribute__((address_space(1))) float*)(ss + r), part, __ATOMIC_RELAXED, __HIP_MEMORY_SCOPE_AGENT); } }
          }
        }
    }
};
template <int ACT> struct EpiNormBf16 {
    static constexpr bool PERM = true;
    bf16_t* O; int ldc, ncols; const float* ss; const float* shw;
    DI void operator()(AccRef acc, const Unit& u, int wr, int wc, int fr_, int fq_) const {
        int fr = fr_, fq = fq_; asm volatile("" : "+v"(fr), "+v"(fq));
        const int row0 = u.pm * 256 + wr * 64 + fr, col0 = u.pn * 256 + wc * 32 + 8 * fq;
        const int mrt = (u.pm * 256 < RL) ? ((u.pm * 256) >> 12) : 16;
        f32x4 sv[2][2];
#pragma unroll
        for (int bj = 0; bj < 2; ++bj) { sv[bj][0] = *(const f32x4*)(shw + (size_t)mrt * 4096 + col0 + bj * 128); sv[bj][1] = *(const f32x4*)(shw + (size_t)mrt * 4096 + col0 + bj * 128 + 4); }
#pragma unroll
        for (int ai = 0; ai < 2; ++ai)
#pragma unroll
            for (int m = 0; m < 4; ++m) { const int r = row0 + ai * 128 + m * 16; bf16_t* rowp = O + (size_t)r * ldc + col0;
                const float rs = rsqrtf(ss[r] * (1.f / 1024.f) + EPS);
#pragma unroll
                for (int bj = 0; bj < 2; ++bj) { f32x4 v0 = acc[ai][bj][m][0] * rs + sv[bj][0], v1 = acc[ai][bj][m][1] * rs + sv[bj][1];
                    if (ACT == 1) {
#pragma unroll
                        for (int jx = 0; jx < 4; ++jx) { const float a = fmaxf(v0[jx], 0.f), b = fmaxf(v1[jx], 0.f); v0[jx] = a * a; v1[jx] = b * b; } }
                    u32x4 w; w.x = pk2(v0[0], v0[1]); w.y = pk2(v0[2], v0[3]); w.z = pk2(v1[0], v1[1]); w.w = pk2(v1[2], v1[3]);
                    if (col0 + bj * 128 < ncols) *(u32x4*)(rowp + bj * 128) = w; } }
    }
};
struct EpiPartial {
    static constexpr bool PERM = false;
    float* part;
    DI void operator()(AccRef acc, const Unit& u, int wr, int wc, int fr_, int fq_) const {
        int fr = fr_, fq = fq_; asm volatile("" : "+v"(fr), "+v"(fq));
        const int ks = u.pm >> 4, pm = u.pm & 15;
        const int row0 = pm * 256 + wr * 64 + fr, col0 = u.pn * 256 + wc * 32 + 4 * fq;
        float* base = part + ((size_t)ks * RC + row0) * 1024 + col0;
#pragma unroll
        for (int ai = 0; ai < 2; ++ai)
#pragma unroll
            for (int m = 0; m < 4; ++m)
#pragma unroll
                for (int bj = 0; bj < 2; ++bj)
#pragma unroll
                    for (int n = 0; n < 2; ++n) *(f32x4*)(base + (size_t)(ai * 128 + m * 16) * 1024 + bj * 128 + n * 16) = acc[ai][bj][m][n];
    }
};
struct EpiQ {
    static constexpr bool PERM = false;
    bf16_t* QL; bf16_t* QC; const f32x2* rope;
    DI void operator()(AccRef acc, const Unit& u, int wr, int wc, int fr_, int fq_) const {
        int fr = fr_, fq = fq_; asm volatile("" : "+v"(fr), "+v"(fq));
        const int row0 = u.pm * 256 + wr * 64 + fr, colb = u.pn * 256 + wc * 32;
        const bool isctx = (u.pm * 256) >= RL;
#pragma unroll
        for (int ai = 0; ai < 2; ++ai)
#pragma unroll
            for (int m = 0; m < 4; ++m) { const int r = row0 + ai * 128 + m * 16;
                int b, t; bf16_t* qb;
                if (!isctx) { b = r >> 12; t = r & 4095; qb = QL + ((size_t)b * 8 * SEQ + t) * 96; }
                else { const int rc = r - RL; b = rc >> 8; t = rc & 255; qb = QC + ((size_t)b * 8 * CTXL + t) * 96; }
                const size_t hstride = (size_t)(isctx ? CTXL : SEQ) * 96;
#pragma unroll
                for (int bj = 0; bj < 2; ++bj)
#pragma unroll
                    for (int n = 0; n < 2; ++n) { const int cg0 = colb + bj * 128 + n * 16;
                        const int h = cg0 / 96, cc0 = cg0 - h * 96;
                        f32x4 v = acc[ai][bj][m][n];
                        const int ln = fq * 16 + fr; f32x4 pv; pv[0] = xshfl(v[0], 32, ln); pv[1] = xshfl(v[1], 32, ln); pv[2] = xshfl(v[2], 32, ln); pv[3] = xshfl(v[3], 32, ln);
                        if (cc0 >= 64 && !isctx) { const int axis = (cc0 - 64) >> 4, half = fq >> 1, f0 = 4 * (fq & 1); const int p = axis ? (t & 63) : (t >> 6);
#pragma unroll
                            for (int i = 0; i < 4; ++i) { const f32x2 cs = rope[p * 8 + f0 + i]; v[i] = half ? (v[i] * cs.x + pv[i] * cs.y) : (v[i] * cs.x - pv[i] * cs.y); } }
                        u32x2 w; w.x = pk2(v[0] * QSCALE, v[1] * QSCALE); w.y = pk2(v[2] * QSCALE, v[3] * QSCALE);
                        *(u32x2*)(qb + (size_t)h * hstride + cc0 + 4 * fq) = w; } }
    }
};
struct EpiKn {
    static constexpr bool PERM = true;
    bf16_t* Kb;
    DI void operator()(AccRef acc, const Unit& u, int wr, int wc, int fr_, int fq_) const {
        int fr = fr_, fq = fq_; asm volatile("" : "+v"(fr), "+v"(fq));
        const int row0 = u.pm * 256 + wr * 64 + fr, col0 = u.pn * 256 + wc * 32 + 8 * fq;
#pragma unroll
        for (int ai = 0; ai < 2; ++ai)
#pragma unroll
            for (int m = 0; m < 4; ++m) { const int r = row0 + ai * 128 + m * 16; int b, pos;
                if (r < RL) { b = r >> 12; pos = CTXL + (r & 4095); } else { const int rc = r - RL; b = rc >> 8; pos = rc & 255; }
#pragma unroll
                for (int bj = 0; bj < 2; ++bj) { const int c = col0 + bj * 128, h = c >> 6, j = c & 63;
                    const f32x4 v0 = acc[ai][bj][m][0], v1 = acc[ai][bj][m][1];
                    u32x4 w; w.x = pk2(v0[0], v0[1]); w.y = pk2(v0[2], v0[3]); w.z = pk2(v1[0], v1[1]); w.w = pk2(v1[2], v1[3]);
                    *(u32x4*)(Kb + ((size_t)(b * 8 + h) * NKEY + pos) * 96 + j) = w; } }
    }
};
struct EpiVT {
    static constexpr bool PERM = true;
    bf16_t* VT;
    DI void operator()(AccRef acc, const Unit& u, int wr, int wc, int fr_, int fq_) const {
        int fr = fr_, fq = fq_; asm volatile("" : "+v"(fr), "+v"(fq));
        const int row0 = u.pm * 256 + wr * 64 + fr, col0 = u.pn * 256 + wc * 32 + 8 * fq;
#pragma unroll
        for (int ai = 0; ai < 2; ++ai)
#pragma unroll
            for (int m = 0; m < 4; ++m) { const int f = row0 + ai * 128 + m * 16, h = f >> 6, dv = f & 63;
#pragma unroll
                for (int bj = 0; bj < 2; ++bj) { const int r = col0 + bj * 128; int b, pos;
                    if (r < RL) { b = r >> 12; pos = CTXL + (r & 4095); } else { const int rc = r - RL; b = rc >> 8; pos = rc & 255; }
                    const f32x4 v0 = acc[ai][bj][m][0], v1 = acc[ai][bj][m][1];
                    const int a = (pos >> 3) & 1; bf16_t* vp = VT + ((size_t)(b * 8 + h) * 64 + dv) * NKEY + (pos & ~15) + 4 * a;
                    u32x2 wl, wh; wl.x = pk2(v0[0], v0[1]); wl.y = pk2(v0[2], v0[3]); wh.x = pk2(v1[0], v1[1]); wh.y = pk2(v1[2], v1[3]);
                    *(u32x2*)vp = wl; *(u32x2*)(vp + 8) = wh; } }
    }
};

#define XB_TMO      128
#define XB_XCNT(j)  (256  + 64 * (j))
#define XB_XSUB(j)  (1280 + 64 * (j))
#define XB_XGEN(j)  (2304 + 64 * (j))
#define XB_TOP      3328
#define XB_TOPGEN   3392
#define XCD_BAR_WORDS 3456
#define XB_SPIN_CAP (1u << 22)
DI unsigned xb_ld(unsigned* p)              { return __hip_atomic_load(p, __ATOMIC_RELAXED, __HIP_MEMORY_SCOPE_AGENT); }
DI unsigned xb_add(unsigned* p, unsigned v) { return __hip_atomic_fetch_add(p, v, __ATOMIC_RELAXED, __HIP_MEMORY_SCOPE_AGENT); }
DI unsigned xb_xcc_id() { return (unsigned)__builtin_amdgcn_s_getreg((3 << 11) | 20) & 0xFu; }
#define XB_SPIN(cond, bar) do { unsigned _sp = 0; while (cond) { __builtin_amdgcn_s_sleep(1); \
    if ((++_sp & 255u) == 0u) { if (xb_ld(&(bar)[XB_TMO])) break; if (_sp > XB_SPIN_CAP) { atomicAdd(&(bar)[XB_TMO], 1u); break; } } } } while (0)
DI void xcd_barrier_post(unsigned* bar, bool t0) { if (t0) (void)xb_add(&bar[XB_XCNT(xb_xcc_id())], 1u); }
DI void xcd_barrier_complete(unsigned* bar, unsigned x, unsigned& nloc, unsigned& nx) {
    const unsigned G = gridDim.x;
    unsigned sum, cnt, mine, sp = 0u;
    for (;;) {
        sum = 0u; cnt = 0u; mine = 0u;
#pragma unroll
        for (unsigned j = 0; j < 16; ++j) { const unsigned c = xb_ld(&bar[XB_XCNT(j)]); sum += c; cnt += (c > 0u) ? 1u : 0u; mine = (j == x) ? c : mine; }
        if (sum == G) break;
        __builtin_amdgcn_s_sleep(1);
        if ((++sp & 255u) == 0u) { if (xb_ld(&bar[XB_TMO])) break; if (sp > XB_SPIN_CAP) { atomicAdd(&bar[XB_TMO], 1u); break; } }
    }
    nloc = mine > 0u ? mine : 1u; nx = cnt > 0u ? cnt : 1u;
}
DI void xcd_barrier(unsigned* bar, volatile LAS unsigned* st, bool t0) {
    asm volatile("s_waitcnt vmcnt(0)" ::: "memory");
    __syncthreads();
    if (t0) {
        const unsigned x = xb_xcc_id();
        __builtin_amdgcn_s_waitcnt(0);
        unsigned nloc = st[0], nx = st[1];
        if (nloc == 0u) { xcd_barrier_complete(bar, x, nloc, nx); st[0] = nloc; st[1] = nx; }
        const unsigned old = xb_add(&bar[XB_XSUB(x)], 1u);
        const unsigned gen = old / nloc;
        if (old + 1u == (gen + 1u) * nloc) {
            __builtin_amdgcn_fence(__ATOMIC_RELEASE, "agent");
            asm volatile("s_waitcnt vmcnt(0)" ::: "memory");
            const unsigned og = xb_add(&bar[XB_TOP], 1u);
            const unsigned tg = og / nx;
            if (og + 1u == (tg + 1u) * nx) xb_add(&bar[XB_TOPGEN], 1u);
            else XB_SPIN(xb_ld(&bar[XB_TOPGEN]) == tg, bar);
            __builtin_amdgcn_fence(__ATOMIC_ACQUIRE, "agent");
            xb_add(&bar[XB_XGEN(x)], 1u);
            asm volatile("s_waitcnt vmcnt(0)" ::: "memory");
        } else {
            XB_SPIN(xb_ld(&bar[XB_XGEN(x)]) == gen, bar);
            __builtin_amdgcn_fence(__ATOMIC_ACQUIRE, "agent");
            asm volatile("s_waitcnt vmcnt(0)" ::: "memory");
        }
    }
    __syncthreads();
}

struct Ctx {
    LAS unsigned char* lds; int tid, lane, wave, G, bid;
};

DI void transpose_item(const float* W, int ldw, int k0, int n0, bf16_t* WT, int ldt, int orow0, LAS float* scr, int lane) {
#pragma unroll 8
    for (int i = 0; i < 32; ++i) { const int kk = 2 * i + (lane >> 5); scr[kk * 33 + (lane & 31)] = W[(size_t)(k0 + kk) * ldw + n0 + (lane & 31)]; }
    LDS_WAIT();
    const int c = lane & 7;
#pragma unroll
    for (int j = 0; j < 4; ++j) { const int n = (lane >> 3) + 8 * j; const LAS float* s = scr + (8 * c) * 33 + n;
        u32x4 o; o.x = pk2(s[0 * 33], s[1 * 33]); o.y = pk2(s[2 * 33], s[3 * 33]); o.z = pk2(s[4 * 33], s[5 * 33]); o.w = pk2(s[6 * 33], s[7 * 33]);
        *(u32x4*)(WT + (size_t)(orow0 + n) * ldt + k0 + 8 * c) = o; }
    LDS_WAIT();
}

DI void setup_adaln(const Params& P, const Ctx& C, int u) {
    const int l = u / 96, j0 = (u % 96) * 64;
    LAS float* sl = (LAS float*)C.lds;
    LAS float* part = sl + 17 * 1024;
    for (int idx = C.tid; idx < 17 * 1024; idx += 512) { const int r = idx >> 10, k = idx & 1023; const float v = (r < 16) ? P.c[r * 1024 + k] : P.c_ctx[k]; sl[idx] = v / (1.f + expf(-v)); }
    __syncthreads();
    const int ks = C.tid >> 6, jj = C.tid & 63;
    float acc[17];
#pragma unroll
    for (int r = 0; r < 17; ++r) acc[r] = 0.f;
    const float* wp = P.w_mod + ((size_t)l * 1024 + ks * 128) * 6144 + j0 + jj;
    for (int k = 0; k < 128; ++k) { const float w = wp[(size_t)k * 6144];
#pragma unroll
        for (int r = 0; r < 17; ++r) acc[r] += sl[r * 1024 + ks * 128 + k] * w; }
#pragma unroll
    for (int r = 0; r < 17; ++r) part[(ks * 17 + r) * 64 + jj] = acc[r];
    __syncthreads();
    float* mod = (float*)(P.ws + OFF_MOD);
    for (int idx = C.tid; idx < 17 * 64; idx += 512) { const int r = idx >> 6, j2 = idx & 63; float s = 0.f;
#pragma unroll
        for (int q = 0; q < 8; ++q) s += part[(q * 17 + r) * 64 + j2];
        mod[((size_t)l * 17 + r) * 6144 + j0 + j2] = s + P.b_mod[l * 6144 + j0 + j2]; }
    __syncthreads();
}

DI void setup_filter(const Params& P, const Ctx& C, int l, int n, int d0, float* H) {
    LAS float* zs = (LAS float*)C.lds;
    LAS float* h1s = zs + 16 * 33;
    LAS float* h2s = h1s + 16 * 64;
    for (int idx = C.tid; idx < 16 * 33; idx += 512) { const int p = idx / 33, e = idx - p * 33; const int d = d0 + p; float v;
        if (e == 0) v = (float)d / (float)(n - 1);
        else { const int k = (e - 1) & 15; const float fr = 1e-4f + (float)k * ((15.0f - 1e-4f) / 15.0f); const float wp = 6.283185307179586f * (float)d / (float)n; const float ang = fr * wp;
            v = (e <= 16) ? cosf(ang) : -sinf(ang); }
        zs[idx] = v; }
    __syncthreads();
    for (int idx = C.tid; idx < 1024; idx += 512) { const int p = idx >> 6, m = idx & 63; float s = P.hy_f_b1[l * 64 + m];
        for (int e = 0; e < 33; ++e) s += zs[p * 33 + e] * P.hy_f_w1[(l * 33 + e) * 64 + m];
        h1s[idx] = sinf(P.hy_f_freq1[l * 64 + m] * s); }
    __syncthreads();
    for (int idx = C.tid; idx < 1024; idx += 512) { const int p = idx >> 6, m = idx & 63; float s = P.hy_f_b2[l * 64 + m];
        for (int e = 0; e < 64; ++e) s += h1s[p * 64 + e] * P.hy_f_w2[(l * 64 + e) * 64 + m];
        h2s[idx] = sinf(P.hy_f_freq2[l * 64 + m] * s); }
    __syncthreads();
    const float la = -3.0701134573253946f, lb = -15.350567286626973f;
#pragma unroll 1
    for (int cc = 0; cc < 2; ++cc) { const int col = C.tid + 512 * cc;
        float acc[16];
#pragma unroll
        for (int p = 0; p < 16; ++p) acc[p] = 0.f;
        for (int e = 0; e < 64; ++e) { const float w = P.hy_f_w3[((size_t)l * 64 + e) * 1024 + col];
#pragma unroll
            for (int p = 0; p < 16; ++p) acc[p] += h2s[p * 64 + e] * w; }
        const int ch = col & 255; const float delta = fabsf(la + (float)ch * ((lb - la) / 255.0f));
        float* hp = H + (size_t)col * n + d0;
#pragma unroll
        for (int q = 0; q < 4; ++q) { f32x4 o;
#pragma unroll
            for (int i = 0; i < 4; ++i) { const int p = 4 * q + i; const float td = (float)(d0 + p) / (float)(n - 1); o[i] = acc[p] * expf(-td * delta); }
            *(f32x4*)(hp + 4 * q) = o; } }
    __syncthreads();
}

DI void phase_setup(const Params& P, const Ctx& C) {
    unsigned char* ws = P.ws;
    for (int u = C.bid; u < 192 + 512 + 16; u += C.G) {
        if (u < 192) setup_adaln(P, C, u);
        else if (u < 192 + 512) { const int v = u - 192, l = v >> 8, blk = v & 255; setup_filter(P, C, l, SEQ, blk * 16, (float*)(ws + OFF_HL) + (size_t)l * 1024 * 4096); }
        else { const int blk = u - 192 - 512; setup_filter(P, C, 0, CTXL, blk * 16, (float*)(ws + OFF_HC)); }
    }
    if (C.bid == 0) { f32x2* rt = (f32x2*)(ws + OFF_ROPE); const int p = C.tid >> 3, f = C.tid & 7; const float inv = exp2f(-(float)f * (13.287712379549449f / 8.0f)); const float a = (float)p * inv; rt[C.tid] = (f32x2){cosf(a), sinf(a)}; }
    LAS float* scr = (LAS float*)(C.lds + C.wave * 8448);
    const int gw = C.bid * 8 + C.wave, NGW = C.G * 8;
    constexpr int I_IN = 16 * 45, I_Q = 4 * 24, I_KV = 2 * 32, I_OUT = 16 * 32, I_M1 = 16 * 128, I_M2 = 64 * 32, I_L = I_IN + I_Q + I_KV + I_OUT + I_M1 + I_M2;
    for (int it = gw; it < 2 * I_L; it += NGW) {
        const int l = it / I_L; int r = it - l * I_L; unsigned char* wl = ws + OFF_W + (size_t)l * SZ_WLAYER;
        if (r < I_IN) { const int kb = r / 45, nb = r % 45; transpose_item(P.w_in + (size_t)l * 1024 * NIN, NIN, kb * 64, nb * 32, (bf16_t*)(wl + WO_IN), 1024, nb * 32, scr, C.lane); continue; } r -= I_IN;
        if (r < I_Q) { const int kb = r / 24, nb = r % 24; transpose_item(P.w_q_up + (size_t)l * 256 * 768, 768, kb * 64, nb * 32, (bf16_t*)(wl + WO_Q), 256, nb * 32, scr, C.lane); continue; } r -= I_Q;
        if (r < I_KV) { const int kb = r / 32, nb = r % 32, n0 = nb * 32, h = n0 >> 7, j0 = n0 & 127;
            bf16_t* dst = (bf16_t*)(wl + (j0 < 64 ? WO_KN : WO_V)); const int orow = h * 64 + (j0 & 63);
            transpose_item(P.w_kv_up + (size_t)l * 128 * 1024, 1024, kb * 64, n0, dst, 256, orow, scr, C.lane); continue; } r -= I_KV;
        if (r < I_OUT) { const int kb = r / 32, nb = r % 32; transpose_item(P.w_out + (size_t)l * 1024 * 1024, 1024, kb * 64, nb * 32, (bf16_t*)(wl + WO_OUT), 1024, nb * 32, scr, C.lane); continue; } r -= I_OUT;
        if (r < I_M1) { const int kb = r / 128, nb = r % 128; transpose_item(P.w_mlp1 + (size_t)l * 1024 * 4096, 4096, kb * 64, nb * 32, (bf16_t*)(wl + WO_M1), 1024, nb * 32, scr, C.lane); continue; } r -= I_M1;
        { const int kb = r / 32, nb = r % 32; transpose_item(P.w_mlp2 + (size_t)l * 4096 * 1024, 1024, kb * 64, nb * 32, (bf16_t*)(wl + WO_M2), 4096, nb * 32, scr, C.lane); }
    }
    const size_t gt = (size_t)C.bid * 512 + C.tid, NGT = (size_t)C.G * 512;
    for (size_t i = gt; i < (size_t)3 * RT; i += NGT) ((float*)(ws + OFF_SS))[RT + i] = 0.f;
    for (int l = 0; l < 2; ++l) { unsigned char* wl = ws + OFF_W + (size_t)l * SZ_WLAYER;
        for (size_t i = gt; i < 12288; i += NGT) *(u32x4*)(wl + WO_IN + (size_t)NIN * 2048 + i * 16) = (u32x4){0u, 0u, 0u, 0u};
        for (size_t i = gt; i < 2 * 512 * 16; i += NGT) { const size_t w = i / (512 * 16), rr = (i / 16) % 512, ch = i % 16;
            *(u32x4*)(wl + (w ? WO_V : WO_KN) + rr * 512 + 256 + ch * 16) = (u32x4){0u, 0u, 0u, 0u}; }
        for (size_t i = gt; i < 65536; i += NGT) { const int n = (int)(i >> 8), k = (int)(i & 255), g = n >> 6;
            const float v = ((k >> 6) == g) ? P.pool_w[((l * 4 + g) * 64 + (k & 63)) * 64 + (n & 63)] * P.pool_scale[l * 256 + n] : 0.f;
            ((bf16_t*)(wl + WO_POOL))[i] = f2bf(v); }
    }
}

DI void shiftw_unit(const Params& P, const Ctx& C, int u) {
    const int l = u / 87, v = u % 87, which = (v >= 23) ? 1 : 0, j0 = (which ? v - 23 : v) * 64, N = which ? DFF : NIN;
    const float* W = which ? P.w_mlp1 + (size_t)l * 1024 * DFF : P.w_in + (size_t)l * 1024 * NIN;
    const float* mod = (const float*)(P.ws + OFF_MOD) + (size_t)l * 17 * 6144 + (which ? 3 : 0) * 1024;
    LAS float* sl = (LAS float*)C.lds;
    LAS float* part = sl + 17 * 1024;
    __syncthreads();
    for (int idx = C.tid; idx < 17 * 1024; idx += 512) { const int r = idx >> 10, k = idx & 1023; sl[idx] = mod[(size_t)r * 6144 + k]; }
    __syncthreads();
    const int ks = C.tid >> 6, jj = C.tid & 63; const bool ok = (j0 + jj) < N;
    float acc[17];
#pragma unroll
    for (int r = 0; r < 17; ++r) acc[r] = 0.f;
    const float* wp = W + (size_t)(ks * 128) * N + j0 + (ok ? jj : 0);
    for (int k = 0; k < 128; ++k) { const float w = wp[(size_t)k * N];
#pragma unroll
        for (int r = 0; r < 17; ++r) acc[r] += sl[r * 1024 + ks * 128 + k] * w; }
#pragma unroll
    for (int r = 0; r < 17; ++r) part[(ks * 17 + r) * 64 + jj] = acc[r];
    __syncthreads();
    float* shw = (float*)(P.ws + OFF_SHW) + (size_t)(l * 2 + which) * 17 * 4096;
    for (int idx = C.tid; idx < 17 * 64; idx += 512) { const int r = idx >> 6, j2 = idx & 63; float sacc = 0.f;
#pragma unroll
        for (int q = 0; q < 8; ++q) sacc += part[(q * 17 + r) * 64 + j2];
        if (j0 + j2 < N) shw[(size_t)r * 4096 + j0 + j2] = sacc; }
}
DI void phase_first(const Params& P, const Ctx& C) {
    const float* mod = (const float*)(P.ws + OFF_MOD);
    const float* gain = P.g_mix;
    bf16_t* hb = (bf16_t*)P.out; float* ss0 = (float*)(P.ws + OFF_SS);
    for (int row = C.bid * 8 + C.wave; row < RT; row += C.G * 8) {
        const float* xr = (row < RL) ? P.x + (size_t)row * 1024 : P.ctx + (size_t)(row - RL) * 1024;
        const int mr = (row < RL) ? (row >> 12) : 16;
        const float* sc = mod + (size_t)mr * 6144 + 1024;
        f32x4 v[4]; float ss = 0.f;
#pragma unroll
        for (int j = 0; j < 4; ++j) { v[j] = *(const f32x4*)(xr + 4 * C.lane + 256 * j); ss += (v[j][0] * v[j][0] + v[j][1] * v[j][1]) + (v[j][2] * v[j][2] + v[j][3] * v[j][3]); }
        ss = wave_sum(ss, C.lane);
        if (C.lane == 0) ss0[row] = ss;
#pragma unroll
        for (int j = 0; j < 4; ++j) { const int c = 4 * C.lane + 256 * j; const f32x4 g = *(const f32x4*)(gain + c), s1 = *(const f32x4*)(sc + c);
            const f32x4 y = v[j] * g * (s1 + 1.0f);
            u32x2 w; w.x = pk2(y[0], y[1]); w.y = pk2(y[2], y[3]);
            *(u32x2*)(hb + (size_t)row * 1024 + c) = w; }
    }
    for (int u = C.bid; u < 174; u += C.G) shiftw_unit(P, C, u);
}

DI float qsum16(float v, int lane) { v += xshfl(v, 1, lane); v += xshfl(v, 2, lane); v += xshfl(v, 4, lane); v += xshfl(v, 8, lane); return v; }
DI void unpack8(const u32x4 w, float (&a)[8]) { a[0] = bflo(w.x); a[1] = bfhi(w.x); a[2] = bflo(w.y); a[3] = bfhi(w.y); a[4] = bflo(w.z); a[5] = bfhi(w.z); a[6] = bflo(w.w); a[7] = bfhi(w.w); }
DI void phase_prep(const Params& P, const Ctx& C, int l) {
    unsigned char* ws = P.ws;
    const bf16_t* proj = (const bf16_t*)(ws + OFF_PROJ);
    bf16_t* NQ = (bf16_t*)(ws + OFF_NQ); bf16_t* Kb = (bf16_t*)(ws + OFF_K); bf16_t* poolA = (bf16_t*)(ws + OFF_POOLA); bf16_t* VXT = (bf16_t*)(ws + OFF_VXT);
    const f32x2* rope = (const f32x2*)(ws + OFF_ROPE);
    const float* gkv = P.g_kv + l * 128; const float* gq = P.g_q + l * 256;
    LAS bf16_t* L = (LAS bf16_t*)C.lds;
    constexpr int LS = 514;
    const int j = C.lane & 15, qw = C.lane >> 4;
    for (int u = C.bid; u < 1280; u += C.G) {
        int row0, b, t0, n, pos_off, ntok; bool isctx;
        if (u < 1024) { row0 = u * 64; b = row0 >> 12; t0 = row0 & 4095; n = SEQ; pos_off = CTXL; isctx = false; ntok = 64; }
        else { const int uc = u - 1024; row0 = RL + uc * 16; b = uc >> 4; t0 = (uc & 15) * 16; n = CTXL; pos_off = 0; isctx = true; ntok = 16; }
        const int lgt = isctx ? 1 : 3;
        const int rowseq = row0 - t0;
#pragma unroll
        for (int itk = 0; itk < 2; ++itk) { const bool act = !isctx || (itk == 0 && C.wave < 4);
            const int tok = !isctx ? (C.wave * 8 + itk * 4 + qw) : (act ? C.wave * 4 + qw : 0), row = row0 + tok, t = t0 + tok;
            const bf16_t* pr = proj + (size_t)row * NIN;
            const u32x4 wkv = *(const u32x4*)(pr + 8 * j), wq0 = *(const u32x4*)(pr + COL_Q + 8 * j), wq1 = *(const u32x4*)(pr + COL_Q + 128 + 8 * j);
            const unsigned wkr = *(const unsigned*)(pr + COL_KR + 2 * j);
            { float a[8]; unpack8(wkv, a); float ss = 0.f;
#pragma unroll
              for (int i = 0; i < 8; ++i) ss += a[i] * a[i];
              const float rs = rsqrtf(qsum16(ss, C.lane) * (1.f / 128.f) + EPS);
              const f32x4 g0 = *(const f32x4*)(gkv + 8 * j), g1 = *(const f32x4*)(gkv + 8 * j + 4);
              u32x4 o; o.x = pk2(a[0] * rs * g0[0], a[1] * rs * g0[1]); o.y = pk2(a[2] * rs * g0[2], a[3] * rs * g0[3]); o.z = pk2(a[4] * rs * g1[0], a[5] * rs * g1[1]); o.w = pk2(a[6] * rs * g1[2], a[7] * rs * g1[3]);
              if (act) *(u32x4*)(NQ + (size_t)row * 384 + 8 * j) = o; }
            { float a[8], c[8]; unpack8(wq0, a); unpack8(wq1, c); float ss = 0.f;
#pragma unroll
              for (int i = 0; i < 8; ++i) ss += a[i] * a[i] + c[i] * c[i];
              const float rs = rsqrtf(qsum16(ss, C.lane) * (1.f / 256.f) + EPS);
              const f32x4 g0 = *(const f32x4*)(gq + 8 * j), g1 = *(const f32x4*)(gq + 8 * j + 4), g2 = *(const f32x4*)(gq + 128 + 8 * j), g3 = *(const f32x4*)(gq + 128 + 8 * j + 4);
              u32x4 o; o.x = pk2(a[0] * rs * g0[0], a[1] * rs * g0[1]); o.y = pk2(a[2] * rs * g0[2], a[3] * rs * g0[3]); o.z = pk2(a[4] * rs * g1[0], a[5] * rs * g1[1]); o.w = pk2(a[6] * rs * g1[2], a[7] * rs * g1[3]);
              if (act) *(u32x4*)(NQ + (size_t)row * 384 + 128 + 8 * j) = o;
              o.x = pk2(c[0] * rs * g2[0], c[1] * rs * g2[1]); o.y = pk2(c[2] * rs * g2[2], c[3] * rs * g2[3]); o.z = pk2(c[4] * rs * g3[0], c[5] * rs * g3[1]); o.w = pk2(c[6] * rs * g3[2], c[7] * rs * g3[3]);
              if (act) *(u32x4*)(NQ + (size_t)row * 384 + 256 + 8 * j) = o; }
            { float x0 = bflo(wkr), x1 = bfhi(wkr); const float p0 = xshfl(x0, 4, C.lane), p1 = xshfl(x1, 4, C.lane);
              if (!isctx) { const int axis = j >> 3, half = (j >> 2) & 1, f = 2 * (j & 3); const int pp = axis ? (t & 63) : (t >> 6); const f32x2 c0 = rope[pp * 8 + f], c1 = rope[pp * 8 + f + 1];
                  x0 = half ? (x0 * c0.x + p0 * c0.y) : (x0 * c0.x - p0 * c0.y); x1 = half ? (x1 * c1.x + p1 * c1.y) : (x1 * c1.x - p1 * c1.y); }
              const unsigned w = pk2(x0, x1);
#pragma unroll
              for (int h = 0; h < 8; ++h) if (act) *(unsigned*)(Kb + ((size_t)(b * 8 + h) * NKEY + pos_off + t) * 96 + 64 + 2 * j) = w; }
        }
        for (int rd = 0; rd < 2; ++rd) {
            const int colbase = COL_POOL + rd * 512;
            __syncthreads();
            { u32x4 v[10];
#pragma unroll
              for (int i = 0; i < 10; ++i) { const int it = C.tid + 512 * i, rr = it >> 6, part = it & 63; const int t = t0 - 8 + rr;
                  v[i] = (u32x4){0u, 0u, 0u, 0u};
                  if (t >= 0 && t < n && rr < ntok + 16) v[i] = *(const u32x4*)(proj + (size_t)(rowseq + t) * NIN + colbase + part * 8); }
#pragma unroll
              for (int i = 0; i < 10; ++i) { const int it = C.tid + 512 * i, rr = it >> 6, part = it & 63;
                  LAS unsigned* d = (LAS unsigned*)(L + rr * LS + part * 8); if (rr < ntok + 16) d[0] = v[i].x; if (rr < ntok + 16) { d[1] = v[i].y; d[2] = v[i].z; d[3] = v[i].w; } } }
            __syncthreads();
            if (rd == 0) {
                for (int it = C.tid; it < ntok * 128; it += 512) { const int tok = it >> 7, cp = it & 127, c = 2 * cp, g = c >> 6, hw = 1 << g;
                    const int t = t0 + tok; const int lo = max(t - hw, 0), hi = min(t + hw, n);
                    float s0 = 0.f, s1 = 0.f;
                    for (int sidx = lo; sidx < hi; ++sidx) { const unsigned w = *(LAS const unsigned*)(L + (sidx - t0 + 8) * LS + c); s0 += bflo(w); s1 += bfhi(w); }
                    const unsigned wc = *(LAS const unsigned*)(L + (tok + 8) * LS + c);
                    const float inv = 1.f / (float)(hi - lo);
                    *(unsigned*)(poolA + (size_t)(row0 + tok) * 256 + c) = pk2(s0 * inv - bflo(wc), s1 * inv - bfhi(wc)); }
            }
            for (int kk = (rd == 0 ? 1 : 0); kk < 2; ++kk) { const int k = rd * 2 + kk - 1;
                const int cb = kk * 256;
                for (int it = C.tid; it < (256 << lgt); it += 512) { const int tg = it & ((1 << lgt) - 1), c = it >> lgt, ch = k * 256 + c;
                    const float w0 = P.hy_conv_w[(l * 3 + 0) * 768 + ch], w1 = P.hy_conv_w[(l * 3 + 1) * 768 + ch], w2 = P.hy_conv_w[(l * 3 + 2) * 768 + ch], bb = P.hy_conv_b[l * 768 + ch];
                    float xv[10];
#pragma unroll
                    for (int i = 0; i < 10; ++i) xv[i] = bf2f(L[(8 * tg + i + 7) * LS + cb + c]);
                    float o[8];
#pragma unroll
                    for (int i = 0; i < 8; ++i) o[i] = xv[i] * w0 + xv[i + 1] * w1 + xv[i + 2] * w2 + bb;
                    u32x4 w; w.x = pk2(o[0], o[1]); w.y = pk2(o[2], o[3]); w.z = pk2(o[4], o[5]); w.w = pk2(o[6], o[7]);
                    *(u32x4*)(VXT + (size_t)k * (SZ_XT / 2) + ((size_t)c * NB + b) * NKEY + pos_off + t0 + 8 * tg) = w; }
            }
        }
        __syncthreads();
    }
}

constexpr int KS_T = 64 * 104, VS_T = 64 * 72;
DI void attn_qk(LAS const bf16_t* Kc, const bf16x8 (&qf)[6], int r, int hh, f32x16& s0, f32x16& s1) {
#pragma unroll
    for (int i = 0; i < 16; ++i) { s0[i] = 0.f; s1[i] = 0.f; }
#pragma unroll
    for (int ks = 0; ks < 6; ++ks) {
        const bf16x8 a0 = *(LAS const bf16x8*)(Kc + r * 104 + 16 * ks + 8 * hh);
        const bf16x8 a1 = *(LAS const bf16x8*)(Kc + (32 + r) * 104 + 16 * ks + 8 * hh);
        s0 = __builtin_amdgcn_mfma_f32_32x32x16_bf16(a0, qf[ks], s0, 0, 0, 0);
        s1 = __builtin_amdgcn_mfma_f32_32x32x16_bf16(a1, qf[ks], s1, 0, 0, 0);
    }
}
struct AttnSt { f32x16 o0, o1; float mref, lsum; };
DI float vmax3(float a, float b, float c) { float d; asm("v_max3_f32 %0, %1, %2, %3" : "=v"(d) : "v"(a), "v"(b), "v"(c)); return d; }
template <bool HAS_NEXT>
DI void attn_tile(LAS const bf16_t* Kn, LAS const bf16_t* Vc, const bf16x8 (&qf)[6], int r, int hh, int lane, f32x16& s0, f32x16& s1, f32x16& n0, f32x16& n1, AttnSt& st, bool first) {
    bf16x8 kf[12], vf[8];
    __builtin_amdgcn_sched_barrier(0);
    if (HAS_NEXT) {
#pragma unroll
        for (int ks = 0; ks < 6; ++ks) { kf[2 * ks] = *(LAS const bf16x8*)(Kn + r * 104 + 16 * ks + 8 * hh); kf[2 * ks + 1] = *(LAS const bf16x8*)(Kn + (32 + r) * 104 + 16 * ks + 8 * hh); }
    }
    if (first) {
        float mx = vmax3(s0[0], s0[1], s0[2]);
#pragma unroll
        for (int i = 3; i < 15; i += 2) mx = vmax3(mx, s0[i], s0[i + 1]);
        mx = vmax3(mx, s0[15], s1[0]);
#pragma unroll
        for (int i = 1; i < 15; i += 2) mx = vmax3(mx, s1[i], s1[i + 1]);
        mx = fmaxf(mx, s1[15]);
        mx = fmaxf(mx, xshfl(mx, 32, lane));
        s0 = s0 - mx; s1 = s1 - mx; st.mref = mx;
    }
    __builtin_amdgcn_sched_barrier(0);
    if (HAS_NEXT) {
        const float nm = -st.mref;
#pragma unroll
        for (int i = 0; i < 16; ++i) { n0[i] = nm; n1[i] = nm; }
#pragma unroll
        for (int ks = 0; ks < 6; ++ks) { n0 = __builtin_amdgcn_mfma_f32_32x32x16_bf16(kf[2 * ks], qf[ks], n0, 0, 0, 0); n1 = __builtin_amdgcn_mfma_f32_32x32x16_bf16(kf[2 * ks + 1], qf[ks], n1, 0, 0, 0); }
    }
#pragma unroll
    for (int sidx = 0; sidx < 4; ++sidx) { vf[2 * sidx] = *(LAS const bf16x8*)(Vc + r * 72 + 16 * sidx + 8 * hh); vf[2 * sidx + 1] = *(LAS const bf16x8*)(Vc + (32 + r) * 72 + 16 * sidx + 8 * hh); }
#pragma unroll
    for (int i = 0; i < 16; ++i) { s0[i] = __builtin_amdgcn_exp2f(s0[i]); s1[i] = __builtin_amdgcn_exp2f(s1[i]); }
    float ps = 0.f;
    { const f32x16 sm = s0 + s1;
#pragma unroll
      for (int i = 0; i < 16; ++i) ps += sm[i]; }
    if (HAS_NEXT) {
#pragma unroll
        for (int i = 0; i < 12; ++i) { __builtin_amdgcn_sched_group_barrier(0x008, 1, 0); __builtin_amdgcn_sched_group_barrier(0x100, 1, 0); __builtin_amdgcn_sched_group_barrier(0x002, 4, 0); }
    }
    __builtin_amdgcn_sched_barrier(0);
    if (__builtin_amdgcn_ballot_w64(!(ps < 1.8446744e19f)) != 0ull) {
        const float sc = 5.421010862427522e-20f;
        s0 = s0 * sc; s1 = s1 * sc; ps *= sc; st.o0 = st.o0 * sc; st.o1 = st.o1 * sc; st.lsum *= sc; st.mref += 64.f;
        if (HAS_NEXT) { n0 = n0 - 64.f; n1 = n1 - 64.f; }
    }
    st.lsum += ps;
    u32x4 pw[4];
#pragma unroll
    for (int st4 = 0; st4 < 2; ++st4) {
        pw[st4].x = pk2(s0[8 * st4 + 0], s0[8 * st4 + 1]); pw[st4].y = pk2(s0[8 * st4 + 2], s0[8 * st4 + 3]); pw[st4].z = pk2(s0[8 * st4 + 4], s0[8 * st4 + 5]); pw[st4].w = pk2(s0[8 * st4 + 6], s0[8 * st4 + 7]);
        pw[2 + st4].x = pk2(s1[8 * st4 + 0], s1[8 * st4 + 1]); pw[2 + st4].y = pk2(s1[8 * st4 + 2], s1[8 * st4 + 3]); pw[2 + st4].z = pk2(s1[8 * st4 + 4], s1[8 * st4 + 5]); pw[2 + st4].w = pk2(s1[8 * st4 + 6], s1[8 * st4 + 7]); }
#pragma unroll
    for (int sidx = 0; sidx < 4; ++sidx) {
        const bf16x8 pf = __builtin_bit_cast(bf16x8, pw[sidx]);
        st.o0 = __builtin_amdgcn_mfma_f32_32x32x16_bf16(vf[2 * sidx], pf, st.o0, 0, 0, 0);
        st.o1 = __builtin_amdgcn_mfma_f32_32x32x16_bf16(vf[2 * sidx + 1], pf, st.o1, 0, 0, 0);
    }
    __builtin_amdgcn_sched_barrier(0);
}
constexpr int AT_NBUF = 5, AT_KB = 64 * 208, AT_VB = 64 * 144, AT_STAGE = AT_KB + AT_VB;
DI void attn_unit(const Ctx& C, const bf16_t* Qp, const bf16_t* Kp, const bf16_t* VTp, int nkeys, bf16_t* outp) {
    const int r = C.lane & 31, hh = C.lane >> 5;
    bf16x8 qf[6];
    { const bf16_t* qrow = Qp + (size_t)(C.wave * 32 + r) * 96 + 8 * hh;
#pragma unroll
      for (int ks = 0; ks < 6; ++ks) qf[ks] = *(const bf16x8*)(qrow + 16 * ks); }
    AttnSt st;
#pragma unroll
    for (int i = 0; i < 16; ++i) { st.o0[i] = 0.f; st.o1[i] = 0.f; }
    st.mref = 0.f; st.lsum = 0.f;
    const char* gb[3]; unsigned gv[3]; unsigned gstep[3]; unsigned lo[3];
#pragma unroll
    for (int k = 0; k < 3; ++k) { int pc = C.wave + 8 * k; if (pc >= 22) pc = C.wave;
        if (pc < 13) { const int q = pc * 64 + C.lane, row = q / 13, part = min(q - row * 13, 11); gb[k] = (const char*)Kp; gv[k] = (unsigned)(row * 192 + part * 16); gstep[k] = 64 * 192; lo[k] = pc * 1024; }
        else { const int q = (pc - 13) * 64 + C.lane, row = q / 9, part = min(q - row * 9, 7); gb[k] = (const char*)VTp; gv[k] = (unsigned)(row * (NKEY * 2) + part * 16); gstep[k] = 128; lo[k] = AT_KB + (pc - 13) * 1024; } }
    const int ntile = nkeys >> 6;
#define AT_ISSUE(tile, buf) do { const int _t = (tile) < ntile ? (tile) : ntile - 1; _Pragma("unroll") for (int _k = 0; _k < 3; ++_k) \
        __builtin_amdgcn_global_load_lds((const unsigned*)((gb[_k] + (size_t)_t * gstep[_k]) + gv[_k]), (LAS unsigned*)(C.lds + (buf) * AT_STAGE + lo[_k]), 16, 0, 0); } while (0)
#define AT_KPTR(buf) ((LAS const bf16_t*)(C.lds + (buf) * AT_STAGE))
#define AT_VPTR(buf) ((LAS const bf16_t*)(C.lds + (buf) * AT_STAGE + AT_KB))
#define AT_SEAM() do { asm volatile("s_waitcnt vmcnt(6)" ::: "memory"); __builtin_amdgcn_s_barrier(); asm volatile("" ::: "memory"); } while (0)
#define AT_NEXT(b) (((b) == AT_NBUF - 1) ? 0 : (b) + 1)
#define AT_PREV(b) (((b) == 0) ? AT_NBUF - 1 : (b) - 1)
    __syncthreads();
    AT_ISSUE(0, 0); AT_ISSUE(1, 1); AT_ISSUE(2, 2); AT_ISSUE(3, 3);
    AT_SEAM();
    f32x16 sa0, sa1, sb0, sb1;
    attn_qk(AT_KPTR(0), qf, r, hh, sa0, sa1);
    int bc = 0, it = 0;
    for (; it + 2 < ntile; it += 2) {
        { const int bn = AT_NEXT(bc); AT_ISSUE(it + 4, AT_PREV(bc));
          attn_tile<true>(AT_KPTR(bn), AT_VPTR(bc), qf, r, hh, C.lane, sa0, sa1, sb0, sb1, st, it == 0);
          AT_SEAM(); bc = bn; }
        { const int bn = AT_NEXT(bc); AT_ISSUE(it + 5, AT_PREV(bc));
          attn_tile<true>(AT_KPTR(bn), AT_VPTR(bc), qf, r, hh, C.lane, sb0, sb1, sa0, sa1, st, false);
          AT_SEAM(); bc = bn; }
    }
    { const int bn = AT_NEXT(bc); AT_ISSUE(ntile, AT_PREV(bc));
      attn_tile<true>(AT_KPTR(bn), AT_VPTR(bc), qf, r, hh, C.lane, sa0, sa1, sb0, sb1, st, false);
      AT_SEAM(); bc = bn; }
    attn_tile<false>(AT_KPTR(0), AT_VPTR(bc), qf, r, hh, C.lane, sb0, sb1, sa0, sa1, st, false);
    asm volatile("s_waitcnt vmcnt(0)" ::: "memory");
#undef AT_ISSUE
#undef AT_KPTR
#undef AT_VPTR
#undef AT_SEAM
#undef AT_NEXT
#undef AT_PREV
    const float ltot = st.lsum + xshfl(st.lsum, 32, C.lane);
    const float inv = 1.f / ltot;
    bf16_t* orow = outp + (size_t)(C.wave * 32 + r) * 512 + 4 * hh;
#pragma unroll
    for (int g = 0; g < 4; ++g) {
        u32x2 w0, w1;
        w0.x = pk2(st.o0[4 * g] * inv, st.o0[4 * g + 1] * inv); w0.y = pk2(st.o0[4 * g + 2] * inv, st.o0[4 * g + 3] * inv);
        w1.x = pk2(st.o1[4 * g] * inv, st.o1[4 * g + 1] * inv); w1.y = pk2(st.o1[4 * g + 2] * inv, st.o1[4 * g + 3] * inv);
        *(u32x2*)(orow + 8 * g) = w0; *(u32x2*)(orow + 32 + 8 * g) = w1;
    }
}

DI void phase_attn(const Params& P, const Ctx& C, int l) {
    unsigned char* ws = P.ws;
    const bf16_t* QL = (const bf16_t*)(ws + OFF_QL); const bf16_t* QC = (const bf16_t*)(ws + OFF_QC);
    const bf16_t* Kb = (const bf16_t*)(ws + OFF_K); const bf16_t* VT = (const bf16_t*)(ws + OFF_VT);
    bf16_t* att = (bf16_t*)(ws + OFF_ATT);
    const int nun = 2048 + (l == 0 ? 128 : 0);
    for (int u = C.bid; u < nun; u += C.G) {
        if (u < 2048) { const int j = u / C.G, w = u - j * C.G;
            const int qb = (w >> 3) & 15, bh = (C.G == 256) ? (j * 16 + (w & 7) * 2 + (w >> 7)) : (u >> 4), b = bh >> 3, h = bh & 7; const int qb2 = (C.G == 256) ? qb : (u & 15);
            attn_unit(C, QL + ((size_t)bh * SEQ + qb2 * 256) * 96, Kb + (size_t)bh * NKEY * 96, VT + (size_t)bh * 64 * NKEY, NKEY,
                      att + ((size_t)b * SEQ + qb2 * 256) * 512 + h * 64); }
        else { const int bh = u - 2048, b = bh >> 3, h = bh & 7;
            attn_unit(C, QC + (size_t)bh * CTXL * 96, Kb + (size_t)bh * NKEY * 96, VT + (size_t)bh * 64 * NKEY, CTXL,
                      att + ((size_t)RL + b * CTXL) * 512 + h * 64); }
    }
    __syncthreads();
}

DI float hval(const float* Hf, const float* Hb, int n, int m) { if (m > 2 * n - 2) return 0.f; const int d = n - 1 - m; return d >= 0 ? Hf[d] : Hb[-d]; }
DI bf16x8 lda_tile(LAS const unsigned char* p) { LAS const unsigned* q = (LAS const unsigned*)p; u32x4 v; v.x = q[0]; v.y = q[1]; v.z = q[2]; v.w = q[3]; return __builtin_bit_cast(bf16x8, v); }

DI void hyena_unit(const Ctx& C, const float* Hf, const float* Hb, int n, const bf16_t* UT, const bf16_t* XT, bf16_t* OT, int pos_off, float bias) {
    LAS bf16_t* R0 = (LAS bf16_t*)C.lds; LAS bf16_t* R1 = R0 + 8192; LAS float* red = (LAS float*)(C.lds + 32768);
    __syncthreads();
    float asum = 0.f;
    for (int m = C.tid; m < 2 * n; m += 512) { const float v0 = hval(Hf, Hb, n, m), v1 = hval(Hf, Hb, n, m + 1); R0[m] = f2bf(v0); R1[m] = f2bf(v1); asum += fabsf(v0); }
    asum = wave_sum(asum, C.lane);
    if (C.lane == 0) red[C.wave] = asum;
    __syncthreads();
    float tot = 0.f;
#pragma unroll
    for (int w = 0; w < 8; ++w) tot += red[w];
    const float invn = 1.f / tot;
    const int i = C.lane & 15, g = C.lane >> 4;
    const int npass = n >> 8, nj = n >> 5;
    for (int pass = C.wave; pass < npass; pass += 8) {
        const int I0 = 16 * pass;
        const int m0 = (n - 1) - 16 * I0 - i + 8 * g;
        LAS const unsigned char* a0 = C.lds + (m0 & 1) * 16384 + (m0 & ~1) * 2;
        f32x4 acc[16]; bf16x8 W[16];
#pragma unroll
        for (int s = 0; s < 16; ++s) { acc[s] = (f32x4){0.f, 0.f, 0.f, 0.f}; W[s] = lda_tile(a0 - 32 * s); }
        const bf16_t* ub = UT + (size_t)i * NKEY + pos_off + 8 * g;
        bf16x8 bq[4];
#pragma unroll
        for (int k = 0; k < 3; ++k) bq[k] = *(const bf16x8*)(ub + 32 * min(k, nj - 1));
        for (int j0 = 0; j0 < nj; j0 += 8) {
#pragma unroll
            for (int u = 0; u < 8; ++u) { const int j = j0 + u;
                acc[14] = __builtin_amdgcn_mfma_f32_16x16x32_bf16(W[(14 - 2 * u + 16) & 15], bq[u & 3], acc[14], 0, 0, 0);
                acc[15] = __builtin_amdgcn_mfma_f32_16x16x32_bf16(W[(15 - 2 * u + 16) & 15], bq[u & 3], acc[15], 0, 0, 0);
                __builtin_amdgcn_sched_barrier(0);
                W[(14 - 2 * u + 16) & 15] = lda_tile(a0 + 64 * (j + 1));
                W[(15 - 2 * u + 16) & 15] = lda_tile(a0 + 64 * (j + 1) - 32);
                bq[(u + 3) & 3] = *(const bf16x8*)(ub + 32 * min(j + 3, nj - 1));
                __builtin_amdgcn_sched_barrier(0);
#pragma unroll
                for (int ii = 0; ii < 14; ++ii) acc[ii] = __builtin_amdgcn_mfma_f32_16x16x32_bf16(W[(ii - 2 * u + 16) & 15], bq[u & 3], acc[ii], 0, 0, 0);
                __builtin_amdgcn_sched_barrier(0); }
        }
#pragma unroll
        for (int ii = 0; ii < 16; ++ii) { const size_t off = (size_t)i * NKEY + pos_off + 16 * (I0 + ii) + 4 * g;
            const u32x2 uu = *(const u32x2*)(UT + off), xx = *(const u32x2*)(XT + off);
            const float y0 = acc[ii][0] * invn + bflo(uu.x) * bias, y1 = acc[ii][1] * invn + bfhi(uu.x) * bias, y2 = acc[ii][2] * invn + bflo(uu.y) * bias, y3 = acc[ii][3] * invn + bfhi(uu.y) * bias;
            u32x2 w; w.x = pk2(bflo(xx.x) * y0, bfhi(xx.x) * y1); w.y = pk2(bflo(xx.y) * y2, bfhi(xx.y) * y3);
            *(u32x2*)(OT + off) = w; }
    }
}

DI void phase_hyena(const Params& P, const Ctx& C, int l, int o) {
    unsigned char* ws = P.ws;
    const bf16_t* VXT = (const bf16_t*)(ws + OFF_VXT); const size_t XS = SZ_XT / 2;
    const bf16_t* UTb = o == 0 ? VXT : (const bf16_t*)(ws + OFF_ZT);
    const bf16_t* XTb = o == 0 ? VXT + XS : VXT + 2 * XS;
    bf16_t* OTb = o == 0 ? (bf16_t*)(ws + OFF_ZT) : (bf16_t*)(ws + OFF_HYT);
    const float* HL = (const float*)(ws + OFF_HL) + (size_t)l * 1024 * 4096; const float* HC = (const float*)(ws + OFF_HC);
    const int nun = 256 + (l == 0 ? 256 : 0);
    for (int u = C.bid; u < nun; u += C.G) {
        const int c = u & 255; const size_t co = (size_t)c * NB * NKEY; const float bias = P.hy_bias[(l * 2 + o) * 256 + c];
        if (u < 256) hyena_unit(C, HL + (size_t)(o * 512 + c) * 4096, HL + (size_t)(o * 512 + 256 + c) * 4096, SEQ, UTb + co, XTb + co, OTb + co, CTXL, bias);
        else hyena_unit(C, HC + (size_t)(o * 512 + c) * 256, HC + (size_t)(o * 512 + 256 + c) * 256, CTXL, UTb + co, XTb + co, OTb + co, 0, bias);
    }
    __syncthreads();
}

DI void phase_merge(const Params& P, const Ctx& C, int l) {
    unsigned char* ws = P.ws;
    const bf16_t* att = (const bf16_t*)(ws + OFF_ATT); const bf16_t* po = (const bf16_t*)(ws + OFF_POOLO); const bf16_t* hyT = (const bf16_t*)(ws + OFF_HYT);
    bf16_t* mb = (bf16_t*)P.out;
    const float* go = P.g_out + l * 1024;
    LAS bf16_t* L = (LAS bf16_t*)C.lds;
    const int nun = (l == 0) ? 1280 : 1024;
    const int j = C.lane & 15, qw = C.lane >> 4;
    for (int u = C.bid; u < nun; u += C.G) {
        int row0, b, t0, pos_off; bool isctx;
        if (u < 1024) { row0 = u * 64; b = row0 >> 12; t0 = row0 & 4095; pos_off = CTXL; isctx = false; }
        else { const int uc = u - 1024; row0 = RL + uc * 16; b = uc >> 4; t0 = (uc & 15) * 16; pos_off = 0; isctx = true; }
        const int nparts = isctx ? 2 : 8;
        __syncthreads();
        { u32x4 v[4];
#pragma unroll
          for (int i = 0; i < 4; ++i) { const int it = C.tid + 512 * i, c = it >> 3, part = it & 7; v[i] = (u32x4){0u, 0u, 0u, 0u}; if (part < nparts) v[i] = *(const u32x4*)(hyT + ((size_t)c * NB + b) * NKEY + pos_off + t0 + part * 8); }
#pragma unroll
          for (int i = 0; i < 4; ++i) { const int it = C.tid + 512 * i, c = it >> 3, part = it & 7; LAS unsigned* d = (LAS unsigned*)(L + c * 66 + part * 8); d[0] = v[i].x; d[1] = v[i].y; d[2] = v[i].z; d[3] = v[i].w; } }
#pragma unroll
        for (int itk = 0; itk < 2; ++itk) { const bool act = !isctx || (itk == 0 && C.wave < 4);
            const int tok = !isctx ? (C.wave * 8 + itk * 4 + qw) : (act ? C.wave * 4 + qw : 0), row = row0 + tok;
            bf16_t* mr = mb + (size_t)row * 1024;
            u32x4 wa[4], wp[2];
#pragma unroll
            for (int q = 0; q < 4; ++q) wa[q] = *(const u32x4*)(att + (size_t)row * 512 + 8 * j + 128 * q);
#pragma unroll
            for (int q = 0; q < 2; ++q) wp[q] = *(const u32x4*)(po + (size_t)row * 256 + 8 * j + 128 * q);
            { float a[4][8]; float ss = 0.f;
#pragma unroll
              for (int q = 0; q < 4; ++q) { unpack8(wa[q], a[q]);
#pragma unroll
                  for (int i = 0; i < 8; ++i) ss += a[q][i] * a[q][i]; }
              const float rs = rsqrtf(qsum16(ss, C.lane) * (1.f / 512.f) + EPS);
#pragma unroll
              for (int q = 0; q < 4; ++q) { const f32x4 g0 = *(const f32x4*)(go + 8 * j + 128 * q), g1 = *(const f32x4*)(go + 8 * j + 128 * q + 4);
                  u32x4 o; o.x = pk2(a[q][0] * rs * g0[0], a[q][1] * rs * g0[1]); o.y = pk2(a[q][2] * rs * g0[2], a[q][3] * rs * g0[3]); o.z = pk2(a[q][4] * rs * g1[0], a[q][5] * rs * g1[1]); o.w = pk2(a[q][6] * rs * g1[2], a[q][7] * rs * g1[3]);
                  if (act) *(u32x4*)(mr + 8 * j + 128 * q) = o; } }
            { float a[2][8]; float ss = 0.f;
#pragma unroll
              for (int q = 0; q < 2; ++q) { unpack8(wp[q], a[q]);
#pragma unroll
                  for (int i = 0; i < 8; ++i) ss += a[q][i] * a[q][i]; }
              const float rs = rsqrtf(qsum16(ss, C.lane) * (1.f / 256.f) + EPS);
#pragma unroll
              for (int q = 0; q < 2; ++q) { const f32x4 g0 = *(const f32x4*)(go + 512 + 8 * j + 128 * q), g1 = *(const f32x4*)(go + 512 + 8 * j + 128 * q + 4);
                  u32x4 o; o.x = pk2(a[q][0] * rs * g0[0], a[q][1] * rs * g0[1]); o.y = pk2(a[q][2] * rs * g0[2], a[q][3] * rs * g0[3]); o.z = pk2(a[q][4] * rs * g1[0], a[q][5] * rs * g1[1]); o.w = pk2(a[q][6] * rs * g1[2], a[q][7] * rs * g1[3]);
                  if (act) *(u32x4*)(mr + 512 + 8 * j + 128 * q) = o; } }
        }
        __syncthreads();
#pragma unroll
        for (int itk = 0; itk < 2; ++itk) { const bool act = !isctx || (itk == 0 && C.wave < 4);
            const int tok = !isctx ? (C.wave * 8 + itk * 4 + qw) : (act ? C.wave * 4 + qw : 0), row = row0 + tok;
            bf16_t* mr = mb + (size_t)row * 1024 + 768;
            float a[8][2]; float ss = 0.f;
#pragma unroll
            for (int i = 0; i < 8; ++i) { const int c = 2 * j + 32 * i; a[i][0] = bf2f(L[c * 66 + tok]); a[i][1] = bf2f(L[(c + 1) * 66 + tok]); ss += a[i][0] * a[i][0] + a[i][1] * a[i][1]; }
            const float rs = rsqrtf(qsum16(ss, C.lane) * (1.f / 256.f) + EPS);
#pragma unroll
            for (int i = 0; i < 8; ++i) { const int c = 2 * j + 32 * i; const f32x2 g = *(const f32x2*)(go + 768 + c); if (act) *(unsigned*)(mr + c) = pk2(a[i][0] * rs * g.x, a[i][1] * rs * g.y); }
        }
    }
    __syncthreads();
}

DI void phase_ctxfin(const Params& P, const Ctx& C) {
    const float* mod0 = (const float*)(P.ws + OFF_MOD); const float* mod1 = mod0 + (size_t)17 * 6144;
    const float* gate = mod0 + (size_t)16 * 6144 + 5 * 1024;
    const float* sc = mod1 + (size_t)16 * 6144 + 1 * 1024;
    const float* gain = P.g_mix + 1024;
    bf16_t* xrb = (bf16_t*)(P.ws + OFF_XR) + (size_t)RL * 1024; const float* part = (const float*)(P.ws + OFF_PART);
    bf16_t* hb = (bf16_t*)P.out; float* ss2 = (float*)(P.ws + OFF_SS) + (size_t)2 * RT;
    for (int row = C.bid * 8 + C.wave; row < RC; row += C.G * 8) {
        bf16_t* xr = xrb + (size_t)row * 1024;
        f32x4 v[4]; float ss = 0.f;
#pragma unroll
        for (int j = 0; j < 4; ++j) { const int c = 4 * C.lane + 256 * j; f32x4 a = *(const f32x4*)(part + (size_t)row * 1024 + c);
#pragma unroll
            for (int ks = 1; ks < 4; ++ks) a = a + *(const f32x4*)(part + ((size_t)ks * RC + row) * 1024 + c);
            const u32x2 xw = *(const u32x2*)(xr + c);
            v[j] = (f32x4){bflo(xw.x), bfhi(xw.x), bflo(xw.y), bfhi(xw.y)} + *(const f32x4*)(gate + c) * a;
            u32x2 o; o.x = pk2(v[j][0], v[j][1]); o.y = pk2(v[j][2], v[j][3]); *(u32x2*)(xr + c) = o;
            ss += (v[j][0] * v[j][0] + v[j][1] * v[j][1]) + (v[j][2] * v[j][2] + v[j][3] * v[j][3]); }
        ss = wave_sum(ss, C.lane);
        if (C.lane == 0) ss2[RL + row] = ss;
#pragma unroll
        for (int j = 0; j < 4; ++j) { const int c = 4 * C.lane + 256 * j; const f32x4 y = v[j] * *(const f32x4*)(gain + c) * (*(const f32x4*)(sc + c) + 1.0f);
            u32x2 w; w.x = pk2(y[0], y[1]); w.y = pk2(y[2], y[3]);
            *(u32x2*)(hb + (size_t)(RL + row) * 1024 + c) = w; }
    }
}

DI void phase_final(const Params& P, const Ctx& C) {
    for (int row = C.bid * 8 + C.wave; row < RL; row += C.G * 8) {
        float* xr = P.out + (size_t)row * 1024; const bf16_t* xb = (const bf16_t*)(P.ws + OFF_XR) + (size_t)row * 1024;
        f32x4 v[4]; float ss = 0.f;
#pragma unroll
        for (int j = 0; j < 4; ++j) { const u32x2 w = *(const u32x2*)(xb + 4 * C.lane + 256 * j); v[j] = (f32x4){bflo(w.x), bfhi(w.x), bflo(w.y), bfhi(w.y)};
            ss += (v[j][0] * v[j][0] + v[j][1] * v[j][1]) + (v[j][2] * v[j][2] + v[j][3] * v[j][3]); }
        const float rs = rsqrtf(wave_sum(ss, C.lane) * (1.f / 1024.f) + EPS);
#pragma unroll
        for (int j = 0; j < 4; ++j) { const f32x4 g = *(const f32x4*)(P.g_final + 4 * C.lane + 256 * j); *(f32x4*)(xr + 4 * C.lane + 256 * j) = v[j] * rs * g; }
    }
}

DI Ctx make_ctx(LAS unsigned char* lds, int wave_s) {
    Ctx C; int bid = blockIdx.x, G = gridDim.x, wv = wave_s;
    int lane; asm volatile("v_mbcnt_lo_u32_b32 %0, -1, 0\n\tv_mbcnt_hi_u32_b32 %0, -1, %0" : "=v"(lane)); asm volatile("" : "+s"(bid)); asm volatile("" : "+s"(G)); asm volatile("" : "+s"(wv));
    C.lds = lds; C.tid = wv * 64 + lane; C.lane = lane; C.wave = wv; C.G = G; C.bid = bid; return C;
}
DI unsigned char* fresh_ws(const Params& P) { unsigned char* w = P.ws; asm volatile("" : "+s"(w)); return w; }

__global__ void __launch_bounds__(512, 2) mega_fwd(Params P) {
    extern __shared__ __attribute__((aligned(16))) unsigned char lds_raw[];
    cg::grid_group grid = cg::this_grid();
    LAS unsigned char* lds = (LAS unsigned char*)lds_raw;
    const int wave_s = __builtin_amdgcn_readfirstlane((int)(threadIdx.x >> 6));
    { const Ctx C = make_ctx(lds, wave_s);
      if (C.bid == 0) for (int i = C.tid; i < XCD_BAR_WORDS; i += 512) ((unsigned*)(P.ws + OFF_BAR))[i] = 0u;
      if (C.tid < 4) ((LAS unsigned*)(lds + 131072))[C.tid] = 0u;
      phase_setup(P, C); }
    grid.sync();
    { const Ctx C = make_ctx(lds, wave_s); xcd_barrier_post((unsigned*)(P.ws + OFF_BAR), C.tid == 0); }
#define GSYNC() do { const Ctx _c = make_ctx(lds, wave_s); xcd_barrier((unsigned*)(fresh_ws(P) + OFF_BAR), (volatile LAS unsigned*)(lds + 131072), _c.tid == 0); } while (0)
    { const Ctx C = make_ctx(lds, wave_s); phase_first(P, C); }
    GSYNC();
#pragma unroll 1
    for (int li = 0; li < 2; ++li) {
        int l = li; asm volatile("" : "+s"(l));
        const bool last = (l == 1);
        const int Mrows = last ? RL : RT;
        { const Ctx C = make_ctx(lds, wave_s); unsigned char* ws = fresh_ws(P); unsigned char* wl = ws + OFF_W + (size_t)l * SZ_WLAYER; pg8::StaticOrder S;
          pg8::Gemm g{(const bf16_t*)P.out, (const bf16_t*)(wl + WO_IN), RT, NINP, 1024, 1024, 1024}; S.init(g.M, g.N, C.G, C.bid);
          EpiNormBf16<0> e{(bf16_t*)(ws + OFF_PROJ), NIN, NIN, (const float*)(ws + OFF_SS) + (size_t)(l == 0 ? 0 : 2) * RT, (const float*)(ws + OFF_SHW) + (size_t)(l * 2 + 0) * 17 * 4096};
          pg8::gemm_phase(C.lds, C.tid, g, S, e); }
        GSYNC();
        { const Ctx C = make_ctx(lds, wave_s); phase_prep(P, C, l); }
        GSYNC();
        { const Ctx C = make_ctx(lds, wave_s); unsigned char* ws = fresh_ws(P); unsigned char* wl = ws + OFF_W + (size_t)l * SZ_WLAYER; pg8::StaticOrder S;
          pg8::Gemm g{(const bf16_t*)(ws + OFF_NQ) + 128, (const bf16_t*)(wl + WO_Q), Mrows, 768, 256, 384, 256}; S.init(g.M, g.N, C.G, C.bid);
          EpiQ e{(bf16_t*)(ws + OFF_QL), (bf16_t*)(ws + OFF_QC), (const f32x2*)(ws + OFF_ROPE)}; pg8::gemm_phase(C.lds, C.tid, g, S, e); }
        __syncthreads();
        { const Ctx C = make_ctx(lds, wave_s); unsigned char* ws = fresh_ws(P); unsigned char* wl = ws + OFF_W + (size_t)l * SZ_WLAYER; pg8::StaticOrder S;
          pg8::Gemm g{(const bf16_t*)(ws + OFF_NQ), (const bf16_t*)(wl + WO_KN), RT, 512, 256, 384, 256}; S.init(g.M, g.N, C.G, C.bid);
          EpiKn e{(bf16_t*)(ws + OFF_K)}; pg8::gemm_phase(C.lds, C.tid, g, S, e); }
        __syncthreads();
        { const Ctx C = make_ctx(lds, wave_s); unsigned char* ws = fresh_ws(P); unsigned char* wl = ws + OFF_W + (size_t)l * SZ_WLAYER; pg8::StaticOrder S;
          pg8::Gemm g{(const bf16_t*)(wl + WO_V), (const bf16_t*)(ws + OFF_NQ), 512, RT, 256, 256, 384}; S.init(g.M, g.N, C.G, C.bid);
          EpiVT e{(bf16_t*)(ws + OFF_VT)}; pg8::gemm_phase(C.lds, C.tid, g, S, e); }
        __syncthreads();
        { const Ctx C = make_ctx(lds, wave_s); unsigned char* ws = fresh_ws(P); unsigned char* wl = ws + OFF_W + (size_t)l * SZ_WLAYER; pg8::StaticOrder S;
          pg8::Gemm g{(const bf16_t*)(ws + OFF_POOLA), (const bf16_t*)(wl + WO_POOL), Mrows, 256, 256, 256, 256}; S.init(g.M, g.N, C.G, C.bid);
          EpiBf16<0> e{(bf16_t*)(ws + OFF_POOLO), 256, 256}; pg8::gemm_phase(C.lds, C.tid, g, S, e); }
        GSYNC();
        { const Ctx C = make_ctx(lds, wave_s); phase_attn(P, C, l); }
        { const Ctx C = make_ctx(lds, wave_s); phase_hyena(P, C, l, 0); }
        GSYNC();
        { const Ctx C = make_ctx(lds, wave_s); phase_hyena(P, C, l, 1); }
        GSYNC();
        { const Ctx C = make_ctx(lds, wave_s); phase_merge(P, C, l); }
        GSYNC();
        { const Ctx C = make_ctx(lds, wave_s); unsigned char* ws = fresh_ws(P); unsigned char* wl = ws + OFF_W + (size_t)l * SZ_WLAYER; pg8::StaticOrder S;
          const float* modl = (const float*)(ws + OFF_MOD) + (size_t)l * 17 * 6144;
          pg8::Gemm g{(const bf16_t*)P.out, (const bf16_t*)(wl + WO_OUT), Mrows, 1024, 1024, 1024, 1024}; S.init(g.M, g.N, C.G, C.bid);
          if (l == 0) { EpiResid2<true, true> e{P.x, P.ctx, (bf16_t*)(ws + OFF_XR), modl + 2 * 1024, (bf16_t*)(ws + OFF_HBUF2), (float*)(ws + OFF_SS) + (size_t)1 * RT, P.g_mlp + l * 1024, modl + 4 * 1024};
            pg8::gemm_phase(C.lds, C.tid, g, S, e); }
          else { EpiResid2<false, true> e{nullptr, nullptr, (bf16_t*)(ws + OFF_XR), modl + 2 * 1024, (bf16_t*)(ws + OFF_HBUF2), (float*)(ws + OFF_SS) + (size_t)3 * RT, P.g_mlp + l * 1024, modl + 4 * 1024};
            pg8::gemm_phase(C.lds, C.tid, g, S, e); } }
        GSYNC();
        { const Ctx C = make_ctx(lds, wave_s); unsigned char* ws = fresh_ws(P); unsigned char* wl = ws + OFF_W + (size_t)l * SZ_WLAYER; pg8::StaticOrder S;
          pg8::Gemm g{(const bf16_t*)(ws + OFF_HBUF2), (const bf16_t*)(wl + WO_M1), Mrows, DFF, 1024, 1024, 1024}; S.init(g.M, g.N, C.G, C.bid);
          EpiNormBf16<1> e{(bf16_t*)(ws + OFF_ACT), DFF, DFF, (const float*)(ws + OFF_SS) + (size_t)(l == 0 ? 1 : 3) * RT, (const float*)(ws + OFF_SHW) + (size_t)(l * 2 + 1) * 17 * 4096};
          pg8::gemm_phase(C.lds, C.tid, g, S, e); }
        GSYNC();
        if (!last) {
          { const Ctx C = make_ctx(lds, wave_s); unsigned char* ws = fresh_ws(P); unsigned char* wl = ws + OFF_W + (size_t)l * SZ_WLAYER; pg8::StaticOrder S;
            const float* modl = (const float*)(ws + OFF_MOD) + (size_t)l * 17 * 6144; const float* modn = modl + (size_t)17 * 6144;
            pg8::Gemm g{(const bf16_t*)(ws + OFF_ACT), (const bf16_t*)(wl + WO_M2), RL, 1024, DFF, DFF, DFF}; S.init(g.M, g.N, C.G, C.bid);
            EpiResid2<false, true> e{nullptr, nullptr, (bf16_t*)(ws + OFF_XR), modl + 5 * 1024,
                             (bf16_t*)P.out, (float*)(ws + OFF_SS) + (size_t)2 * RT, P.g_mix + 1024, modn + 1 * 1024};
            pg8::gemm_phase(C.lds, C.tid, g, S, e); }
          __syncthreads();
          { const Ctx C = make_ctx(lds, wave_s); unsigned char* ws = fresh_ws(P); unsigned char* wl = ws + OFF_W + (size_t)l * SZ_WLAYER; pg8::StaticOrder S;
            pg8::Gemm g{(const bf16_t*)(ws + OFF_ACT) + (size_t)RL * DFF, (const bf16_t*)(wl + WO_M2), 4 * RC, 1024, 1024, DFF, DFF, 16, (size_t)1024 * 2}; S.init(g.M, g.N, C.G, C.bid);
            EpiPartial e{(float*)(ws + OFF_PART)};
            pg8::gemm_phase(C.lds, C.tid, g, S, e); }
          GSYNC();
          { const Ctx C = make_ctx(lds, wave_s); phase_ctxfin(P, C); }
        }
        else { const Ctx C = make_ctx(lds, wave_s); unsigned char* ws = fresh_ws(P); unsigned char* wl = ws + OFF_W + (size_t)l * SZ_WLAYER; pg8::StaticOrder S;
          const float* modl = (const float*)(ws + OFF_MOD) + (size_t)l * 17 * 6144;
          pg8::Gemm g{(const bf16_t*)(ws + OFF_ACT), (const bf16_t*)(wl + WO_M2), Mrows, 1024, DFF, DFF, DFF}; S.init(g.M, g.N, C.G, C.bid);
          EpiResid2<false, false> e{nullptr, nullptr, (bf16_t*)(ws + OFF_XR), modl + 5 * 1024, nullptr, nullptr, nullptr, nullptr};
          pg8::gemm_phase(C.lds, C.tid, g, S, e); }
        GSYNC();
    }
    { const Ctx C = make_ctx(lds, wave_s); phase_final(P, C); }
}

extern "C" void kernel_launch(void* const* d_in, const int* in_sizes, int n_in, void* d_out, int out_size, void* d_ws, size_t ws_size, hipStream_t stream) {
    static int grid = 0;
    if (grid == 0) {
        if (n_in != 30 || ws_size < WS_END) { fprintf(stderr, "kernel_launch: unexpected n_in %d / ws %zu (need %zu)\n", n_in, ws_size, (size_t)WS_END); grid = -1; return; }
        int dev = 0, cus = 0, per_cu = 0;
        (void)hipGetDevice(&dev);
        (void)hipDeviceGetAttribute(&cus, hipDeviceAttributeMultiprocessorCount, dev);
        if (hipFuncSetAttribute((const void*)mega_fwd, hipFuncAttributeMaxDynamicSharedMemorySize, LDS_BYTES) != hipSuccess) fprintf(stderr, "kernel_launch: hipFuncSetAttribute failed\n");
        if (hipOccupancyMaxActiveBlocksPerMultiprocessor(&per_cu, (const void*)mega_fwd, 512, LDS_BYTES) != hipSuccess || per_cu < 1) { fprintf(stderr, "kernel_launch: occupancy query gave %d\n", per_cu); per_cu = 1; }
        (void)hipGetLastError();
        grid = cus * 1;
    }
    if (grid < 0) return;
    Params p{};
    const float** pp = (const float**)&p;
    for (int i = 0; i < 30; ++i) pp[i] = (const float*)d_in[i];
    p.out = (float*)d_out; p.ws = (unsigned char*)d_ws;
    void* args[] = {&p};
    hipError_t e = hipLaunchCooperativeKernel((const void*)mega_fwd, dim3(grid), dim3(512), args, LDS_BYTES, stream);
    if (e != hipSuccess) fprintf(stderr, "cooperative launch failed: %s (grid %d)\n", hipGetErrorString(e), grid);
}
```

```cpp
#include <hip/hip_runtime.h>
#include <hip/hip_cooperative_groups.h>
#include <cstdio>
#include <cstdint>
namespace cg = cooperative_groups;

#define DI __device__ __forceinline__
#define LAS __attribute__((address_space(3)))
typedef unsigned short bf16_t;
typedef short bf16x8 __attribute__((ext_vector_type(8)));
typedef short s16x4 __attribute__((ext_vector_type(4)));
typedef float f32x4 __attribute__((ext_vector_type(4)));
typedef float f32x2 __attribute__((ext_vector_type(2)));
typedef float f32x16 __attribute__((ext_vector_type(16)));
typedef unsigned u32x4 __attribute__((ext_vector_type(4)));
typedef unsigned u32x2 __attribute__((ext_vector_type(2)));
typedef __bf16 bf16x2_t __attribute__((ext_vector_type(2)));

DI unsigned pk2(float lo, float hi) { f32x2 v = {lo, hi}; bf16x2_t b = __builtin_convertvector(v, bf16x2_t); return __builtin_bit_cast(unsigned, b); }
DI float bflo(unsigned w) { return __uint_as_float(w << 16); }
DI float bfhi(unsigned w) { return __uint_as_float(w & 0xffff0000u); }
DI float bf2f(bf16_t v) { return __uint_as_float(((unsigned)v) << 16); }
DI bf16_t f2bf(float f) { return (bf16_t)(pk2(f, 0.f) & 0xffffu); }
DI float xshfl(float v, int o, int lane) { return __int_as_float(__builtin_amdgcn_ds_bpermute((lane ^ o) << 2, __float_as_int(v))); }
DI float wave_sum(float v, int lane) {
#pragma unroll
    for (int o = 1; o < 64; o <<= 1) v += xshfl(v, o, lane);
    return v;
}
#define LDS_WAIT() asm volatile("s_waitcnt lgkmcnt(0)" ::: "memory")

constexpr int NB = 16, SEQ = 4096, CTXL = 256, DM = 1024, RL = NB * SEQ, RC = NB * CTXL, RT = RL + RC, NKEY = SEQ + CTXL;
constexpr int NIN = 1440, NINP = 1536, DFF = 4096;
constexpr int COL_KR = 128, COL_Q = 160, COL_POOL = 416, COL_HY = 672;
constexpr float EPS = 1e-6f;
constexpr float QSCALE = 0.10206207261596575f * 1.4426950408889634f;

constexpr size_t al256(size_t x) { return (x + 255) & ~(size_t)255; }
constexpr size_t SZ_WIN = (size_t)NINP * 1024 * 2, SZ_WQ = 768 * 256 * 2, SZ_WKN = 512 * 128 * 2, SZ_WV = 512 * 128 * 2, SZ_WPOOL = 256 * 256 * 2,
                 SZ_WOUT = 1024 * 1024 * 2, SZ_WM1 = (size_t)4096 * 1024 * 2, SZ_WM2 = (size_t)4096 * 1024 * 2;
constexpr size_t WO_IN = 0, WO_Q = WO_IN + SZ_WIN, WO_KN = WO_Q + SZ_WQ, WO_V = WO_KN + SZ_WKN, WO_POOL = WO_V + SZ_WV, WO_OUT = WO_POOL + SZ_WPOOL,
                 WO_M1 = WO_OUT + SZ_WOUT, WO_M2 = WO_M1 + SZ_WM1, SZ_WLAYER = WO_M2 + SZ_WM2;
constexpr size_t OFF_W = 0;
constexpr size_t OFF_MOD = al256(OFF_W + 2 * SZ_WLAYER);
constexpr size_t OFF_ROPE = al256(OFF_MOD + (size_t)2 * 17 * 6144 * 4);
constexpr size_t OFF_HL = al256(OFF_ROPE + 64 * 8 * 8);
constexpr size_t OFF_HC = al256(OFF_HL + (size_t)2 * 1024 * 4096 * 4);
constexpr size_t OFF_XC = al256(OFF_HC + (size_t)1024 * 256 * 4);
constexpr size_t OFF_XR = al256(OFF_XC + (size_t)RC * 1024 * 4);
constexpr size_t OFF_HBUF = OFF_XR;
constexpr size_t OFF_BIG = al256(OFF_HBUF + (size_t)RT * 1024 * 2);
constexpr size_t SZ_PROJ = (size_t)RT * NIN * 2, SZ_NQ = (size_t)RT * 384 * 2, SZ_R256 = (size_t)RT * 256 * 2;
constexpr size_t SZ_K = (size_t)NB * 8 * NKEY * 96 * 2, SZ_VT = (size_t)NB * 8 * 64 * NKEY * 2, SZ_XT = (size_t)256 * NB * NKEY * 2;
constexpr size_t SZ_QL = (size_t)NB * 8 * SEQ * 96 * 2, SZ_QC = (size_t)NB * 8 * CTXL * 96 * 2, SZ_ATT = (size_t)RT * 512 * 2;
constexpr size_t OFF_PROJ = OFF_BIG;
constexpr size_t OFF_QL = OFF_PROJ, OFF_QC = OFF_QL + SZ_QL, OFF_ATT = OFF_QC + SZ_QC;
static_assert(SZ_QL + SZ_QC + SZ_ATT <= SZ_PROJ, "overlay 1");
constexpr size_t OFF_NQ = al256(OFF_PROJ + SZ_PROJ);
constexpr size_t OFF_POOLA = OFF_NQ + SZ_NQ;
constexpr size_t OFF_ZT = OFF_NQ, OFF_HYT = OFF_ZT + SZ_XT;
static_assert(2 * SZ_XT <= SZ_NQ + SZ_R256, "overlay 2");
constexpr size_t OFF_K = al256(OFF_POOLA + SZ_R256);
constexpr size_t OFF_VT = al256(OFF_K + SZ_K);
constexpr size_t OFF_POOLO = al256(OFF_VT + SZ_VT);
constexpr size_t OFF_VXT = al256(OFF_POOLO + SZ_R256);
constexpr size_t OFF_BIG_END = al256(OFF_VXT + 3 * SZ_XT);
constexpr size_t OFF_ACT = OFF_BIG;
constexpr size_t SZ_ACT = (size_t)RT * DFF * 2;
static_assert(OFF_ACT + SZ_ACT <= OFF_BIG_END, "act overlay");
constexpr size_t OFF_HBUF2 = OFF_BIG_END;
constexpr size_t OFF_SS = al256(OFF_HBUF2 + (size_t)RT * 1024 * 2);
constexpr size_t OFF_SHW = al256(OFF_SS + (size_t)4 * RT * 4);
constexpr size_t OFF_BAR = al256(OFF_SHW + (size_t)2 * 2 * 17 * 4096 * 4);
constexpr size_t OFF_PART = al256(OFF_BAR + 3456 * 4);
constexpr size_t WS_END = al256(OFF_PART + (size_t)4 * RC * 1024 * 4);
static_assert(WS_END <= ((size_t)1 << 30), "workspace");

constexpr int LDS_BYTES = 131072 + 16;

struct Params {
    const float *x, *c, *ctx, *c_ctx, *w_mod, *b_mod, *g_mix, *g_mlp, *w_in, *g_q, *w_q_up, *g_kv, *w_kv_up, *pool_w, *pool_scale, *hy_conv_w, *hy_conv_b,
        *hy_f_w1, *hy_f_b1, *hy_f_freq1, *hy_f_w2, *hy_f_b2, *hy_f_freq2, *hy_f_w3, *hy_bias, *g_out, *w_out, *w_mlp1, *w_mlp2, *g_final;
    float* out; unsigned char* ws;
};

namespace pg8 {
#define PG8_LAS __attribute__((address_space(3)))
constexpr int BM = 256, BK = 64, HALF = 128, HTB = HALF * BK * 2, STAGE_BYTES = 8 * HTB, NXCD = 8, WGM = 8;
DI int lds_byte(int r, int c) { const int st = (r >> 4) * 2 + (c >> 5), rr = r & 15, cc = c & 31, ob = rr * 64 + cc * 2; return st * 1024 + (ob ^ (((ob >> 9) & 1) << 5)); }
DI void stage_rc(int b, int& R, int& C) { const int st = b / 1024, sb = b % 1024, swz = sb ^ (((sb >> 9) & 1) << 5); R = (st >> 1) * 16 + swz / 64; C = (st & 1) * 32 + (swz % 64) / 2; }
DI int perm32(int rho) { const int n = rho >> 4, i = rho & 15; return 8 * (i >> 2) + 4 * n + (i & 3); }
struct Unit { int pm, pn; };
struct Gemm { const bf16_t* A; const bf16_t* Bt; int M, N, K, lda, ldb; int mt; size_t kso; };
DI void unit_ptrs(const Gemm& g, const Unit& u, size_t tstepA, size_t tstepB, const char*& a, const char*& b) {
    int pm = u.pm; size_t ko = 0;
    if (g.mt) { const int ks = pm / g.mt; pm -= ks * g.mt; ko = (size_t)ks * g.kso; }
    a = (const char*)g.A + (size_t)pm * tstepA + ko; b = (const char*)g.Bt + (size_t)u.pn * tstepB + ko;
}
struct StaticOrder {
    int nM, nN, nwg, G, c;
    DI void init(int M, int N, int G_, int c_) { nM = M / BM; nN = N / BM; nwg = nM * nN; G = G_; c = c_; }
    DI bool next(int i, Unit& u) const {
        const long L = (long)i * G + c; if (L >= nwg) return false;
        int wgid = (int)L; { const int q = nwg / NXCD, r = nwg % NXCD, xcd = wgid % NXCD, off = wgid / NXCD; wgid = (xcd < r ? xcd * (q + 1) : r * (q + 1) + (xcd - r) * q) + off; }
        const int nig = WGM * nN, gid = wgid / nig, fm = gid * WGM, gsz = (nM - fm) < WGM ? (nM - fm) : WGM;
        u.pm = fm + ((wgid % nig) % gsz); u.pn = (wgid % nig) / gsz; return true;
    }
};
template <class Epi, bool ALIGN_EPI = true, bool SP2 = true>
DI void gemm_phase(PG8_LAS unsigned char* lds, const int tid, const Gemm g, const StaticOrder& S, const Epi& E) {
    const int wid = __builtin_amdgcn_readfirstlane(tid >> 6), lane = tid & 63, wr = wid >> 2, wc = wid & 3, fr = lane & 15, fq = lane >> 4;
    const int K = g.K, nt = K / BK;
    unsigned voffA[2], voffB[2];
#pragma unroll
    for (int i = 0; i < 2; ++i) { int R, C; stage_rc(tid * 16 + i * 8192, R, C); const int Rb = Epi::PERM ? ((R & ~31) + perm32(R & 31)) : R;
        voffA[i] = (unsigned)(R * g.lda + C) * 2u; voffB[i] = (unsigned)(Rb * g.ldb + C) * 2u; }
    const size_t kstep = (size_t)(BK * 2);
    const size_t hstepA = (size_t)HALF * g.lda * 2, hstepB = (size_t)HALF * g.ldb * 2;
    const size_t tstepA = 2 * hstepA, tstepB = 2 * hstepB;
    const unsigned ldsw = (unsigned)wid * 1024u;
    const int aoff = lds_byte(wr * 64 + fr, fq * 8), boff = lds_byte(wc * 32 + fr, fq * 8);
#define PG8_SA(b, h) (((b) * 2 + (h)) * HTB)
#define PG8_SB(b, h) ((4 + (b) * 2 + (h)) * HTB)
#define PG8_STAGE(bufoff, gbase, voff) do { _Pragma("unroll") for (int _i = 0; _i < 2; ++_i) \
        __builtin_amdgcn_global_load_lds((const unsigned*)((const char*)(gbase) + (voff)[_i]), (PG8_LAS unsigned*)(lds + (bufoff) + ldsw + _i * 8192), 16, 0, 0); } while (0)
#define PG8_LDA(dst, b, h) do { _Pragma("unroll") for (int m = 0; m < 4; ++m) _Pragma("unroll") for (int k = 0; k < 2; ++k) dst[m][k] = *(const PG8_LAS bf16x8*)(lds + PG8_SA(b, h) + aoff + m * 2048 + k * 1024); } while (0)
#define PG8_LDB(dst, b, h) do { _Pragma("unroll") for (int n = 0; n < 2; ++n) _Pragma("unroll") for (int k = 0; k < 2; ++k) dst[n][k] = *(const PG8_LAS bf16x8*)(lds + PG8_SB(b, h) + boff + n * 2048 + k * 1024); } while (0)
#define PG8_MMA(ai, bj, At, Bt) do { __builtin_amdgcn_s_setprio(1); _Pragma("unroll") for (int m = 0; m < 4; ++m) _Pragma("unroll") for (int n = 0; n < 2; ++n) _Pragma("unroll") for (int k = 0; k < 2; ++k) \
        acc[ai][bj][m][n] = __builtin_amdgcn_mfma_f32_16x16x32_bf16(Bt[n][k], At[m][k], acc[ai][bj][m][n], 0, 0, 0); __builtin_amdgcn_s_setprio(0); } while (0)
#define PG8_WAIT_V(n) asm volatile("s_waitcnt vmcnt(" #n ")" ::: "memory")
#define PG8_WAIT_L(n) asm volatile("s_waitcnt lgkmcnt(" #n ")" ::: "memory")
#define PG8_BAR __builtin_amdgcn_s_barrier()
#define PG8_SCHED __builtin_amdgcn_sched_barrier(0)
    Unit cur, nxt; int ui = 0;
    if (!S.next(0, cur)) return;
    f32x4 acc[2][2][4][2];
#pragma unroll
    for (int a = 0; a < 2; ++a)
#pragma unroll
        for (int b = 0; b < 2; ++b)
#pragma unroll
            for (int m = 0; m < 4; ++m)
#pragma unroll
                for (int n = 0; n < 2; ++n) acc[a][b][m][n] = (f32x4){0.f, 0.f, 0.f, 0.f};
    bf16x8 At[4][2], B0[2][2], B1[2][2];
    const char* cA; const char* cB; unit_ptrs(g, cur, tstepA, tstepB, cA, cB);
    if constexpr (SP2) {
        PG8_STAGE(PG8_SB(0, 0), cB, voffB); PG8_STAGE(PG8_SB(0, 1), cB + hstepB, voffB); PG8_STAGE(PG8_SA(0, 0), cA, voffA); PG8_STAGE(PG8_SA(0, 1), cA + hstepA, voffA);
        if (wr == 1) PG8_BAR;
        PG8_WAIT_V(2); PG8_BAR;
        PG8_STAGE(PG8_SB(1, 0), cB + kstep, voffB); PG8_STAGE(PG8_SA(1, 0), cA + kstep, voffA); PG8_STAGE(PG8_SB(1, 1), cB + hstepB + kstep, voffB);
        PG8_WAIT_V(6); PG8_BAR;
    } else {
        PG8_STAGE(PG8_SB(0, 0), cB, voffB); PG8_STAGE(PG8_SA(0, 0), cA, voffA); PG8_STAGE(PG8_SB(0, 1), cB + hstepB, voffB); PG8_STAGE(PG8_SA(0, 1), cA + hstepA, voffA);
        if (wr == 1) PG8_BAR;
        PG8_WAIT_V(4); PG8_BAR;
        PG8_STAGE(PG8_SB(1, 0), cB + kstep, voffB); PG8_STAGE(PG8_SA(1, 0), cA + kstep, voffA); PG8_STAGE(PG8_SB(1, 1), cB + hstepB + kstep, voffB);
        PG8_WAIT_V(6); PG8_BAR;
    }
    for (;;) {
        const bool has_next = S.next(ui + 1, nxt);
        const char* nA = cA; const char* nB = cB; if (has_next) unit_ptrs(g, nxt, tstepA, tstepB, nA, nB);
        for (int t = 0; t < nt; t += 2) {
            const bool last = (t == nt - 2);
            const char* a1 = cA + (size_t)(t + 1) * kstep;
            const char* a2 = last ? nA : cA + (size_t)(t + 2) * kstep; const char* b2 = last ? nB : cB + (size_t)(t + 2) * kstep;
            const char* a3 = a2 + kstep; const char* b3 = b2 + kstep;
            if constexpr (SP2) {
            PG8_LDB(B0, 0, 0); PG8_LDB(B1, 0, 1); PG8_SCHED; PG8_LDA(At, 0, 0); PG8_STAGE(PG8_SA(1, 1), a1 + hstepA, voffA);
            PG8_WAIT_V(8); PG8_WAIT_L(0); PG8_BAR; PG8_MMA(0, 0, At, B0); PG8_MMA(0, 1, At, B1); PG8_BAR; PG8_SCHED;
            PG8_LDA(At, 0, 1); PG8_STAGE(PG8_SB(0, 0), b2, voffB); PG8_STAGE(PG8_SB(0, 1), b2 + hstepB, voffB); PG8_STAGE(PG8_SA(0, 0), a2, voffA);
            PG8_WAIT_V(8); PG8_WAIT_L(0); PG8_BAR; PG8_MMA(1, 0, At, B0); PG8_MMA(1, 1, At, B1); PG8_BAR; PG8_SCHED;
            PG8_LDB(B0, 1, 0); PG8_LDB(B1, 1, 1); PG8_SCHED; PG8_LDA(At, 1, 0); PG8_STAGE(PG8_SA(0, 1), a2 + hstepA, voffA);
            PG8_WAIT_V(8); PG8_WAIT_L(0); PG8_BAR; PG8_MMA(0, 0, At, B0); PG8_MMA(0, 1, At, B1); PG8_BAR; PG8_SCHED;
            PG8_LDA(At, 1, 1); PG8_STAGE(PG8_SB(1, 0), b3, voffB); PG8_STAGE(PG8_SB(1, 1), b3 + hstepB, voffB); PG8_STAGE(PG8_SA(1, 0), a3, voffA);
            PG8_WAIT_V(8); PG8_WAIT_L(0); PG8_BAR; PG8_MMA(1, 0, At, B0); PG8_MMA(1, 1, At, B1); PG8_BAR; PG8_SCHED;
            } else {
            PG8_LDB(B0, 0, 0); PG8_SCHED; PG8_LDA(At, 0, 0); PG8_STAGE(PG8_SA(1, 1), a1 + hstepA, voffA);
            PG8_WAIT_L(8); PG8_BAR; PG8_WAIT_L(0); PG8_MMA(0, 0, At, B0); PG8_BAR; PG8_SCHED;
            PG8_LDB(B1, 0, 1); PG8_STAGE(PG8_SB(0, 0), b2, voffB);
            PG8_BAR; PG8_WAIT_L(0); PG8_MMA(0, 1, At, B1); PG8_BAR;
            PG8_LDA(At, 0, 1); PG8_STAGE(PG8_SA(0, 0), a2, voffA);
            PG8_BAR; PG8_WAIT_L(0); PG8_MMA(1, 0, At, B0); PG8_BAR; PG8_SCHED;
            PG8_STAGE(PG8_SB(0, 1), b2 + hstepB, voffB);
            PG8_WAIT_V(6); PG8_BAR; PG8_MMA(1, 1, At, B1); PG8_BAR;
            PG8_LDB(B0, 1, 0); PG8_SCHED; PG8_LDA(At, 1, 0); PG8_STAGE(PG8_SA(0, 1), a2 + hstepA, voffA);
            PG8_WAIT_L(8); PG8_BAR; PG8_WAIT_L(0); PG8_MMA(0, 0, At, B0); PG8_BAR; PG8_SCHED;
            PG8_LDB(B1, 1, 1); PG8_STAGE(PG8_SB(1, 0), b3, voffB);
            PG8_BAR; PG8_WAIT_L(0); PG8_MMA(0, 1, At, B1); PG8_BAR;
            PG8_LDA(At, 1, 1); PG8_STAGE(PG8_SA(1, 0), a3, voffA);
            PG8_BAR; PG8_WAIT_L(0); PG8_MMA(1, 0, At, B0); PG8_BAR; PG8_SCHED;
            PG8_STAGE(PG8_SB(1, 1), b3 + hstepB, voffB);
            PG8_WAIT_V(6); PG8_BAR; PG8_MMA(1, 1, At, B1); PG8_BAR;
            }
        }
        if constexpr (ALIGN_EPI) { if (wr == 0) PG8_BAR; }
        E(acc, cur, wr, wc, fr, fq);
        if (!has_next) break;
#pragma unroll
        for (int a = 0; a < 2; ++a)
#pragma unroll
            for (int b = 0; b < 2; ++b)
#pragma unroll
                for (int m = 0; m < 4; ++m)
#pragma unroll
                    for (int n = 0; n < 2; ++n) acc[a][b][m][n] = (f32x4){0.f, 0.f, 0.f, 0.f};
        cur = nxt; cA = nA; cB = nB; ++ui;
        if constexpr (ALIGN_EPI) { if (wr == 1) PG8_BAR; }
    }
    PG8_WAIT_V(0);
    if constexpr (!ALIGN_EPI) { if (wr == 0) PG8_BAR; }
    PG8_BAR;
#undef PG8_SA
#undef PG8_SB
#undef PG8_STAGE
#undef PG8_LDA
#undef PG8_LDB
#undef PG8_MMA
#undef PG8_WAIT_V
#undef PG8_WAIT_L
#undef PG8_BAR
#undef PG8_SCHED
}
}
using pg8::Unit;
typedef const f32x4 (&AccRef)[2][2][4][2];

template <int ACT> struct EpiBf16 {
    static constexpr bool PERM = true;
    bf16_t* O; int ldc, ncols;
    DI void operator()(AccRef acc, const Unit& u, int wr, int wc, int fr_, int fq_) const {
        int fr = fr_, fq = fq_; asm volatile("" : "+v"(fr), "+v"(fq));
        const int row0 = u.pm * 256 + wr * 64 + fr, col0 = u.pn * 256 + wc * 32 + 8 * fq;
#pragma unroll
        for (int ai = 0; ai < 2; ++ai)
#pragma unroll
            for (int m = 0; m < 4; ++m) { bf16_t* rowp = O + (size_t)(row0 + ai * 128 + m * 16) * ldc + col0;
#pragma unroll
                for (int bj = 0; bj < 2; ++bj) { f32x4 v0 = acc[ai][bj][m][0], v1 = acc[ai][bj][m][1];
                    if (ACT == 1) {
#pragma unroll
                        for (int j = 0; j < 4; ++j) { const float a = fmaxf(v0[j], 0.f), b = fmaxf(v1[j], 0.f); v0[j] = a * a; v1[j] = b * b; } }
                    u32x4 w; w.x = pk2(v0[0], v0[1]); w.y = pk2(v0[2], v0[3]); w.z = pk2(v1[0], v1[1]); w.w = pk2(v1[2], v1[3]);
                    if (col0 + bj * 128 < ncols) *(u32x4*)(rowp + bj * 128) = w; } }
    }
};
template <bool FUSE> struct EpiResid {
    static constexpr bool PERM = false;
    const float* srcL; float* dstL; const float* srcC; float* dstC; const float* gate;
    bf16_t* A2; float* ss; const float* gain; const float* scl;
    DI void operator()(AccRef acc, const Unit& u, int wr, int wc, int fr_, int fq_) const {
        int fr = fr_, fq = fq_; asm volatile("" : "+v"(fr), "+v"(fq));
        const int row0 = u.pm * 256 + wr * 64 + fr, col0 = u.pn * 256 + wc * 32 + 4 * fq, ln = fq * 16 + fr;
        const bool isctx = (u.pm * 256) >= RL;
        const int mrt = isctx ? 16 : ((u.pm * 256) >> 12);
        const float* sbase = isctx ? srcC - (size_t)RL * 1024 : srcL; float* dbase = isctx ? dstC - (size_t)RL * 1024 : dstL;
        const float* gp = gate + (size_t)mrt * 6144;
        f32x4 gv[2][2], gs[2][2];
#pragma unroll
        for (int bj = 0; bj < 2; ++bj)
#pragma unroll
            for (int n = 0; n < 2; ++n) { const int c = col0 + bj * 128 + n * 16; gv[bj][n] = *(const f32x4*)(gp + c);
                if (FUSE) gs[bj][n] = *(const f32x4*)(gain + c) * (*(const f32x4*)(scl + (size_t)mrt * 6144 + c) + 1.0f); }
#pragma unroll
        for (int ai = 0; ai < 2; ++ai)
#pragma unroll
          for (int mp = 0; mp < 2; ++mp) {
            f32x4 xv[2][2][2];
#pragma unroll
            for (int mm = 0; mm < 2; ++mm)
#pragma unroll
                for (int bj = 0; bj < 2; ++bj)
#pragma unroll
                    for (int n = 0; n < 2; ++n) xv[mm][bj][n] = *(const f32x4*)(sbase + (size_t)(row0 + ai * 128 + (2 * mp + mm) * 16) * 1024 + col0 + bj * 128 + n * 16);
#pragma unroll
            for (int mm = 0; mm < 2; ++mm) { const int m = 2 * mp + mm; const int r = row0 + ai * 128 + m * 16;
                float part = 0.f;
#pragma unroll
                for (int bj = 0; bj < 2; ++bj)
#pragma unroll
                    for (int n = 0; n < 2; ++n) { const int c = col0 + bj * 128 + n * 16;
                        const f32x4 xn = xv[mm][bj][n] + gv[bj][n] * acc[ai][bj][m][n];
                        *(f32x4*)(dbase + (size_t)r * 1024 + c) = xn;
                        if (FUSE) { const f32x4 an = xn * gs[bj][n]; u32x2 w; w.x = pk2(an[0], an[1]); w.y = pk2(an[2], an[3]); *(u32x2*)(A2 + (size_t)r * 1024 + c) = w;
                            part += (xn[0] * xn[0] + xn[1] * xn[1]) + (xn[2] * xn[2] + xn[3] * xn[3]); } }
                if (FUSE) { part += xshfl(part, 16, ln); part += xshfl(part, 32, ln);
                    if (fq == 0) (void)__hip_atomic_fetch_add((__attribute__((address_space(1))) float*)(ss + r), part, __ATOMIC_RELAXED, __HIP_MEMORY_SCOPE_AGENT); } }
          }
    }
};
template <bool SRC_F32, bool FUSE> struct EpiResid2 {
    static constexpr bool PERM = true;
    const float* srcL; const float* srcC; bf16_t* xr; const float* gate;
    bf16_t* A2; float* ss; const float* gain; const float* scl;
    DI void operator()(AccRef acc, const Unit& u, int wr, int wc, int fr_, int fq_) const {
        int fr = fr_, fq = fq_; asm volatile("" : "+v"(fr), "+v"(fq));
        typedef __attribute__((address_space(1))) float gfloat; typedef __attribute__((address_space(1))) unsigned short gbf16;
        typedef __attribute__((address_space(1))) f32x4 gf32x4; typedef __attribute__((address_space(1))) u32x4 gu32x4;
        const int row0 = u.pm * 256 + wr * 64 + fr, col0 = u.pn * 256 + wc * 32 + 8 * fq, ln = fq * 16 + fr;
        const bool isctx = (u.pm * 256) >= RL;
        const int mrt = isctx ? 16 : ((u.pm * 256) >> 12);
        const gfloat* __restrict__ sbase = (const gfloat*)(isctx ? srcC - (size_t)RL * 1024 : srcL);
        gbf16* __restrict__ xb = (gbf16*)xr; gbf16* __restrict__ a2 = (gbf16*)A2;
        const gfloat* __restrict__ gp = (const gfloat*)(gate + (size_t)mrt * 6144);
        f32x4 gv[2][2], gs[2][2];
#pragma unroll
        for (int bj = 0; bj < 2; ++bj)
#pragma unroll
            for (int hf = 0; hf < 2; ++hf) { const int c = col0 + bj * 128 + 4 * hf; gv[bj][hf] = *(const gf32x4*)(gp + c);
                if (FUSE) gs[bj][hf] = *(const gf32x4*)((const gfloat*)gain + c) * (*(const gf32x4*)((const gfloat*)scl + (size_t)mrt * 6144 + c) + 1.0f); }
#pragma unroll
        for (int ai = 0; ai < 2; ++ai) {
            constexpr int NB_ = SRC_F32 ? 2 : 1, RB_ = SRC_F32 ? 2 : 4;
#pragma unroll
          for (int mp = 0; mp < NB_; ++mp) {
            f32x4 xf[SRC_F32 ? 2 : 1][2][2]; u32x4 xw[SRC_F32 ? 1 : 4][2];
#pragma unroll
            for (int mm = 0; mm < RB_; ++mm)
#pragma unroll
                for (int bj = 0; bj < 2; ++bj) { const size_t off = (size_t)(row0 + ai * 128 + (RB_ * mp + mm) * 16) * 1024 + col0 + bj * 128;
                    if (SRC_F32) { xf[mm][bj][0] = *(const gf32x4*)(sbase + off); xf[mm][bj][1] = *(const gf32x4*)(sbase + off + 4); }
                    else xw[mm][bj] = *(const gu32x4*)(xb + off); }
#pragma unroll
            for (int mm = 0; mm < RB_; ++mm) { const int m = RB_ * mp + mm; const int r = row0 + ai * 128 + m * 16;
                float part = 0.f;
#pragma unroll
                for (int bj = 0; bj < 2; ++bj) { const size_t off = (size_t)r * 1024 + col0 + bj * 128;
                    f32x4 x0, x1;
                    if (SRC_F32) { x0 = xf[mm][bj][0]; x1 = xf[mm][bj][1]; }
                    else { const u32x4 w = xw[mm][bj]; x0 = (f32x4){bflo(w.x), bfhi(w.x), bflo(w.y), bfhi(w.y)}; x1 = (f32x4){bflo(w.z), bfhi(w.z), bflo(w.w), bfhi(w.w)}; }
                    const f32x4 n0 = x0 + gv[bj][0] * acc[ai][bj][m][0], n1 = x1 + gv[bj][1] * acc[ai][bj][m][1];
                    u32x4 o; o.x = pk2(n0[0], n0[1]); o.y = pk2(n0[2], n0[3]); o.z = pk2(n1[0], n1[1]); o.w = pk2(n1[2], n1[3]);
                    *(gu32x4*)(xb + off) = o;
                    if (FUSE) { const f32x4 a0 = n0 * gs[bj][0], a1 = n1 * gs[bj][1];
                        u32x4 w2; w2.x = pk2(a0[0], a0[1]); w2.y = pk2(a0[2], a0[3]); w2.z = pk2(a1[0], a1[1]); w2.w = pk2(a1[2], a1[3]);
                        *(gu32x4*)(a2 + off) = w2;
                        part += ((n0[0] * n0[0] + n0[1] * n0[1]) + (n0[2] * n0[2] + n0[3] * n0[3])) + ((n1[0] * n1[0] + n1[1] * n1[1]) + (n1[2] * n1[2] + n1[3] * n1[3])); } }
                if (FUSE) { part += xshfl(part, 16, ln); part += xshfl(part, 32, ln);
                    if (fq == 0) (void)__hip_atomic_fetch_add((__attribute__((address_space(1))) float*)(ss + r), part, __ATOMIC_RELAXED, __HIP_MEMORY_SCOPE_AGENT); } }
          }
        }
    }
};
template <int ACT> struct EpiNormBf16 {
    static constexpr bool PERM = true;
    bf16_t* O; int ldc, ncols; const float* ss; const float* shw;
    DI void operator()(AccRef acc, const Unit& u, int wr, int wc, int fr_, int fq_) const {
        int fr = fr_, fq = fq_; asm volatile("" : "+v"(fr), "+v"(fq));
        const int row0 = u.pm * 256 + wr * 64 + fr, col0 = u.pn * 256 + wc * 32 + 8 * fq;
        const int mrt = (u.pm * 256 < RL) ? ((u.pm * 256) >> 12) : 16;
        f32x4 sv[2][2];
#pragma unroll
        for (int bj = 0; bj < 2; ++bj) { sv[bj][0] = *(const f32x4*)(shw + (size_t)mrt * 4096 + col0 + bj * 128); sv[bj][1] = *(const f32x4*)(shw + (size_t)mrt * 4096 + col0 + bj * 128 + 4); }
#pragma unroll
        for (int ai = 0; ai < 2; ++ai)
#pragma unroll
            for (int m = 0; m < 4; ++m) { const int r = row0 + ai * 128 + m * 16; bf16_t* rowp = O + (size_t)r * ldc + col0;
                const float rs = rsqrtf(ss[r] * (1.f / 1024.f) + EPS);
#pragma unroll
                for (int bj = 0; bj < 2; ++bj) { f32x4 v0 = acc[ai][bj][m][0] * rs + sv[bj][0], v1 = acc[ai][bj][m][1] * rs + sv[bj][1];
                    if (ACT == 1) {
#pragma unroll
                        for (int jx = 0; jx < 4; ++jx) { const float a = fmaxf(v0[jx], 0.f), b = fmaxf(v1[jx], 0.f); v0[jx] = a * a; v1[jx] = b * b; } }
                    u32x4 w; w.x = pk2(v0[0], v0[1]); w.y = pk2(v0[2], v0[3]); w.z = pk2(v1[0], v1[1]); w.w = pk2(v1[2], v1[3]);
                    if (col0 + bj * 128 < ncols) *(u32x4*)(rowp + bj * 128) = w; } }
    }
};
struct EpiPartial {
    static constexpr bool PERM = false;
    float* part;
    DI void operator()(AccRef acc, const Unit& u, int wr, int wc, int fr_, int fq_) const {
        int fr = fr_, fq = fq_; asm volatile("" : "+v"(fr), "+v"(fq));
        const int ks = u.pm >> 4, pm = u.pm & 15;
        const int row0 = pm * 256 + wr * 64 + fr, col0 = u.pn * 256 + wc * 32 + 4 * fq;
        float* base = part + ((size_t)ks * RC + row0) * 1024 + col0;
#pragma unroll
        for (int ai = 0; ai < 2; ++ai)
#pragma unroll
            for (int m = 0; m < 4; ++m)
#pragma unroll
                for (int bj = 0; bj < 2; ++bj)
#pragma unroll
                    for (int n = 0; n < 2; ++n) *(f32x4*)(base + (size_t)(ai * 128 + m * 16) * 1024 + bj * 128 + n * 16) = acc[ai][bj][m][n];
    }
};
struct EpiQ {
    static constexpr bool PERM = false;
    bf16_t* QL; bf16_t* QC; const f32x2* rope;
    DI void operator()(AccRef acc, const Unit& u, int wr, int wc, int fr_, int fq_) const {
        int fr = fr_, fq = fq_; asm volatile("" : "+v"(fr), "+v"(fq));
        const int row0 = u.pm * 256 + wr * 64 + fr, colb = u.pn * 256 + wc * 32;
        const bool isctx = (u.pm * 256) >= RL;
#pragma unroll
        for (int ai = 0; ai < 2; ++ai)
#pragma unroll
            for (int m = 0; m < 4; ++m) { const int r = row0 + ai * 128 + m * 16;
                int b, t; bf16_t* qb;
                if (!isctx) { b = r >> 12; t = r & 4095; qb = QL + ((size_t)b * 8 * SEQ + t) * 96; }
                else { const int rc = r - RL; b = rc >> 8; t = rc & 255; qb = QC + ((size_t)b * 8 * CTXL + t) * 96; }
                const size_t hstride = (size_t)(isctx ? CTXL : SEQ) * 96;
#pragma unroll
                for (int bj = 0; bj < 2; ++bj)
#pragma unroll
                    for (int n = 0; n < 2; ++n) { const int cg0 = colb + bj * 128 + n * 16;
                        const int h = cg0 / 96, cc0 = cg0 - h * 96;
                        f32x4 v = acc[ai][bj][m][n];
                        const int ln = fq * 16 + fr; f32x4 pv; pv[0] = xshfl(v[0], 32, ln); pv[1] = xshfl(v[1], 32, ln); pv[2] = xshfl(v[2], 32, ln); pv[3] = xshfl(v[3], 32, ln);
                        if (cc0 >= 64 && !isctx) { const int axis = (cc0 - 64) >> 4, half = fq >> 1, f0 = 4 * (fq & 1); const int p = axis ? (t & 63) : (t >> 6);
#pragma unroll
                            for (int i = 0; i < 4; ++i) { const f32x2 cs = rope[p * 8 + f0 + i]; v[i] = half ? (v[i] * cs.x + pv[i] * cs.y) : (v[i] * cs.x - pv[i] * cs.y); } }
                        u32x2 w; w.x = pk2(v[0] * QSCALE, v[1] * QSCALE); w.y = pk2(v[2] * QSCALE, v[3] * QSCALE);
                        *(u32x2*)(qb + (size_t)h * hstride + cc0 + 4 * fq) = w; } }
    }
};
struct EpiKn {
    static constexpr bool PERM = true;
    bf16_t* Kb;
    DI void operator()(AccRef acc, const Unit& u, int wr, int wc, int fr_, int fq_) const {
        int fr = fr_, fq = fq_; asm volatile("" : "+v"(fr), "+v"(fq));
        const int row0 = u.pm * 256 + wr * 64 + fr, col0 = u.pn * 256 + wc * 32 + 8 * fq;
#pragma unroll
        for (int ai = 0; ai < 2; ++ai)
#pragma unroll
            for (int m = 0; m < 4; ++m) { const int r = row0 + ai * 128 + m * 16; int b, pos;
                if (r < RL) { b = r >> 12; pos = CTXL + (r & 4095); } else { const int rc = r - RL; b = rc >> 8; pos = rc & 255; }
#pragma unroll
                for (int bj = 0; bj < 2; ++bj) { const int c = col0 + bj * 128, h = c >> 6, j = c & 63;
                    const f32x4 v0 = acc[ai][bj][m][0], v1 = acc[ai][bj][m][1];
                    u32x4 w; w.x = pk2(v0[0], v0[1]); w.y = pk2(v0[2], v0[3]); w.z = pk2(v1[0], v1[1]); w.w = pk2(v1[2], v1[3]);
                    *(u32x4*)(Kb + ((size_t)(b * 8 + h) * NKEY + pos) * 96 + j) = w; } }
    }
};
struct EpiVT {
    static constexpr bool PERM = true;
    bf16_t* VT;
    DI void operator()(AccRef acc, const Unit& u, int wr, int wc, int fr_, int fq_) const {
        int fr = fr_, fq = fq_; asm volatile("" : "+v"(fr), "+v"(fq));
        const int row0 = u.pm * 256 + wr * 64 + fr, col0 = u.pn * 256 + wc * 32 + 8 * fq;
#pragma unroll
        for (int ai = 0; ai < 2; ++ai)
#pragma unroll
            for (int m = 0; m < 4; ++m) { const int f = row0 + ai * 128 + m * 16, h = f >> 6, dv = f & 63;
#pragma unroll
                for (int bj = 0; bj < 2; ++bj) { const int r = col0 + bj * 128; int b, pos;
                    if (r < RL) { b = r >> 12; pos = CTXL + (r & 4095); } else { const int rc = r - RL; b = rc >> 8; pos = rc & 255; }
                    const f32x4 v0 = acc[ai][bj][m][0], v1 = acc[ai][bj][m][1];
                    const int a = (pos >> 3) & 1; bf16_t* vp = VT + ((size_t)(b * 8 + h) * 64 + dv) * NKEY + (pos & ~15) + 4 * a;
                    u32x2 wl, wh; wl.x = pk2(v0[0], v0[1]); wl.y = pk2(v0[2], v0[3]); wh.x = pk2(v1[0], v1[1]); wh.y = pk2(v1[2], v1[3]);
                    *(u32x2*)vp = wl; *(u32x2*)(vp + 8) = wh; } }
    }
};

#define XB_TMO      128
#define XB_XCNT(j)  (256  + 64 * (j))
#define XB_XSUB(j)  (1280 + 64 * (j))
#define XB_XGEN(j)  (2304 + 64 * (j))
#define XB_TOP      3328
#define XB_TOPGEN   3392
#define XCD_BAR_WORDS 3456
#define XB_SPIN_CAP (1u << 22)
DI unsigned xb_ld(unsigned* p)              { return __hip_atomic_load(p, __ATOMIC_RELAXED, __HIP_MEMORY_SCOPE_AGENT); }
DI unsigned xb_add(unsigned* p, unsigned v) { return __hip_atomic_fetch_add(p, v, __ATOMIC_RELAXED, __HIP_MEMORY_SCOPE_AGENT); }
DI unsigned xb_xcc_id() { return (unsigned)__builtin_amdgcn_s_getreg((3 << 11) | 20) & 0xFu; }
#define XB_SPIN(cond, bar) do { unsigned _sp = 0; while (cond) { __builtin_amdgcn_s_sleep(1); \
    if ((++_sp & 255u) == 0u) { if (xb_ld(&(bar)[XB_TMO])) break; if (_sp > XB_SPIN_CAP) { atomicAdd(&(bar)[XB_TMO], 1u); break; } } } } while (0)
DI void xcd_barrier_post(unsigned* bar, bool t0) { if (t0) (void)xb_add(&bar[XB_XCNT(xb_xcc_id())], 1u); }
DI void xcd_barrier_complete(unsigned* bar, unsigned x, unsigned& nloc, unsigned& nx) {
    const unsigned G = gridDim.x;
    unsigned sum, cnt, mine, sp = 0u;
    for (;;) {
        sum = 0u; cnt = 0u; mine = 0u;
#pragma unroll
        for (unsigned j = 0; j < 16; ++j) { const unsigned c = xb_ld(&bar[XB_XCNT(j)]); sum += c; cnt += (c > 0u) ? 1u : 0u; mine = (j == x) ? c : mine; }
        if (sum == G) break;
        __builtin_amdgcn_s_sleep(1);
        if ((++sp & 255u) == 0u) { if (xb_ld(&bar[XB_TMO])) break; if (sp > XB_SPIN_CAP) { atomicAdd(&bar[XB_TMO], 1u); break; } }
    }
    nloc = mine > 0u ? mine : 1u; nx = cnt > 0u ? cnt : 1u;
}
DI void xcd_barrier(unsigned* bar, volatile LAS unsigned* st, bool t0) {
    asm volatile("s_waitcnt vmcnt(0)" ::: "memory");
    __syncthreads();
    if (t0) {
        const unsigned x = xb_xcc_id();
        __builtin_amdgcn_s_waitcnt(0);
        unsigned nloc = st[0], nx = st[1];
        if (nloc == 0u) { xcd_barrier_complete(bar, x, nloc, nx); st[0] = nloc; st[1] = nx; }
        const unsigned old = xb_add(&bar[XB_XSUB(x)], 1u);
        const unsigned gen = old / nloc;
        if (old + 1u == (gen + 1u) * nloc) {
            __builtin_amdgcn_fence(__ATOMIC_RELEASE, "agent");
            asm volatile("s_waitcnt vmcnt(0)" ::: "memory");
            const unsigned og = xb_add(&bar[XB_TOP], 1u);
            const unsigned tg = og / nx;
            if (og + 1u == (tg + 1u) * nx) xb_add(&bar[XB_TOPGEN], 1u);
            else XB_SPIN(xb_ld(&bar[XB_TOPGEN]) == tg, bar);
            __builtin_amdgcn_fence(__ATOMIC_ACQUIRE, "agent");
            xb_add(&bar[XB_XGEN(x)], 1u);
            asm volatile("s_waitcnt vmcnt(0)" ::: "memory");
        } else {
            XB_SPIN(xb_ld(&bar[XB_XGEN(x)]) == gen, bar);
            __builtin_amdgcn_fence(__ATOMIC_ACQUIRE, "agent");
            asm volatile("s_waitcnt vmcnt(0)" ::: "memory");
        }
    }
    __syncthreads();
}

struct Ctx {
    LAS unsigned char* lds; int tid, lane, wave, G, bid;
};

DI void transpose_item(const float* W, int ldw, int k0, int n0, bf16_t* WT, int ldt, int orow0, LAS float* scr, int lane) {
#pragma unroll 8
    for (int i = 0; i < 32; ++i) { const int kk = 2 * i + (lane >> 5); scr[kk * 33 + (lane & 31)] = W[(size_t)(k0 + kk) * ldw + n0 + (lane & 31)]; }
    LDS_WAIT();
    const int c = lane & 7;
#pragma unroll
    for (int j = 0; j < 4; ++j) { const int n = (lane >> 3) + 8 * j; const LAS float* s = scr + (8 * c) * 33 + n;
        u32x4 o; o.x = pk2(s[0 * 33], s[1 * 33]); o.y = pk2(s[2 * 33], s[3 * 33]); o.z = pk2(s[4 * 33], s[5 * 33]); o.w = pk2(s[6 * 33], s[7 * 33]);
        *(u32x4*)(WT + (size_t)(orow0 + n) * ldt + k0 + 8 * c) = o; }
    LDS_WAIT();
}

DI void setup_adaln(const Params& P, const Ctx& C, int u) {
    const int l = u / 96, j0 = (u % 96) * 64;
    LAS float* sl = (LAS float*)C.lds;
    LAS float* part = sl + 17 * 1024;
    for (int idx = C.tid; idx < 17 * 1024; idx += 512) { const int r = idx >> 10, k = idx & 1023; const float v = (r < 16) ? P.c[r * 1024 + k] : P.c_ctx[k]; sl[idx] = v / (1.f + expf(-v)); }
    __syncthreads();
    const int ks = C.tid >> 6, jj = C.tid & 63;
    float acc[17];
#pragma unroll
    for (int r = 0; r < 17; ++r) acc[r] = 0.f;
    const float* wp = P.w_mod + ((size_t)l * 1024 + ks * 128) * 6144 + j0 + jj;
    for (int k = 0; k < 128; ++k) { const float w = wp[(size_t)k * 6144];
#pragma unroll
        for (int r = 0; r < 17; ++r) acc[r] += sl[r * 1024 + ks * 128 + k] * w; }
#pragma unroll
    for (int r = 0; r < 17; ++r) part[(ks * 17 + r) * 64 + jj] = acc[r];
    __syncthreads();
    float* mod = (float*)(P.ws + OFF_MOD);
    for (int idx = C.tid; idx < 17 * 64; idx += 512) { const int r = idx >> 6, j2 = idx & 63; float s = 0.f;
#pragma unroll
        for (int q = 0; q < 8; ++q) s += part[(q * 17 + r) * 64 + j2];
        mod[((size_t)l * 17 + r) * 6144 + j0 + j2] = s + P.b_mod[l * 6144 + j0 + j2]; }
    __syncthreads();
}

DI void setup_filter(const Params& P, const Ctx& C, int l, int n, int d0, float* H) {
    LAS float* zs = (LAS float*)C.lds;
    LAS float* h1s = zs + 16 * 33;
    LAS float* h2s = h1s + 16 * 64;
    for (int idx = C.tid; idx < 16 * 33; idx += 512) { const int p = idx / 33, e = idx - p * 33; const int d = d0 + p; float v;
        if (e == 0) v = (float)d / (float)(n - 1);
        else { const int k = (e - 1) & 15; const float fr = 1e-4f + (float)k * ((15.0f - 1e-4f) / 15.0f); const float wp = 6.283185307179586f * (float)d / (float)n; const float ang = fr * wp;
            v = (e <= 16) ? cosf(ang) : -sinf(ang); }
        zs[idx] = v; }
    __syncthreads();
    for (int idx = C.tid; idx < 1024; idx += 512) { const int p = idx >> 6, m = idx & 63; float s = P.hy_f_b1[l * 64 + m];
        for (int e = 0; e < 33; ++e) s += zs[p * 33 + e] * P.hy_f_w1[(l * 33 + e) * 64 + m];
        h1s[idx] = sinf(P.hy_f_freq1[l * 64 + m] * s); }
    __syncthreads();
    for (int idx = C.tid; idx < 1024; idx += 512) { const int p = idx >> 6, m = idx & 63; float s = P.hy_f_b2[l * 64 + m];
        for (int e = 0; e < 64; ++e) s += h1s[p * 64 + e] * P.hy_f_w2[(l * 64 + e) * 64 + m];
        h2s[idx] = sinf(P.hy_f_freq2[l * 64 + m] * s); }
    __syncthreads();
    const float la = -3.0701134573253946f, lb = -15.350567286626973f;
#pragma unroll 1
    for (int cc = 0; cc < 2; ++cc) { const int col = C.tid + 512 * cc;
        float acc[16];
#pragma unroll
        for (int p = 0; p < 16; ++p) acc[p] = 0.f;
        for (int e = 0; e < 64; ++e) { const float w = P.hy_f_w3[((size_t)l * 64 + e) * 1024 + col];
#pragma unroll
            for (int p = 0; p < 16; ++p) acc[p] += h2s[p * 64 + e] * w; }
        const int ch = col & 255; const float delta = fabsf(la + (float)ch * ((lb - la) / 255.0f));
        float* hp = H + (size_t)col * n + d0;
#pragma unroll
        for (int q = 0; q < 4; ++q) { f32x4 o;
#pragma unroll
            for (int i = 0; i < 4; ++i) { const int p = 4 * q + i; const float td = (float)(d0 + p) / (float)(n - 1); o[i] = acc[p] * expf(-td * delta); }
            *(f32x4*)(hp + 4 * q) = o; } }
    __syncthreads();
}

DI void phase_setup(const Params& P, const Ctx& C) {
    unsigned char* ws = P.ws;
    for (int u = C.bid; u < 192 + 512 + 16; u += C.G) {
        if (u < 192) setup_adaln(P, C, u);
        else if (u < 192 + 512) { const int v = u - 192, l = v >> 8, blk = v & 255; setup_filter(P, C, l, SEQ, blk * 16, (float*)(ws + OFF_HL) + (size_t)l * 1024 * 4096); }
        else { const int blk = u - 192 - 512; setup_filter(P, C, 0, CTXL, blk * 16, (float*)(ws + OFF_HC)); }
    }
    if (C.bid == 0) { f32x2* rt = (f32x2*)(ws + OFF_ROPE); const int p = C.tid >> 3, f = C.tid & 7; const float inv = exp2f(-(float)f * (13.287712379549449f / 8.0f)); const float a = (float)p * inv; rt[C.tid] = (f32x2){cosf(a), sinf(a)}; }
    LAS float* scr = (LAS float*)(C.lds + C.wave * 8448);
    const int gw = C.bid * 8 + C.wave, NGW = C.G * 8;
    constexpr int I_IN = 16 * 45, I_Q = 4 * 24, I_KV = 2 * 32, I_OUT = 16 * 32, I_M1 = 16 * 128, I_M2 = 64 * 32, I_L = I_IN + I_Q + I_KV + I_OUT + I_M1 + I_M2;
    for (int it = gw; it < 2 * I_L; it += NGW) {
        const int l = it / I_L; int r = it - l * I_L; unsigned char* wl = ws + OFF_W + (size_t)l * SZ_WLAYER;
        if (r < I_IN) { const int kb = r / 45, nb = r % 45; transpose_item(P.w_in + (size_t)l * 1024 * NIN, NIN, kb * 64, nb * 32, (bf16_t*)(wl + WO_IN), 1024, nb * 32, scr, C.lane); continue; } r -= I_IN;
        if (r < I_Q) { const int kb = r / 24, nb = r % 24; transpose_item(P.w_q_up + (size_t)l * 256 * 768, 768, kb * 64, nb * 32, (bf16_t*)(wl + WO_Q), 256, nb * 32, scr, C.lane); continue; } r -= I_Q;
        if (r < I_KV) { const int kb = r / 32, nb = r % 32, n0 = nb * 32, h = n0 >> 7, j0 = n0 & 127;
            bf16_t* dst = (bf16_t*)(wl + (j0 < 64 ? WO_KN : WO_V)); const int orow = h * 64 + (j0 & 63);
            transpose_item(P.w_kv_up + (size_t)l * 128 * 1024, 1024, kb * 64, n0, dst, 128, orow, scr, C.lane); continue; } r -= I_KV;
        if (r < I_OUT) { const int kb = r / 32, nb = r % 32; transpose_item(P.w_out + (size_t)l * 1024 * 1024, 1024, kb * 64, nb * 32, (bf16_t*)(wl + WO_OUT), 1024, nb * 32, scr, C.lane); continue; } r -= I_OUT;
        if (r < I_M1) { const int kb = r / 128, nb = r % 128; transpose_item(P.w_mlp1 + (size_t)l * 1024 * 4096, 4096, kb * 64, nb * 32, (bf16_t*)(wl + WO_M1), 1024, nb * 32, scr, C.lane); continue; } r -= I_M1;
        { const int kb = r / 32, nb = r % 32; transpose_item(P.w_mlp2 + (size_t)l * 4096 * 1024, 1024, kb * 64, nb * 32, (bf16_t*)(wl + WO_M2), 4096, nb * 32, scr, C.lane); }
    }
    const size_t gt = (size_t)C.bid * 512 + C.tid, NGT = (size_t)C.G * 512;
    for (size_t i = gt; i < (size_t)3 * RT; i += NGT) ((float*)(ws + OFF_SS))[RT + i] = 0.f;
    for (int l = 0; l < 2; ++l) { unsigned char* wl = ws + OFF_W + (size_t)l * SZ_WLAYER;
        for (size_t i = gt; i < 12288; i += NGT) *(u32x4*)(wl + WO_IN + (size_t)NIN * 2048 + i * 16) = (u32x4){0u, 0u, 0u, 0u};
        for (size_t i = gt; i < 65536; i += NGT) { const int n = (int)(i >> 8), k = (int)(i & 255), g = n >> 6;
            const float v = ((k >> 6) == g) ? P.pool_w[((l * 4 + g) * 64 + (k & 63)) * 64 + (n & 63)] * P.pool_scale[l * 256 + n] : 0.f;
            ((bf16_t*)(wl + WO_POOL))[i] = f2bf(v); }
    }
}

DI void shiftw_unit(const Params& P, const Ctx& C, int u) {
    const int l = u / 87, v = u % 87, which = (v >= 23) ? 1 : 0, j0 = (which ? v - 23 : v) * 64, N = which ? DFF : NIN;
    const float* W = which ? P.w_mlp1 + (size_t)l * 1024 * DFF : P.w_in + (size_t)l * 1024 * NIN;
    const float* mod = (const float*)(P.ws + OFF_MOD) + (size_t)l * 17 * 6144 + (which ? 3 : 0) * 1024;
    LAS float* sl = (LAS float*)C.lds;
    LAS float* part = sl + 17 * 1024;
    __syncthreads();
    for (int idx = C.tid; idx < 17 * 1024; idx += 512) { const int r = idx >> 10, k = idx & 1023; sl[idx] = mod[(size_t)r * 6144 + k]; }
    __syncthreads();
    const int ks = C.tid >> 6, jj = C.tid & 63; const bool ok = (j0 + jj) < N;
    float acc[17];
#pragma unroll
    for (int r = 0; r < 17; ++r) acc[r] = 0.f;
    const float* wp = W + (size_t)(ks * 128) * N + j0 + (ok ? jj : 0);
    for (int k = 0; k < 128; ++k) { const float w = wp[(size_t)k * N];
#pragma unroll
        for (int r = 0; r < 17; ++r) acc[r] += sl[r * 1024 + ks * 128 + k] * w; }
#pragma unroll
    for (int r = 0; r < 17; ++r) part[(ks * 17 + r) * 64 + jj] = acc[r];
    __syncthreads();
    float* shw = (float*)(P.ws + OFF_SHW) + (size_t)(l * 2 + which) * 17 * 4096;
    for (int idx = C.tid; idx < 17 * 64; idx += 512) { const int r = idx >> 6, j2 = idx & 63; float sacc = 0.f;
#pragma unroll
        for (int q = 0; q < 8; ++q) sacc += part[(q * 17 + r) * 64 + j2];
        if (j0 + j2 < N) shw[(size_t)r * 4096 + j0 + j2] = sacc; }
}
DI void phase_first(const Params& P, const Ctx& C) {
    const float* mod = (const float*)(P.ws + OFF_MOD);
    const float* gain = P.g_mix;
    bf16_t* hb = (bf16_t*)P.out; float* ss0 = (float*)(P.ws + OFF_SS);
    for (int row = C.bid * 8 + C.wave; row < RT; row += C.G * 8) {
        const float* xr = (row < RL) ? P.x + (size_t)row * 1024 : P.ctx + (size_t)(row - RL) * 1024;
        const int mr = (row < RL) ? (row >> 12) : 16;
        const float* sc = mod + (size_t)mr * 6144 + 1024;
        f32x4 v[4]; float ss = 0.f;
#pragma unroll
        for (int j = 0; j < 4; ++j) { v[j] = *(const f32x4*)(xr + 4 * C.lane + 256 * j); ss += (v[j][0] * v[j][0] + v[j][1] * v[j][1]) + (v[j][2] * v[j][2] + v[j][3] * v[j][3]); }
        ss = wave_sum(ss, C.lane);
        if (C.lane == 0) ss0[row] = ss;
#pragma unroll
        for (int j = 0; j < 4; ++j) { const int c = 4 * C.lane + 256 * j; const f32x4 g = *(const f32x4*)(gain + c), s1 = *(const f32x4*)(sc + c);
            const f32x4 y = v[j] * g * (s1 + 1.0f);
            u32x2 w; w.x = pk2(y[0], y[1]); w.y = pk2(y[2], y[3]);
            *(u32x2*)(hb + (size_t)row * 1024 + c) = w; }
    }
    for (int u = C.bid; u < 174; u += C.G) shiftw_unit(P, C, u);
}

DI float qsum16(float v, int lane) { v += xshfl(v, 1, lane); v += xshfl(v, 2, lane); v += xshfl(v, 4, lane); v += xshfl(v, 8, lane); return v; }
DI void unpack8(const u32x4 w, float (&a)[8]) { a[0] = bflo(w.x); a[1] = bfhi(w.x); a[2] = bflo(w.y); a[3] = bfhi(w.y); a[4] = bflo(w.z); a[5] = bfhi(w.z); a[6] = bflo(w.w); a[7] = bfhi(w.w); }
DI void phase_prep(const Params& P, const Ctx& C, int l) {
    unsigned char* ws = P.ws;
    const bf16_t* proj = (const bf16_t*)(ws + OFF_PROJ);
    bf16_t* NQ = (bf16_t*)(ws + OFF_NQ); bf16_t* Kb = (bf16_t*)(ws + OFF_K); bf16_t* poolA = (bf16_t*)(ws + OFF_POOLA); bf16_t* VXT = (bf16_t*)(ws + OFF_VXT);
    const f32x2* rope = (const f32x2*)(ws + OFF_ROPE);
    const float* gkv = P.g_kv + l * 128; const float* gq = P.g_q + l * 256;
    LAS bf16_t* L = (LAS bf16_t*)C.lds;
    constexpr int LS = 514;
    const int j = C.lane & 15, qw = C.lane >> 4;
    for (int u = C.bid; u < 1280; u += C.G) {
        int row0, b, t0, n, pos_off, ntok; bool isctx;
        if (u < 1024) { row0 = u * 64; b = row0 >> 12; t0 = row0 & 4095; n = SEQ; pos_off = CTXL; isctx = false; ntok = 64; }
        else { const int uc = u - 1024; row0 = RL + uc * 16; b = uc >> 4; t0 = (uc & 15) * 16; n = CTXL; pos_off = 0; isctx = true; ntok = 16; }
        const int lgt = isctx ? 1 : 3;
        const int rowseq = row0 - t0;
#pragma unroll
        for (int itk = 0; itk < 2; ++itk) { const bool act = !isctx || (itk == 0 && C.wave < 4);
            const int tok = !isctx ? (C.wave * 8 + itk * 4 + qw) : (act ? C.wave * 4 + qw : 0), row = row0 + tok, t = t0 + tok;
            const bf16_t* pr = proj + (size_t)row * NIN;
            const u32x4 wkv = *(const u32x4*)(pr + 8 * j), wq0 = *(const u32x4*)(pr + COL_Q + 8 * j), wq1 = *(const u32x4*)(pr + COL_Q + 128 + 8 * j);
            const unsigned wkr = *(const unsigned*)(pr + COL_KR + 2 * j);
            { float a[8]; unpack8(wkv, a); float ss = 0.f;
#pragma unroll
              for (int i = 0; i < 8; ++i) ss += a[i] * a[i];
              const float rs = rsqrtf(qsum16(ss, C.lane) * (1.f / 128.f) + EPS);
              const f32x4 g0 = *(const f32x4*)(gkv + 8 * j), g1 = *(const f32x4*)(gkv + 8 * j + 4);
              u32x4 o; o.x = pk2(a[0] * rs * g0[0], a[1] * rs * g0[1]); o.y = pk2(a[2] * rs * g0[2], a[3] * rs * g0[3]); o.z = pk2(a[4] * rs * g1[0], a[5] * rs * g1[1]); o.w = pk2(a[6] * rs * g1[2], a[7] * rs * g1[3]);
              if (act) *(u32x4*)(NQ + (size_t)row * 384 + 8 * j) = o; }
            { float a[8], c[8]; unpack8(wq0, a); unpack8(wq1, c); float ss = 0.f;
#pragma unroll
              for (int i = 0; i < 8; ++i) ss += a[i] * a[i] + c[i] * c[i];
              const float rs = rsqrtf(qsum16(ss, C.lane) * (1.f / 256.f) + EPS);
              const f32x4 g0 = *(const f32x4*)(gq + 8 * j), g1 = *(const f32x4*)(gq + 8 * j + 4), g2 = *(const f32x4*)(gq + 128 + 8 * j), g3 = *(const f32x4*)(gq + 128 + 8 * j + 4);
              u32x4 o; o.x = pk2(a[0] * rs * g0[0], a[1] * rs * g0[1]); o.y = pk2(a[2] * rs * g0[2], a[3] * rs * g0[3]); o.z = pk2(a[4] * rs * g1[0], a[5] * rs * g1[1]); o.w = pk2(a[6] * rs * g1[2], a[7] * rs * g1[3]);
              if (act) *(u32x4*)(NQ + (size_t)row * 384 + 128 + 8 * j) = o;
              o.x = pk2(c[0] * rs * g2[0], c[1] * rs * g2[1]); o.y = pk2(c[2] * rs * g2[2], c[3] * rs * g2[3]); o.z = pk2(c[4] * rs * g3[0], c[5] * rs * g3[1]); o.w = pk2(c[6] * rs * g3[2], c[7] * rs * g3[3]);
              if (act) *(u32x4*)(NQ + (size_t)row * 384 + 256 + 8 * j) = o; }
            { float x0 = bflo(wkr), x1 = bfhi(wkr); const float p0 = xshfl(x0, 4, C.lane), p1 = xshfl(x1, 4, C.lane);
              if (!isctx) { const int axis = j >> 3, half = (j >> 2) & 1, f = 2 * (j & 3); const int pp = axis ? (t & 63) : (t >> 6); const f32x2 c0 = rope[pp * 8 + f], c1 = rope[pp * 8 + f + 1];
                  x0 = half ? (x0 * c0.x + p0 * c0.y) : (x0 * c0.x - p0 * c0.y); x1 = half ? (x1 * c1.x + p1 * c1.y) : (x1 * c1.x - p1 * c1.y); }
              const unsigned w = pk2(x0, x1);
#pragma unroll
              for (int h = 0; h < 8; ++h) if (act) *(unsigned*)(Kb + ((size_t)(b * 8 + h) * NKEY + pos_off + t) * 96 + 64 + 2 * j) = w; }
        }
        for (int rd = 0; rd < 2; ++rd) {
            const int colbase = COL_POOL + rd * 512;
            __syncthreads();
            { u32x4 v[10];
#pragma unroll
              for (int i = 0; i < 10; ++i) { const int it = C.tid + 512 * i, rr = it >> 6, part = it & 63; const int t = t0 - 8 + rr;
                  v[i] = (u32x4){0u, 0u, 0u, 0u};
                  if (t >= 0 && t < n && rr < ntok + 16) v[i] = *(const u32x4*)(proj + (size_t)(rowseq + t) * NIN + colbase + part * 8); }
#pragma unroll
              for (int i = 0; i < 10; ++i) { const int it = C.tid + 512 * i, rr = it >> 6, part = it & 63;
                  LAS unsigned* d = (LAS unsigned*)(L + rr * LS + part * 8); if (rr < ntok + 16) d[0] = v[i].x; if (rr < ntok + 16) { d[1] = v[i].y; d[2] = v[i].z; d[3] = v[i].w; } } }
            __syncthreads();
            if (rd == 0) {
                for (int it = C.tid; it < ntok * 128; it += 512) { const int tok = it >> 7, cp = it & 127, c = 2 * cp, g = c >> 6, hw = 1 << g;
                    const int t = t0 + tok; const int lo = max(t - hw, 0), hi = min(t + hw, n);
                    float s0 = 0.f, s1 = 0.f;
                    for (int sidx = lo; sidx < hi; ++sidx) { const unsigned w = *(LAS const unsigned*)(L + (sidx - t0 + 8) * LS + c); s0 += bflo(w); s1 += bfhi(w); }
                    const unsigned wc = *(LAS const unsigned*)(L + (tok + 8) * LS + c);
                    const float inv = 1.f / (float)(hi - lo);
                    *(unsigned*)(poolA + (size_t)(row0 + tok) * 256 + c) = pk2(s0 * inv - bflo(wc), s1 * inv - bfhi(wc)); }
            }
            for (int kk = (rd == 0 ? 1 : 0); kk < 2; ++kk) { const int k = rd * 2 + kk - 1;
                const int cb = kk * 256;
                for (int it = C.tid; it < (256 << lgt); it += 512) { const int tg = it & ((1 << lgt) - 1), c = it >> lgt, ch = k * 256 + c;
                    const float w0 = P.hy_conv_w[(l * 3 + 0) * 768 + ch], w1 = P.hy_conv_w[(l * 3 + 1) * 768 + ch], w2 = P.hy_conv_w[(l * 3 + 2) * 768 + ch], bb = P.hy_conv_b[l * 768 + ch];
                    float xv[10];
#pragma unroll
                    for (int i = 0; i < 10; ++i) xv[i] = bf2f(L[(8 * tg + i + 7) * LS + cb + c]);
                    float o[8];
#pragma unroll
                    for (int i = 0; i < 8; ++i) o[i] = xv[i] * w0 + xv[i + 1] * w1 + xv[i + 2] * w2 + bb;
                    u32x4 w; w.x = pk2(o[0], o[1]); w.y = pk2(o[2], o[3]); w.z = pk2(o[4], o[5]); w.w = pk2(o[6], o[7]);
                    *(u32x4*)(VXT + (size_t)k * (SZ_XT / 2) + ((size_t)c * NB + b) * NKEY + pos_off + t0 + 8 * tg) = w; }
            }
        }
        __syncthreads();
    }
}

constexpr int KS_T = 64 * 104, VS_T = 64 * 72;
DI void attn_qk(LAS const bf16_t* Kc, const bf16x8 (&qf)[6], int r, int hh, f32x16& s0, f32x16& s1) {
#pragma unroll
    for (int i = 0; i < 16; ++i) { s0[i] = 0.f; s1[i] = 0.f; }
#pragma unroll
    for (int ks = 0; ks < 6; ++ks) {
        const bf16x8 a0 = *(LAS const bf16x8*)(Kc + r * 104 + 16 * ks + 8 * hh);
        const bf16x8 a1 = *(LAS const bf16x8*)(Kc + (32 + r) * 104 + 16 * ks + 8 * hh);
        s0 = __builtin_amdgcn_mfma_f32_32x32x16_bf16(a0, qf[ks], s0, 0, 0, 0);
        s1 = __builtin_amdgcn_mfma_f32_32x32x16_bf16(a1, qf[ks], s1, 0, 0, 0);
    }
}
struct AttnSt { f32x16 o0, o1; float mref, lsum; };
DI float vmax3(float a, float b, float c) { float d; asm("v_max3_f32 %0, %1, %2, %3" : "=v"(d) : "v"(a), "v"(b), "v"(c)); return d; }
template <bool HAS_NEXT>
DI void attn_tile(LAS const bf16_t* Kn, LAS const bf16_t* Vc, const bf16x8 (&qf)[6], int r, int hh, int lane, f32x16& s0, f32x16& s1, f32x16& n0, f32x16& n1, AttnSt& st, bool first) {
    bf16x8 kf[12], vf[8];
    __builtin_amdgcn_sched_barrier(0);
    if (HAS_NEXT) {
#pragma unroll
        for (int ks = 0; ks < 6; ++ks) { kf[2 * ks] = *(LAS const bf16x8*)(Kn + r * 104 + 16 * ks + 8 * hh); kf[2 * ks + 1] = *(LAS const bf16x8*)(Kn + (32 + r) * 104 + 16 * ks + 8 * hh); }
    }
    if (first) {
        float mx = vmax3(s0[0], s0[1], s0[2]);
#pragma unroll
        for (int i = 3; i < 15; i += 2) mx = vmax3(mx, s0[i], s0[i + 1]);
        mx = vmax3(mx, s0[15], s1[0]);
#pragma unroll
        for (int i = 1; i < 15; i += 2) mx = vmax3(mx, s1[i], s1[i + 1]);
        mx = fmaxf(mx, s1[15]);
        mx = fmaxf(mx, xshfl(mx, 32, lane));
        s0 = s0 - mx; s1 = s1 - mx; st.mref = mx;
    }
    __builtin_amdgcn_sched_barrier(0);
    if (HAS_NEXT) {
        const float nm = -st.mref;
#pragma unroll
        for (int i = 0; i < 16; ++i) { n0[i] = nm; n1[i] = nm; }
#pragma unroll
        for (int ks = 0; ks < 6; ++ks) { n0 = __builtin_amdgcn_mfma_f32_32x32x16_bf16(kf[2 * ks], qf[ks], n0, 0, 0, 0); n1 = __builtin_amdgcn_mfma_f32_32x32x16_bf16(kf[2 * ks + 1], qf[ks], n1, 0, 0, 0); }
    }
#pragma unroll
    for (int sidx = 0; sidx < 4; ++sidx) { vf[2 * sidx] = *(LAS const bf16x8*)(Vc + r * 72 + 16 * sidx + 8 * hh); vf[2 * sidx + 1] = *(LAS const bf16x8*)(Vc + (32 + r) * 72 + 16 * sidx + 8 * hh); }
#pragma unroll
    for (int i = 0; i < 16; ++i) { s0[i] = __builtin_amdgcn_exp2f(s0[i]); s1[i] = __builtin_amdgcn_exp2f(s1[i]); }
    float ps = 0.f;
    { const f32x16 sm = s0 + s1;
#pragma unroll
      for (int i = 0; i < 16; ++i) ps += sm[i]; }
    if (HAS_NEXT) {
#pragma unroll
        for (int i = 0; i < 12; ++i) { __builtin_amdgcn_sched_group_barrier(0x008, 1, 0); __builtin_amdgcn_sched_group_barrier(0x100, 1, 0); __builtin_amdgcn_sched_group_barrier(0x002, 4, 0); }
    }
    __builtin_amdgcn_sched_barrier(0);
    if (__builtin_amdgcn_ballot_w64(!(ps < 1.8446744e19f)) != 0ull) {
        const float sc = 5.421010862427522e-20f;
        s0 = s0 * sc; s1 = s1 * sc; ps *= sc; st.o0 = st.o0 * sc; st.o1 = st.o1 * sc; st.lsum *= sc; st.mref += 64.f;
        if (HAS_NEXT) { n0 = n0 - 64.f; n1 = n1 - 64.f; }
    }
    st.lsum += ps;
    u32x4 pw[4];
#pragma unroll
    for (int st4 = 0; st4 < 2; ++st4) {
        pw[st4].x = pk2(s0[8 * st4 + 0], s0[8 * st4 + 1]); pw[st4].y = pk2(s0[8 * st4 + 2], s0[8 * st4 + 3]); pw[st4].z = pk2(s0[8 * st4 + 4], s0[8 * st4 + 5]); pw[st4].w = pk2(s0[8 * st4 + 6], s0[8 * st4 + 7]);
        pw[2 + st4].x = pk2(s1[8 * st4 + 0], s1[8 * st4 + 1]); pw[2 + st4].y = pk2(s1[8 * st4 + 2], s1[8 * st4 + 3]); pw[2 + st4].z = pk2(s1[8 * st4 + 4], s1[8 * st4 + 5]); pw[2 + st4].w = pk2(s1[8 * st4 + 6], s1[8 * st4 + 7]); }
#pragma unroll
    for (int sidx = 0; sidx < 4; ++sidx) {
        const bf16x8 pf = __builtin_bit_cast(bf16x8, pw[sidx]);
        st.o0 = __builtin_amdgcn_mfma_f32_32x32x16_bf16(vf[2 * sidx], pf, st.o0, 0, 0, 0);
        st.o1 = __builtin_amdgcn_mfma_f32_32x32x16_bf16(vf[2 * sidx + 1], pf, st.o1, 0, 0, 0);
    }
    __builtin_amdgcn_sched_barrier(0);
}
constexpr int AT_NBUF = 5, AT_KB = 64 * 208, AT_VB = 64 * 144, AT_STAGE = AT_KB + AT_VB;
DI void attn_unit(const Ctx& C, const bf16_t* Qp, const bf16_t* Kp, const bf16_t* VTp, int nkeys, bf16_t* outp) {
    const int r = C.lane & 31, hh = C.lane >> 5;
    bf16x8 qf[6];
    { const bf16_t* qrow = Qp + (size_t)(C.wave * 32 + r) * 96 + 8 * hh;
#pragma unroll
      for (int ks = 0; ks < 6; ++ks) qf[ks] = *(const bf16x8*)(qrow + 16 * ks); }
    AttnSt st;
#pragma unroll
    for (int i = 0; i < 16; ++i) { st.o0[i] = 0.f; st.o1[i] = 0.f; }
    st.mref = 0.f; st.lsum = 0.f;
    const char* gb[3]; unsigned gv[3]; unsigned gstep[3]; unsigned lo[3];
#pragma unroll
    for (int k = 0; k < 3; ++k) { int pc = C.wave + 8 * k; if (pc >= 22) pc = C.wave;
        if (pc < 13) { const int q = pc * 64 + C.lane, row = q / 13, part = min(q - row * 13, 11); gb[k] = (const char*)Kp; gv[k] = (unsigned)(row * 192 + part * 16); gstep[k] = 64 * 192; lo[k] = pc * 1024; }
        else { const int q = (pc - 13) * 64 + C.lane, row = q / 9, part = min(q - row * 9, 7); gb[k] = (const char*)VTp; gv[k] = (unsigned)(row * (NKEY * 2) + part * 16); gstep[k] = 128; lo[k] = AT_KB + (pc - 13) * 1024; } }
    const int ntile = nkeys >> 6;
#define AT_ISSUE(tile, buf) do { const int _t = (tile) < ntile ? (tile) : ntile - 1; _Pragma("unroll") for (int _k = 0; _k < 3; ++_k) \
        __builtin_amdgcn_global_load_lds((const unsigned*)((gb[_k] + (size_t)_t * gstep[_k]) + gv[_k]), (LAS unsigned*)(C.lds + (buf) * AT_STAGE + lo[_k]), 16, 0, 0); } while (0)
#define AT_KPTR(buf) ((LAS const bf16_t*)(C.lds + (buf) * AT_STAGE))
#define AT_VPTR(buf) ((LAS const bf16_t*)(C.lds + (buf) * AT_STAGE + AT_KB))
#define AT_SEAM() do { asm volatile("s_waitcnt vmcnt(6)" ::: "memory"); __builtin_amdgcn_s_barrier(); asm volatile("" ::: "memory"); } while (0)
#define AT_NEXT(b) (((b) == AT_NBUF - 1) ? 0 : (b) + 1)
#define AT_PREV(b) (((b) == 0) ? AT_NBUF - 1 : (b) - 1)
    __syncthreads();
    AT_ISSUE(0, 0); AT_ISSUE(1, 1); AT_ISSUE(2, 2); AT_ISSUE(3, 3);
    AT_SEAM();
    f32x16 sa0, sa1, sb0, sb1;
    attn_qk(AT_KPTR(0), qf, r, hh, sa0, sa1);
    int bc = 0, it = 0;
    for (; it + 2 < ntile; it += 2) {
        { const int bn = AT_NEXT(bc); AT_ISSUE(it + 4, AT_PREV(bc));
          attn_tile<true>(AT_KPTR(bn), AT_VPTR(bc), qf, r, hh, C.lane, sa0, sa1, sb0, sb1, st, it == 0);
          AT_SEAM(); bc = bn; }
        { const int bn = AT_NEXT(bc); AT_ISSUE(it + 5, AT_PREV(bc));
          attn_tile<true>(AT_KPTR(bn), AT_VPTR(bc), qf, r, hh, C.lane, sb0, sb1, sa0, sa1, st, false);
          AT_SEAM(); bc = bn; }
    }
    { const int bn = AT_NEXT(bc); AT_ISSUE(ntile, AT_PREV(bc));
      attn_tile<true>(AT_KPTR(bn), AT_VPTR(bc), qf, r, hh, C.lane, sa0, sa1, sb0, sb1, st, false);
      AT_SEAM(); bc = bn; }
    attn_tile<false>(AT_KPTR(0), AT_VPTR(bc), qf, r, hh, C.lane, sb0, sb1, sa0, sa1, st, false);
    asm volatile("s_waitcnt vmcnt(0)" ::: "memory");
#undef AT_ISSUE
#undef AT_KPTR
#undef AT_VPTR
#undef AT_SEAM
#undef AT_NEXT
#undef AT_PREV
    const float ltot = st.lsum + xshfl(st.lsum, 32, C.lane);
    const float inv = 1.f / ltot;
    bf16_t* orow = outp + (size_t)(C.wave * 32 + r) * 512 + 4 * hh;
#pragma unroll
    for (int g = 0; g < 4; ++g) {
        u32x2 w0, w1;
        w0.x = pk2(st.o0[4 * g] * inv, st.o0[4 * g + 1] * inv); w0.y = pk2(st.o0[4 * g + 2] * inv, st.o0[4 * g + 3] * inv);
        w1.x = pk2(st.o1[4 * g] * inv, st.o1[4 * g + 1] * inv); w1.y = pk2(st.o1[4 * g + 2] * inv, st.o1[4 * g + 3] * inv);
        *(u32x2*)(orow + 8 * g) = w0; *(u32x2*)(orow + 32 + 8 * g) = w1;
    }
}

DI void phase_attn(const Params& P, const Ctx& C, int l) {
    unsigned char* ws = P.ws;
    const bf16_t* QL = (const bf16_t*)(ws + OFF_QL); const bf16_t* QC = (const bf16_t*)(ws + OFF_QC);
    const bf16_t* Kb = (const bf16_t*)(ws + OFF_K); const bf16_t* VT = (const bf16_t*)(ws + OFF_VT);
    bf16_t* att = (bf16_t*)(ws + OFF_ATT);
    const int nun = 2048 + (l == 0 ? 128 : 0);
    for (int u = C.bid; u < nun; u += C.G) {
        if (u < 2048) { const int j = u / C.G, w = u - j * C.G;
            const int qb = (w >> 3) & 15, bh = (C.G == 256) ? (j * 16 + (w & 7) * 2 + (w >> 7)) : (u >> 4), b = bh >> 3, h = bh & 7; const int qb2 = (C.G == 256) ? qb : (u & 15);
            attn_unit(C, QL + ((size_t)bh * SEQ + qb2 * 256) * 96, Kb + (size_t)bh * NKEY * 96, VT + (size_t)bh * 64 * NKEY, NKEY,
                      att + ((size_t)b * SEQ + qb2 * 256) * 512 + h * 64); }
        else { const int bh = u - 2048, b = bh >> 3, h = bh & 7;
            attn_unit(C, QC + (size_t)bh * CTXL * 96, Kb + (size_t)bh * NKEY * 96, VT + (size_t)bh * 64 * NKEY, CTXL,
                      att + ((size_t)RL + b * CTXL) * 512 + h * 64); }
    }
    __syncthreads();
}

DI float hval(const float* Hf, const float* Hb, int n, int m) { if (m > 2 * n - 2) return 0.f; const int d = n - 1 - m; return d >= 0 ? Hf[d] : Hb[-d]; }
DI bf16x8 lda_tile(LAS const unsigned char* p) { LAS const unsigned* q = (LAS const unsigned*)p; u32x4 v; v.x = q[0]; v.y = q[1]; v.z = q[2]; v.w = q[3]; return __builtin_bit_cast(bf16x8, v); }

DI void hyena_unit(const Ctx& C, const float* Hf, const float* Hb, int n, const bf16_t* UT, const bf16_t* XT, bf16_t* OT, int pos_off, float bias) {
    LAS bf16_t* R0 = (LAS bf16_t*)C.lds; LAS bf16_t* R1 = R0 + 8192; LAS float* red = (LAS float*)(C.lds + 32768);
    __syncthreads();
    float asum = 0.f;
    for (int m = C.tid; m < 2 * n; m += 512) { const float v0 = hval(Hf, Hb, n, m), v1 = hval(Hf, Hb, n, m + 1); R0[m] = f2bf(v0); R1[m] = f2bf(v1); asum += fabsf(v0); }
    asum = wave_sum(asum, C.lane);
    if (C.lane == 0) red[C.wave] = asum;
    __syncthreads();
    float tot = 0.f;
#pragma unroll
    for (int w = 0; w < 8; ++w) tot += red[w];
    const float invn = 1.f / tot;
    const int i = C.lane & 15, g = C.lane >> 4;
    const int npass = n >> 8, nj = n >> 5;
    for (int pass = C.wave; pass < npass; pass += 8) {
        const int I0 = 16 * pass;
        const int m0 = (n - 1) - 16 * I0 - i + 8 * g;
        LAS const unsigned char* a0 = C.lds + (m0 & 1) * 16384 + (m0 & ~1) * 2;
        f32x4 acc[16]; bf16x8 W[16];
#pragma unroll
        for (int s = 0; s < 16; ++s) { acc[s] = (f32x4){0.f, 0.f, 0.f, 0.f}; W[s] = lda_tile(a0 - 32 * s); }
        const bf16_t* ub = UT + (size_t)i * NKEY + pos_off + 8 * g;
        bf16x8 bq[4];
#pragma unroll
        for (int k = 0; k < 3; ++k) bq[k] = *(const bf16x8*)(ub + 32 * min(k, nj - 1));
        for (int j0 = 0; j0 < nj; j0 += 8) {
#pragma unroll
            for (int u = 0; u < 8; ++u) { const int j = j0 + u;
                acc[14] = __builtin_amdgcn_mfma_f32_16x16x32_bf16(W[(14 - 2 * u + 16) & 15], bq[u & 3], acc[14], 0, 0, 0);
                acc[15] = __builtin_amdgcn_mfma_f32_16x16x32_bf16(W[(15 - 2 * u + 16) & 15], bq[u & 3], acc[15], 0, 0, 0);
                __builtin_amdgcn_sched_barrier(0);
                W[(14 - 2 * u + 16) & 15] = lda_tile(a0 + 64 * (j + 1));
                W[(15 - 2 * u + 16) & 15] = lda_tile(a0 + 64 * (j + 1) - 32);
                bq[(u + 3) & 3] = *(const bf16x8*)(ub + 32 * min(j + 3, nj - 1));
                __builtin_amdgcn_sched_barrier(0);
#pragma unroll
                for (int ii = 0; ii < 14; ++ii) acc[ii] = __builtin_amdgcn_mfma_f32_16x16x32_bf16(W[(ii - 2 * u + 16) & 15], bq[u & 3], acc[ii], 0, 0, 0);
                __builtin_amdgcn_sched_barrier(0); }
        }
#pragma unroll
        for (int ii = 0; ii < 16; ++ii) { const size_t off = (size_t)i * NKEY + pos_off + 16 * (I0 + ii) + 4 * g;
            const u32x2 uu = *(const u32x2*)(UT + off), xx = *(const u32x2*)(XT + off);
            const float y0 = acc[ii][0] * invn + bflo(uu.x) * bias, y1 = acc[ii][1] * invn + bfhi(uu.x) * bias, y2 = acc[ii][2] * invn + bflo(uu.y) * bias, y3 = acc[ii][3] * invn + bfhi(uu.y) * bias;
            u32x2 w; w.x = pk2(bflo(xx.x) * y0, bfhi(xx.x) * y1); w.y = pk2(bflo(xx.y) * y2, bfhi(xx.y) * y3);
            *(u32x2*)(OT + off) = w; }
    }
}

DI void phase_hyena(const Params& P, const Ctx& C, int l, int o) {
    unsigned char* ws = P.ws;
    const bf16_t* VXT = (const bf16_t*)(ws + OFF_VXT); const size_t XS = SZ_XT / 2;
    const bf16_t* UTb = o == 0 ? VXT : (const bf16_t*)(ws + OFF_ZT);
    const bf16_t* XTb = o == 0 ? VXT + XS : VXT + 2 * XS;
    bf16_t* OTb = o == 0 ? (bf16_t*)(ws + OFF_ZT) : (bf16_t*)(ws + OFF_HYT);
    const float* HL = (const float*)(ws + OFF_HL) + (size_t)l * 1024 * 4096; const float* HC = (const float*)(ws + OFF_HC);
    const int nun = 256 + (l == 0 ? 256 : 0);
    for (int u = C.bid; u < nun; u += C.G) {
        const int c = u & 255; const size_t co = (size_t)c * NB * NKEY; const float bias = P.hy_bias[(l * 2 + o) * 256 + c];
        if (u < 256) hyena_unit(C, HL + (size_t)(o * 512 + c) * 4096, HL + (size_t)(o * 512 + 256 + c) * 4096, SEQ, UTb + co, XTb + co, OTb + co, CTXL, bias);
        else hyena_unit(C, HC + (size_t)(o * 512 + c) * 256, HC + (size_t)(o * 512 + 256 + c) * 256, CTXL, UTb + co, XTb + co, OTb + co, 0, bias);
    }
    __syncthreads();
}

DI void phase_merge(const Params& P, const Ctx& C, int l) {
    unsigned char* ws = P.ws;
    const bf16_t* att = (const bf16_t*)(ws + OFF_ATT); const bf16_t* po = (const bf16_t*)(ws + OFF_POOLO); const bf16_t* hyT = (const bf16_t*)(ws + OFF_HYT);
    bf16_t* mb = (bf16_t*)P.out;
    const float* go = P.g_out + l * 1024;
    LAS bf16_t* L = (LAS bf16_t*)C.lds;
    const int nun = (l == 0) ? 1280 : 1024;
    const int j = C.lane & 15, qw = C.lane >> 4;
    for (int u = C.bid; u < nun; u += C.G) {
        int row0, b, t0, pos_off; bool isctx;
        if (u < 1024) { row0 = u * 64; b = row0 >> 12; t0 = row0 & 4095; pos_off = CTXL; isctx = false; }
        else { const int uc = u - 1024; row0 = RL + uc * 16; b = uc >> 4; t0 = (uc & 15) * 16; pos_off = 0; isctx = true; }
        const int nparts = isctx ? 2 : 8;
        __syncthreads();
        { u32x4 v[4];
#pragma unroll
          for (int i = 0; i < 4; ++i) { const int it = C.tid + 512 * i, c = it >> 3, part = it & 7; v[i] = (u32x4){0u, 0u, 0u, 0u}; if (part < nparts) v[i] = *(const u32x4*)(hyT + ((size_t)c * NB + b) * NKEY + pos_off + t0 + part * 8); }
#pragma unroll
          for (int i = 0; i < 4; ++i) { const int it = C.tid + 512 * i, c = it >> 3, part = it & 7; LAS unsigned* d = (LAS unsigned*)(L + c * 66 + part * 8); d[0] = v[i].x; d[1] = v[i].y; d[2] = v[i].z; d[3] = v[i].w; } }
#pragma unroll
        for (int itk = 0; itk < 2; ++itk) { const bool act = !isctx || (itk == 0 && C.wave < 4);
            const int tok = !isctx ? (C.wave * 8 + itk * 4 + qw) : (act ? C.wave * 4 + qw : 0), row = row0 + tok;
            bf16_t* mr = mb + (size_t)row * 1024;
            u32x4 wa[4], wp[2];
#pragma unroll
            for (int q = 0; q < 4; ++q) wa[q] = *(const u32x4*)(att + (size_t)row * 512 + 8 * j + 128 * q);
#pragma unroll
            for (int q = 0; q < 2; ++q) wp[q] = *(const u32x4*)(po + (size_t)row * 256 + 8 * j + 128 * q);
            { float a[4][8]; float ss = 0.f;
#pragma unroll
              for (int q = 0; q < 4; ++q) { unpack8(wa[q], a[q]);
#pragma unroll
                  for (int i = 0; i < 8; ++i) ss += a[q][i] * a[q][i]; }
              const float rs = rsqrtf(qsum16(ss, C.lane) * (1.f / 512.f) + EPS);
#pragma unroll
              for (int q = 0; q < 4; ++q) { const f32x4 g0 = *(const f32x4*)(go + 8 * j + 128 * q), g1 = *(const f32x4*)(go + 8 * j + 128 * q + 4);
                  u32x4 o; o.x = pk2(a[q][0] * rs * g0[0], a[q][1] * rs * g0[1]); o.y = pk2(a[q][2] * rs * g0[2], a[q][3] * rs * g0[3]); o.z = pk2(a[q][4] * rs * g1[0], a[q][5] * rs * g1[1]); o.w = pk2(a[q][6] * rs * g1[2], a[q][7] * rs * g1[3]);
                  if (act) *(u32x4*)(mr + 8 * j + 128 * q) = o; } }
            { float a[2][8]; float ss = 0.f;
#pragma unroll
              for (int q = 0; q < 2; ++q) { unpack8(wp[q], a[q]);
#pragma unroll
                  for (int i = 0; i < 8; ++i) ss += a[q][i] * a[q][i]; }
              const float rs = rsqrtf(qsum16(ss, C.lane) * (1.f / 256.f) + EPS);
#pragma unroll
              for (int q = 0; q < 2; ++q) { const f32x4 g0 = *(const f32x4*)(go + 512 + 8 * j + 128 * q), g1 = *(const f32x4*)(go + 512 + 8 * j + 128 * q + 4);
                  u32x4 o; o.x = pk2(a[q][0] * rs * g0[0], a[q][1] * rs * g0[1]); o.y = pk2(a[q][2] * rs * g0[2], a[q][3] * rs * g0[3]); o.z = pk2(a[q][4] * rs * g1[0], a[q][5] * rs * g1[1]); o.w = pk2(a[q][6] * rs * g1[2], a[q][7] * rs * g1[3]);
                  if (act) *(u32x4*)(mr + 512 + 8 * j + 128 * q) = o; } }
        }
        __syncthreads();
#pragma unroll
        for (int itk = 0; itk < 2; ++itk) { const bool act = !isctx || (itk == 0 && C.wave < 4);
            const int tok = !isctx ? (C.wave * 8 + itk * 4 + qw) : (act ? C.wave * 4 + qw : 0), row = row0 + tok;
            bf16_t* mr = mb + (size_t)row * 1024 + 768;
            float a[8][2]; float ss = 0.f;
#pragma unroll
            for (int i = 0; i < 8; ++i) { const int c = 2 * j + 32 * i; a[i][0] = bf2f(L[c * 66 + tok]); a[i][1] = bf2f(L[(c + 1) * 66 + tok]); ss += a[i][0] * a[i][0] + a[i][1] * a[i][1]; }
            const float rs = rsqrtf(qsum16(ss, C.lane) * (1.f / 256.f) + EPS);
#pragma unroll
            for (int i = 0; i < 8; ++i) { const int c = 2 * j + 32 * i; const f32x2 g = *(const f32x2*)(go + 768 + c); if (act) *(unsigned*)(mr + c) = pk2(a[i][0] * rs * g.x, a[i][1] * rs * g.y); }
        }
    }
    __syncthreads();
}

DI void phase_ctxfin(const Params& P, const Ctx& C) {
    const float* mod0 = (const float*)(P.ws + OFF_MOD); const float* mod1 = mod0 + (size_t)17 * 6144;
    const float* gate = mod0 + (size_t)16 * 6144 + 5 * 1024;
    const float* sc = mod1 + (size_t)16 * 6144 + 1 * 1024;
    const float* gain = P.g_mix + 1024;
    bf16_t* xrb = (bf16_t*)(P.ws + OFF_XR) + (size_t)RL * 1024; const float* part = (const float*)(P.ws + OFF_PART);
    bf16_t* hb = (bf16_t*)P.out; float* ss2 = (float*)(P.ws + OFF_SS) + (size_t)2 * RT;
    for (int row = C.bid * 8 + C.wave; row < RC; row += C.G * 8) {
        bf16_t* xr = xrb + (size_t)row * 1024;
        f32x4 v[4]; float ss = 0.f;
#pragma unroll
        for (int j = 0; j < 4; ++j) { const int c = 4 * C.lane + 256 * j; f32x4 a = *(const f32x4*)(part + (size_t)row * 1024 + c);
#pragma unroll
            for (int ks = 1; ks < 4; ++ks) a = a + *(const f32x4*)(part + ((size_t)ks * RC + row) * 1024 + c);
            const u32x2 xw = *(const u32x2*)(xr + c);
            v[j] = (f32x4){bflo(xw.x), bfhi(xw.x), bflo(xw.y), bfhi(xw.y)} + *(const f32x4*)(gate + c) * a;
            u32x2 o; o.x = pk2(v[j][0], v[j][1]); o.y = pk2(v[j][2], v[j][3]); *(u32x2*)(xr + c) = o;
            ss += (v[j][0] * v[j][0] + v[j][1] * v[j][1]) + (v[j][2] * v[j][2] + v[j][3] * v[j][3]); }
        ss = wave_sum(ss, C.lane);
        if (C.lane == 0) ss2[RL + row] = ss;
#pragma unroll
        for (int j = 0; j < 4; ++j) { const int c = 4 * C.lane + 256 * j; const f32x4 y = v[j] * *(const f32x4*)(gain + c) * (*(const f32x4*)(sc + c) + 1.0f);
            u32x2 w; w.x = pk2(y[0], y[1]); w.y = pk2(y[2], y[3]);
            *(u32x2*)(hb + (size_t)(RL + row) * 1024 + c) = w; }
    }
}

DI void phase_final(const Params& P, const Ctx& C) {
    for (int row = C.bid * 8 + C.wave; row < RL; row += C.G * 8) {
        float* xr = P.out + (size_t)row * 1024; const bf16_t* xb = (const bf16_t*)(P.ws + OFF_XR) + (size_t)row * 1024;
        f32x4 v[4]; float ss = 0.f;
#pragma unroll
        for (int j = 0; j < 4; ++j) { const u32x2 w = *(const u32x2*)(xb + 4 * C.lane + 256 * j); v[j] = (f32x4){bflo(w.x), bfhi(w.x), bflo(w.y), bfhi(w.y)};
            ss += (v[j][0] * v[j][0] + v[j][1] * v[j][1]) + (v[j][2] * v[j][2] + v[j][3] * v[j][3]); }
        const float rs = rsqrtf(wave_sum(ss, C.lane) * (1.f / 1024.f) + EPS);
#pragma unroll
        for (int j = 0; j < 4; ++j) { const f32x4 g = *(const f32x4*)(P.g_final + 4 * C.lane + 256 * j); *(f32x4*)(xr + 4 * C.lane + 256 * j) = v[j] * rs * g; }
    }
}

DI Ctx make_ctx(LAS unsigned char* lds, int wave_s) {
    Ctx C; int bid = blockIdx.x, G = gridDim.x, wv = wave_s;
    int lane; asm volatile("v_mbcnt_lo_u32_b32 %0, -1, 0\n\tv_mbcnt_hi_u32_b32 %0, -1, %0" : "=v"(lane)); asm volatile("" : "+s"(bid)); asm volatile("" : "+s"(G)); asm volatile("" : "+s"(wv));
    C.lds = lds; C.tid = wv * 64 + lane; C.lane = lane; C.wave = wv; C.G = G; C.bid = bid; return C;
}
DI unsigned char* fresh_ws(const Params& P) { unsigned char* w = P.ws; asm volatile("" : "+s"(w)); return w; }

__global__ void __launch_bounds__(512, 2) mega_fwd(Params P) {
    extern __shared__ __attribute__((aligned(16))) unsigned char lds_raw[];
    cg::grid_group grid = cg::this_grid();
    LAS unsigned char* lds = (LAS unsigned char*)lds_raw;
    const int wave_s = __builtin_amdgcn_readfirstlane((int)(threadIdx.x >> 6));
    { const Ctx C = make_ctx(lds, wave_s);
      if (C.bid == 0) for (int i = C.tid; i < XCD_BAR_WORDS; i += 512) ((unsigned*)(P.ws + OFF_BAR))[i] = 0u;
      if (C.tid < 4) ((LAS unsigned*)(lds + 131072))[C.tid] = 0u;
      phase_setup(P, C); }
    grid.sync();
    { const Ctx C = make_ctx(lds, wave_s); xcd_barrier_post((unsigned*)(P.ws + OFF_BAR), C.tid == 0); }
#define GSYNC() do { const Ctx _c = make_ctx(lds, wave_s); xcd_barrier((unsigned*)(fresh_ws(P) + OFF_BAR), (volatile LAS unsigned*)(lds + 131072), _c.tid == 0); } while (0)
    { const Ctx C = make_ctx(lds, wave_s); phase_first(P, C); }
    GSYNC();
#pragma unroll 1
    for (int li = 0; li < 2; ++li) {
        int l = li; asm volatile("" : "+s"(l));
        const bool last = (l == 1);
        const int Mrows = last ? RL : RT;
        { const Ctx C = make_ctx(lds, wave_s); unsigned char* ws = fresh_ws(P); unsigned char* wl = ws + OFF_W + (size_t)l * SZ_WLAYER; pg8::StaticOrder S;
          pg8::Gemm g{(const bf16_t*)P.out, (const bf16_t*)(wl + WO_IN), RT, NINP, 1024, 1024, 1024}; S.init(g.M, g.N, C.G, C.bid);
          EpiNormBf16<0> e{(bf16_t*)(ws + OFF_PROJ), NIN, NIN, (const float*)(ws + OFF_SS) + (size_t)(l == 0 ? 0 : 2) * RT, (const float*)(ws + OFF_SHW) + (size_t)(l * 2 + 0) * 17 * 4096};
          pg8::gemm_phase(C.lds, C.tid, g, S, e); }
        GSYNC();
        { const Ctx C = make_ctx(lds, wave_s); phase_prep(P, C, l); }
        GSYNC();
        { const Ctx C = make_ctx(lds, wave_s); unsigned char* ws = fresh_ws(P); unsigned char* wl = ws + OFF_W + (size_t)l * SZ_WLAYER; pg8::StaticOrder S;
          pg8::Gemm g{(const bf16_t*)(ws + OFF_NQ) + 128, (const bf16_t*)(wl + WO_Q), Mrows, 768, 256, 384, 256}; S.init(g.M, g.N, C.G, C.bid);
          EpiQ e{(bf16_t*)(ws + OFF_QL), (bf16_t*)(ws + OFF_QC), (const f32x2*)(ws + OFF_ROPE)}; pg8::gemm_phase(C.lds, C.tid, g, S, e); }
        __syncthreads();
        { const Ctx C = make_ctx(lds, wave_s); unsigned char* ws = fresh_ws(P); unsigned char* wl = ws + OFF_W + (size_t)l * SZ_WLAYER; pg8::StaticOrder S;
          pg8::Gemm g{(const bf16_t*)(ws + OFF_NQ), (const bf16_t*)(wl + WO_KN), RT, 512, 128, 384, 128}; S.init(g.M, g.N, C.G, C.bid);
          EpiKn e{(bf16_t*)(ws + OFF_K)}; pg8::gemm_phase(C.lds, C.tid, g, S, e); }
        __syncthreads();
        { const Ctx C = make_ctx(lds, wave_s); unsigned char* ws = fresh_ws(P); unsigned char* wl = ws + OFF_W + (size_t)l * SZ_WLAYER; pg8::StaticOrder S;
          pg8::Gemm g{(const bf16_t*)(wl + WO_V), (const bf16_t*)(ws + OFF_NQ), 512, RT, 128, 128, 384}; S.init(g.M, g.N, C.G, C.bid);
          EpiVT e{(bf16_t*)(ws + OFF_VT)}; pg8::gemm_phase(C.lds, C.tid, g, S, e); }
        __syncthreads();
        { const Ctx C = make_ctx(lds, wave_s); unsigned char* ws = fresh_ws(P); unsigned char* wl = ws + OFF_W + (size_t)l * SZ_WLAYER; pg8::StaticOrder S;
          pg8::Gemm g{(const bf16_t*)(ws + OFF_POOLA), (const bf16_t*)(wl + WO_POOL), Mrows, 256, 256, 256, 256}; S.init(g.M, g.N, C.G, C.bid);
          EpiBf16<0> e{(bf16_t*)(ws + OFF_POOLO), 256, 256}; pg8::gemm_phase(C.lds, C.tid, g, S, e); }
        GSYNC();
        { const Ctx C = make_ctx(lds, wave_s); phase_attn(P, C, l); }
        { const Ctx C = make_ctx(lds, wave_s); phase_hyena(P, C, l, 0); }
        GSYNC();
        { const Ctx C = make_ctx(lds, wave_s); phase_hyena(P, C, l, 1); }
        GSYNC();
        { const Ctx C = make_ctx(lds, wave_s); phase_merge(P, C, l); }
        GSYNC();
        { const Ctx C = make_ctx(lds, wave_s); unsigned char* ws = fresh_ws(P); unsigned char* wl = ws + OFF_W + (size_t)l * SZ_WLAYER; pg8::StaticOrder S;
          const float* modl = (const float*)(ws + OFF_MOD) + (size_t)l * 17 * 6144;
          pg8::Gemm g{(const bf16_t*)P.out, (const bf16_t*)(wl + WO_OUT), Mrows, 1024, 1024, 1024, 1024}; S.init(g.M, g.N, C.G, C.bid);
          if (l == 0) { EpiResid2<true, true> e{P.x, P.ctx, (bf16_t*)(ws + OFF_XR), modl + 2 * 1024, (bf16_t*)(ws + OFF_HBUF2), (float*)(ws + OFF_SS) + (size_t)1 * RT, P.g_mlp + l * 1024, modl + 4 * 1024};
            pg8::gemm_phase(C.lds, C.tid, g, S, e); }
          else { EpiResid2<false, true> e{nullptr, nullptr, (bf16_t*)(ws + OFF_XR), modl + 2 * 1024, (bf16_t*)(ws + OFF_HBUF2), (float*)(ws + OFF_SS) + (size_t)3 * RT, P.g_mlp + l * 1024, modl + 4 * 1024};
            pg8::gemm_phase(C.lds, C.tid, g, S, e); } }
        GSYNC();
        { const Ctx C = make_ctx(lds, wave_s); unsigned char* ws = fresh_ws(P); unsigned char* wl = ws + OFF_W + (size_t)l * SZ_WLAYER; pg8::StaticOrder S;
          pg8::Gemm g{(const bf16_t*)(ws + OFF_HBUF2), (const bf16_t*)(wl + WO_M1), Mrows, DFF, 1024, 1024, 1024}; S.init(g.M, g.N, C.G, C.bid);
          EpiNormBf16<1> e{(bf16_t*)(ws + OFF_ACT), DFF, DFF, (const float*)(ws + OFF_SS) + (size_t)(l == 0 ? 1 : 3) * RT, (const float*)(ws + OFF_SHW) + (size_t)(l * 2 + 1) * 17 * 4096};
          pg8::gemm_phase(C.lds, C.tid, g, S, e); }
        GSYNC();
        if (!last) {
          { const Ctx C = make_ctx(lds, wave_s); unsigned char* ws = fresh_ws(P); unsigned char* wl = ws + OFF_W + (size_t)l * SZ_WLAYER; pg8::StaticOrder S;
            const float* modl = (const float*)(ws + OFF_MOD) + (size_t)l * 17 * 6144; const float* modn = modl + (size_t)17 * 6144;
            pg8::Gemm g{(const bf16_t*)(ws + OFF_ACT), (const bf16_t*)(wl + WO_M2), RL, 1024, DFF, DFF, DFF}; S.init(g.M, g.N, C.G, C.bid);
            EpiResid2<false, true> e{nullptr, nullptr, (bf16_t*)(ws + OFF_XR), modl + 5 * 1024,
                             (bf16_t*)P.out, (float*)(ws + OFF_SS) + (size_t)2 * RT, P.g_mix + 1024, modn + 1 * 1024};
            pg8::gemm_phase(C.lds, C.tid, g, S, e); }
          __syncthreads();
          { const Ctx C = make_ctx(lds, wave_s); unsigned char* ws = fresh_ws(P); unsigned char* wl = ws + OFF_W + (size_t)l * SZ_WLAYER; pg8::StaticOrder S;
            pg8::Gemm g{(const bf16_t*)(ws + OFF_ACT) + (size_t)RL * DFF, (const bf16_t*)(wl + WO_M2), 4 * RC, 1024, 1024, DFF, DFF, 16, (size_t)1024 * 2}; S.init(g.M, g.N, C.G, C.bid);
            EpiPartial e{(float*)(ws + OFF_PART)};
            pg8::gemm_phase(C.lds, C.tid, g, S, e); }
          GSYNC();
          { const Ctx C = make_ctx(lds, wave_s); phase_ctxfin(P, C); }
        }
        else { const Ctx C = make_ctx(lds, wave_s); unsigned char* ws = fresh_ws(P); unsigned char* wl = ws + OFF_W + (size_t)l * SZ_WLAYER; pg8::StaticOrder S;
          const float* modl = (const float*)(ws + OFF_MOD) + (size_t)l * 17 * 6144;
          pg8::Gemm g{(const bf16_t*)(ws + OFF_ACT), (const bf16_t*)(wl + WO_M2), Mrows, 1024, DFF, DFF, DFF}; S.init(g.M, g.N, C.G, C.bid);
          EpiResid2<false, false> e{nullptr, nullptr, (bf16_t*)(ws + OFF_XR), modl + 5 * 1024, nullptr, nullptr, nullptr, nullptr};
          pg8::gemm_phase(C.lds, C.tid, g, S, e); }
        GSYNC();
    }
    { const Ctx C = make_ctx(lds, wave_s); phase_final(P, C); }
}

extern "C" void kernel_launch(void* const* d_in, const int* in_sizes, int n_in, void* d_out, int out_size, void* d_ws, size_t ws_size, hipStream_t stream) {
    static int grid = 0;
    if (grid == 0) {
        if (n_in != 30 || ws_size < WS_END) { fprintf(stderr, "kernel_launch: unexpected n_in %d / ws %zu (need %zu)\n", n_in, ws_size, (size_t)WS_END); grid = -1; return; }
        int dev = 0, cus = 0, per_cu = 0;
        (void)hipGetDevice(&dev);
        (void)hipDeviceGetAttribute(&cus, hipDeviceAttributeMultiprocessorCount, dev);
        if (hipFuncSetAttribute((const void*)mega_fwd, hipFuncAttributeMaxDynamicSharedMemorySize, LDS_BYTES) != hipSuccess) fprintf(stderr, "kernel_launch: hipFuncSetAttribute failed\n");
        if (hipOccupancyMaxActiveBlocksPerMultiprocessor(&per_cu, (const void*)mega_fwd, 512, LDS_BYTES) != hipSuccess || per_cu < 1) { fprintf(stderr, "kernel_launch: occupancy query gave %d\n", per_cu); per_cu = 1; }
        (void)hipGetLastError();
        grid = cus * 1;
    }
    if (grid < 0) return;
    Params p{};
    const float** pp = (const float**)&p;
    for (int i = 0; i < 30; ++i) pp[i] = (const float*)d_in[i];
    p.out = (float*)d_out; p.ws = (unsigned char*)d_ws;
    void* args[] = {&p};
    hipError_t e = hipLaunchCooperativeKernel((const void*)mega_fwd, dim3(grid), dim3(512), args, LDS_BYTES, stream);
    if (e != hipSuccess) fprintf(stderr, "cooperative launch failed: %s (grid %d)\n", hipGetErrorString(e), grid);
}
```

```cpp
#include <hip/hip_runtime.h>
#include <hip/hip_cooperative_groups.h>
#include <cstdio>
#include <cstdint>
namespace cg = cooperative_groups;

#define DI __device__ __forceinline__
#define LAS __attribute__((address_space(3)))
typedef unsigned short bf16_t;
typedef short bf16x8 __attribute__((ext_vector_type(8)));
typedef short s16x4 __attribute__((ext_vector_type(4)));
typedef float f32x4 __attribute__((ext_vector_type(4)));
typedef float f32x2 __attribute__((ext_vector_type(2)));
typedef float f32x16 __attribute__((ext_vector_type(16)));
typedef unsigned u32x4 __attribute__((ext_vector_type(4)));
typedef unsigned u32x2 __attribute__((ext_vector_type(2)));
typedef __bf16 bf16x2_t __attribute__((ext_vector_type(2)));

DI unsigned pk2(float lo, float hi) { f32x2 v = {lo, hi}; bf16x2_t b = __builtin_convertvector(v, bf16x2_t); return __builtin_bit_cast(unsigned, b); }
DI float bflo(unsigned w) { return __uint_as_float(w << 16); }
DI float bfhi(unsigned w) { return __uint_as_float(w & 0xffff0000u); }
DI float bf2f(bf16_t v) { return __uint_as_float(((unsigned)v) << 16); }
DI bf16_t f2bf(float f) { return (bf16_t)(pk2(f, 0.f) & 0xffffu); }
DI float xshfl(float v, int o, int lane) { return __int_as_float(__builtin_amdgcn_ds_bpermute((lane ^ o) << 2, __float_as_int(v))); }
DI float wave_sum(float v, int lane) {
#pragma unroll
    for (int o = 1; o < 64; o <<= 1) v += xshfl(v, o, lane);
    return v;
}
#define LDS_WAIT() asm volatile("s_waitcnt lgkmcnt(0)" ::: "memory")

constexpr int NB = 16, SEQ = 4096, CTXL = 256, DM = 1024, RL = NB * SEQ, RC = NB * CTXL, RT = RL + RC, NKEY = SEQ + CTXL;
constexpr int NIN = 1440, NINP = 1536, DFF = 4096;
constexpr int COL_KR = 128, COL_Q = 160, COL_POOL = 416, COL_HY = 672;
constexpr float EPS = 1e-6f;
constexpr float QSCALE = 0.10206207261596575f * 1.4426950408889634f;

constexpr size_t al256(size_t x) { return (x + 255) & ~(size_t)255; }
constexpr size_t SZ_WIN = (size_t)NINP * 1024 * 2, SZ_WQ = 768 * 256 * 2, SZ_WKN = 512 * 128 * 2, SZ_WV = 512 * 128 * 2, SZ_WPOOL = 256 * 256 * 2,
                 SZ_WOUT = 1024 * 1024 * 2, SZ_WM1 = (size_t)4096 * 1024 * 2, SZ_WM2 = (size_t)4096 * 1024 * 2;
constexpr size_t WO_IN = 0, WO_Q = WO_IN + SZ_WIN, WO_KN = WO_Q + SZ_WQ, WO_V = WO_KN + SZ_WKN, WO_POOL = WO_V + SZ_WV, WO_OUT = WO_POOL + SZ_WPOOL,
                 WO_M1 = WO_OUT + SZ_WOUT, WO_M2 = WO_M1 + SZ_WM1, SZ_WLAYER = WO_M2 + SZ_WM2;
constexpr size_t OFF_W = 0;
constexpr size_t OFF_MOD = al256(OFF_W + 2 * SZ_WLAYER);
constexpr size_t OFF_ROPE = al256(OFF_MOD + (size_t)2 * 17 * 6144 * 4);
constexpr size_t OFF_HL = al256(OFF_ROPE + 64 * 8 * 8);
constexpr size_t OFF_HC = al256(OFF_HL + (size_t)2 * 1024 * 4096 * 4);
constexpr size_t OFF_XC = al256(OFF_HC + (size_t)1024 * 256 * 4);
constexpr size_t OFF_XR = al256(OFF_XC + (size_t)RC * 1024 * 4);
constexpr size_t OFF_HBUF = OFF_XR;
constexpr size_t OFF_BIG = al256(OFF_HBUF + (size_t)RT * 1024 * 2);
constexpr size_t SZ_PROJ = (size_t)RT * NIN * 2, SZ_NQ = (size_t)RT * 384 * 2, SZ_R256 = (size_t)RT * 256 * 2;
constexpr size_t SZ_K = (size_t)NB * 8 * NKEY * 96 * 2, SZ_VT = (size_t)NB * 8 * 64 * NKEY * 2, SZ_XT = (size_t)256 * NB * NKEY * 2;
constexpr size_t SZ_QL = (size_t)NB * 8 * SEQ * 96 * 2, SZ_QC = (size_t)NB * 8 * CTXL * 96 * 2, SZ_ATT = (size_t)RT * 512 * 2;
constexpr size_t OFF_PROJ = OFF_BIG;
constexpr size_t OFF_QL = OFF_PROJ, OFF_QC = OFF_QL + SZ_QL, OFF_ATT = OFF_QC + SZ_QC;
static_assert(SZ_QL + SZ_QC + SZ_ATT <= SZ_PROJ, "overlay 1");
constexpr size_t OFF_NQ = al256(OFF_PROJ + SZ_PROJ);
constexpr size_t OFF_POOLA = OFF_NQ + SZ_NQ;
constexpr size_t OFF_ZT = OFF_NQ, OFF_HYT = OFF_ZT + SZ_XT;
static_assert(2 * SZ_XT <= SZ_NQ + SZ_R256, "overlay 2");
constexpr size_t OFF_K = al256(OFF_POOLA + SZ_R256);
constexpr size_t OFF_VT = al256(OFF_K + SZ_K);
constexpr size_t OFF_POOLO = al256(OFF_VT + SZ_VT);
constexpr size_t OFF_VXT = al256(OFF_POOLO + SZ_R256);
constexpr size_t OFF_BIG_END = al256(OFF_VXT + 3 * SZ_XT);
constexpr size_t OFF_ACT = OFF_BIG;
constexpr size_t SZ_ACT = (size_t)RT * DFF * 2;
static_assert(OFF_ACT + SZ_ACT <= OFF_BIG_END, "act overlay");
constexpr size_t OFF_HBUF2 = OFF_BIG_END;
constexpr size_t OFF_SS = al256(OFF_HBUF2 + (size_t)RT * 1024 * 2);
constexpr size_t OFF_SHW = al256(OFF_SS + (size_t)4 * RT * 4);
constexpr size_t OFF_BAR = al256(OFF_SHW + (size_t)2 * 2 * 17 * 4096 * 4);
constexpr size_t OFF_PART = al256(OFF_BAR + 3456 * 4);
constexpr size_t WS_END = al256(OFF_PART + (size_t)4 * RC * 1024 * 4);
static_assert(WS_END <= ((size_t)1 << 30), "workspace");

constexpr int LDS_BYTES = 131072 + 16;

struct Params {
    const float *x, *c, *ctx, *c_ctx, *w_mod, *b_mod, *g_mix, *g_mlp, *w_in, *g_q, *w_q_up, *g_kv, *w_kv_up, *pool_w, *pool_scale, *hy_conv_w, *hy_conv_b,
        *hy_f_w1, *hy_f_b1, *hy_f_freq1, *hy_f_w2, *hy_f_b2, *hy_f_freq2, *hy_f_w3, *hy_bias, *g_out, *w_out, *w_mlp1, *w_mlp2, *g_final;
    float* out; unsigned char* ws;
};

namespace pg8 {
#define PG8_LAS __attribute__((address_space(3)))
constexpr int BM = 256, BK = 64, HALF = 128, HTB = HALF * BK * 2, STAGE_BYTES = 8 * HTB, NXCD = 8, WGM = 8;
DI int lds_byte(int r, int c) { const int st = (r >> 4) * 2 + (c >> 5), rr = r & 15, cc = c & 31, ob = rr * 64 + cc * 2; return st * 1024 + (ob ^ (((ob >> 9) & 1) << 5)); }
DI void stage_rc(int b, int& R, int& C) { const int st = b / 1024, sb = b % 1024, swz = sb ^ (((sb >> 9) & 1) << 5); R = (st >> 1) * 16 + swz / 64; C = (st & 1) * 32 + (swz % 64) / 2; }
DI int perm32(int rho) { const int n = rho >> 4, i = rho & 15; return 8 * (i >> 2) + 4 * n + (i & 3); }
struct Unit { int pm, pn; };
struct Gemm { const bf16_t* A; const bf16_t* Bt; int M, N, K, lda, ldb; int mt; size_t kso; };
DI void unit_ptrs(const Gemm& g, const Unit& u, size_t tstepA, size_t tstepB, const char*& a, const char*& b) {
    int pm = u.pm; size_t ko = 0;
    if (g.mt) { const int ks = pm / g.mt; pm -= ks * g.mt; ko = (size_t)ks * g.kso; }
    a = (const char*)g.A + (size_t)pm * tstepA + ko; b = (const char*)g.Bt + (size_t)u.pn * tstepB + ko;
}
struct StaticOrder {
    int nM, nN, nwg, G, c;
    DI void init(int M, int N, int G_, int c_) { nM = M / BM; nN = N / BM; nwg = nM * nN; G = G_; c = c_; }
    DI bool next(int i, Unit& u) const {
        const long L = (long)i * G + c; if (L >= nwg) return false;
        int wgid = (int)L; { const int q = nwg / NXCD, r = nwg % NXCD, xcd = wgid % NXCD, off = wgid / NXCD; wgid = (xcd < r ? xcd * (q + 1) : r * (q + 1) + (xcd - r) * q) + off; }
        const int nig = WGM * nN, gid = wgid / nig, fm = gid * WGM, gsz = (nM - fm) < WGM ? (nM - fm) : WGM;
        u.pm = fm + ((wgid % nig) % gsz); u.pn = (wgid % nig) / gsz; return true;
    }
};
template <class Epi, bool ALIGN_EPI = true, bool SP2 = true>
DI void gemm_phase(PG8_LAS unsigned char* lds, const int tid, const Gemm g, const StaticOrder& S, const Epi& E) {
    const int wid = __builtin_amdgcn_readfirstlane(tid >> 6), lane = tid & 63, wr = wid >> 2, wc = wid & 3, fr = lane & 15, fq = lane >> 4;
    const int K = g.K, nt = K / BK;
    unsigned voffA[2], voffB[2];
#pragma unroll
    for (int i = 0; i < 2; ++i) { int R, C; stage_rc(tid * 16 + i * 8192, R, C); const int Rb = Epi::PERM ? ((R & ~31) + perm32(R & 31)) : R;
        voffA[i] = (unsigned)(R * g.lda + C) * 2u; voffB[i] = (unsigned)(Rb * g.ldb + C) * 2u; }
    const size_t kstep = (size_t)(BK * 2);
    const size_t hstepA = (size_t)HALF * g.lda * 2, hstepB = (size_t)HALF * g.ldb * 2;
    const size_t tstepA = 2 * hstepA, tstepB = 2 * hstepB;
    const unsigned ldsw = (unsigned)wid * 1024u;
    const int aoff = lds_byte(wr * 64 + fr, fq * 8), boff = lds_byte(wc * 32 + fr, fq * 8);
#define PG8_SA(b, h) (((b) * 2 + (h)) * HTB)
#define PG8_SB(b, h) ((4 + (b) * 2 + (h)) * HTB)
#define PG8_STAGE(bufoff, gbase, voff) do { _Pragma("unroll") for (int _i = 0; _i < 2; ++_i) \
        __builtin_amdgcn_global_load_lds((const unsigned*)((const char*)(gbase) + (voff)[_i]), (PG8_LAS unsigned*)(lds + (bufoff) + ldsw + _i * 8192), 16, 0, 0); } while (0)
#define PG8_LDA(dst, b, h) do { _Pragma("unroll") for (int m = 0; m < 4; ++m) _Pragma("unroll") for (int k = 0; k < 2; ++k) dst[m][k] = *(const PG8_LAS bf16x8*)(lds + PG8_SA(b, h) + aoff + m * 2048 + k * 1024); } while (0)
#define PG8_LDB(dst, b, h) do { _Pragma("unroll") for (int n = 0; n < 2; ++n) _Pragma("unroll") for (int k = 0; k < 2; ++k) dst[n][k] = *(const PG8_LAS bf16x8*)(lds + PG8_SB(b, h) + boff + n * 2048 + k * 1024); } while (0)
#define PG8_MMA(ai, bj, At, Bt) do { __builtin_amdgcn_s_setprio(1); _Pragma("unroll") for (int m = 0; m < 4; ++m) _Pragma("unroll") for (int n = 0; n < 2; ++n) _Pragma("unroll") for (int k = 0; k < 2; ++k) \
        acc[ai][bj][m][n] = __builtin_amdgcn_mfma_f32_16x16x32_bf16(Bt[n][k], At[m][k], acc[ai][bj][m][n], 0, 0, 0); __builtin_amdgcn_s_setprio(0); } while (0)
#define PG8_WAIT_V(n) asm volatile("s_waitcnt vmcnt(" #n ")" ::: "memory")
#define PG8_WAIT_L(n) asm volatile("s_waitcnt lgkmcnt(" #n ")" ::: "memory")
#define PG8_BAR __builtin_amdgcn_s_barrier()
#define PG8_SCHED __builtin_amdgcn_sched_barrier(0)
    Unit cur, nxt; int ui = 0;
    if (!S.next(0, cur)) return;
    f32x4 acc[2][2][4][2];
#pragma unroll
    for (int a = 0; a < 2; ++a)
#pragma unroll
        for (int b = 0; b < 2; ++b)
#pragma unroll
            for (int m = 0; m < 4; ++m)
#pragma unroll
                for (int n = 0; n < 2; ++n) acc[a][b][m][n] = (f32x4){0.f, 0.f, 0.f, 0.f};
    bf16x8 At[4][2], B0[2][2], B1[2][2];
    const char* cA; const char* cB; unit_ptrs(g, cur, tstepA, tstepB, cA, cB);
    if constexpr (SP2) {
        PG8_STAGE(PG8_SB(0, 0), cB, voffB); PG8_STAGE(PG8_SB(0, 1), cB + hstepB, voffB); PG8_STAGE(PG8_SA(0, 0), cA, voffA); PG8_STAGE(PG8_SA(0, 1), cA + hstepA, voffA);
        if (wr == 1) PG8_BAR;
        PG8_WAIT_V(2); PG8_BAR;
        PG8_STAGE(PG8_SB(1, 0), cB + kstep, voffB); PG8_STAGE(PG8_SA(1, 0), cA + kstep, voffA); PG8_STAGE(PG8_SB(1, 1), cB + hstepB + kstep, voffB);
        PG8_WAIT_V(6); PG8_BAR;
    } else {
        PG8_STAGE(PG8_SB(0, 0), cB, voffB); PG8_STAGE(PG8_SA(0, 0), cA, voffA); PG8_STAGE(PG8_SB(0, 1), cB + hstepB, voffB); PG8_STAGE(PG8_SA(0, 1), cA + hstepA, voffA);
        if (wr == 1) PG8_BAR;
        PG8_WAIT_V(4); PG8_BAR;
        PG8_STAGE(PG8_SB(1, 0), cB + kstep, voffB); PG8_STAGE(PG8_SA(1, 0), cA + kstep, voffA); PG8_STAGE(PG8_SB(1, 1), cB + hstepB + kstep, voffB);
        PG8_WAIT_V(6); PG8_BAR;
    }
    for (;;) {
        const bool has_next = S.next(ui + 1, nxt);
        const char* nA = cA; const char* nB = cB; if (has_next) unit_ptrs(g, nxt, tstepA, tstepB, nA, nB);
        for (int t = 0; t < nt; t += 2) {
            const bool last = (t == nt - 2);
            const char* a1 = cA + (size_t)(t + 1) * kstep;
            const char* a2 = last ? nA : cA + (size_t)(t + 2) * kstep; const char* b2 = last ? nB : cB + (size_t)(t + 2) * kstep;
            const char* a3 = a2 + kstep; const char* b3 = b2 + kstep;
            if constexpr (SP2) {
            PG8_LDB(B0, 0, 0); PG8_LDB(B1, 0, 1); PG8_SCHED; PG8_LDA(At, 0, 0); PG8_STAGE(PG8_SA(1, 1), a1 + hstepA, voffA);
            PG8_WAIT_V(8); PG8_WAIT_L(0); PG8_BAR; PG8_MMA(0, 0, At, B0); PG8_MMA(0, 1, At, B1); PG8_BAR; PG8_SCHED;
            PG8_LDA(At, 0, 1); PG8_STAGE(PG8_SB(0, 0), b2, voffB); PG8_STAGE(PG8_SB(0, 1), b2 + hstepB, voffB); PG8_STAGE(PG8_SA(0, 0), a2, voffA);
            PG8_WAIT_V(8); PG8_WAIT_L(0); PG8_BAR; PG8_MMA(1, 0, At, B0); PG8_MMA(1, 1, At, B1); PG8_BAR; PG8_SCHED;
            PG8_LDB(B0, 1, 0); PG8_LDB(B1, 1, 1); PG8_SCHED; PG8_LDA(At, 1, 0); PG8_STAGE(PG8_SA(0, 1), a2 + hstepA, voffA);
            PG8_WAIT_V(8); PG8_WAIT_L(0); PG8_BAR; PG8_MMA(0, 0, At, B0); PG8_MMA(0, 1, At, B1); PG8_BAR; PG8_SCHED;
            PG8_LDA(At, 1, 1); PG8_STAGE(PG8_SB(1, 0), b3, voffB); PG8_STAGE(PG8_SB(1, 1), b3 + hstepB, voffB); PG8_STAGE(PG8_SA(1, 0), a3, voffA);
            PG8_WAIT_V(8); PG8_WAIT_L(0); PG8_BAR; PG8_MMA(1, 0, At, B0); PG8_MMA(1, 1, At, B1); PG8_BAR; PG8_SCHED;
            } else {
            PG8_LDB(B0, 0, 0); PG8_SCHED; PG8_LDA(At, 0, 0); PG8_STAGE(PG8_SA(1, 1), a1 + hstepA, voffA);
            PG8_WAIT_L(8); PG8_BAR; PG8_WAIT_L(0); PG8_MMA(0, 0, At, B0); PG8_BAR; PG8_SCHED;
            PG8_LDB(B1, 0, 1); PG8_STAGE(PG8_SB(0, 0), b2, voffB);
            PG8_BAR; PG8_WAIT_L(0); PG8_MMA(0, 1, At, B1); PG8_BAR;
            PG8_LDA(At, 0, 1); PG8_STAGE(PG8_SA(0, 0), a2, voffA);
            PG8_BAR; PG8_WAIT_L(0); PG8_MMA(1, 0, At, B0); PG8_BAR; PG8_SCHED;
            PG8_STAGE(PG8_SB(0, 1), b2 + hstepB, voffB);
            PG8_WAIT_V(6); PG8_BAR; PG8_MMA(1, 1, At, B1); PG8_BAR;
            PG8_LDB(B0, 1, 0); PG8_SCHED; PG8_LDA(At, 1, 0); PG8_STAGE(PG8_SA(0, 1), a2 + hstepA, voffA);
            PG8_WAIT_L(8); PG8_BAR; PG8_WAIT_L(0); PG8_MMA(0, 0, At, B0); PG8_BAR; PG8_SCHED;
            PG8_LDB(B1, 1, 1); PG8_STAGE(PG8_SB(1, 0), b3, voffB);
            PG8_BAR; PG8_WAIT_L(0); PG8_MMA(0, 1, At, B1); PG8_BAR;
            PG8_LDA(At, 1, 1); PG8_STAGE(PG8_SA(1, 0), a3, voffA);
            PG8_BAR; PG8_WAIT_L(0); PG8_MMA(1, 0, At, B0); PG8_BAR; PG8_SCHED;
            PG8_STAGE(PG8_SB(1, 1), b3 + hstepB, voffB);
            PG8_WAIT_V(6); PG8_BAR; PG8_MMA(1, 1, At, B1); PG8_BAR;
            }
        }
        if constexpr (ALIGN_EPI) { if (wr == 0) PG8_BAR; }
        E(acc, cur, wr, wc, fr, fq);
        if (!has_next) break;
#pragma unroll
        for (int a = 0; a < 2; ++a)
#pragma unroll
            for (int b = 0; b < 2; ++b)
#pragma unroll
                for (int m = 0; m < 4; ++m)
#pragma unroll
                    for (int n = 0; n < 2; ++n) acc[a][b][m][n] = (f32x4){0.f, 0.f, 0.f, 0.f};
        cur = nxt; cA = nA; cB = nB; ++ui;
        if constexpr (ALIGN_EPI) { if (wr == 1) PG8_BAR; }
    }
    PG8_WAIT_V(0);
    if constexpr (!ALIGN_EPI) { if (wr == 0) PG8_BAR; }
    PG8_BAR;
#undef PG8_SA
#undef PG8_SB
#undef PG8_STAGE
#undef PG8_LDA
#undef PG8_LDB
#undef PG8_MMA
#undef PG8_WAIT_V
#undef PG8_WAIT_L
#undef PG8_BAR
#undef PG8_SCHED
}
}
using pg8::Unit;
typedef const f32x4 (&AccRef)[2][2][4][2];

template <int ACT> struct EpiBf16 {
    static constexpr bool PERM = true;
    bf16_t* O; int ldc, ncols;
    DI void operator()(AccRef acc, const Unit& u, int wr, int wc, int fr_, int fq_) const {
        int fr = fr_, fq = fq_; asm volatile("" : "+v"(fr), "+v"(fq));
        const int row0 = u.pm * 256 + wr * 64 + fr, col0 = u.pn * 256 + wc * 32 + 8 * fq;
#pragma unroll
        for (int ai = 0; ai < 2; ++ai)
#pragma unroll
            for (int m = 0; m < 4; ++m) { bf16_t* rowp = O + (size_t)(row0 + ai * 128 + m * 16) * ldc + col0;
#pragma unroll
                for (int bj = 0; bj < 2; ++bj) { f32x4 v0 = acc[ai][bj][m][0], v1 = acc[ai][bj][m][1];
                    if (ACT == 1) {
#pragma unroll
                        for (int j = 0; j < 4; ++j) { const float a = fmaxf(v0[j], 0.f), b = fmaxf(v1[j], 0.f); v0[j] = a * a; v1[j] = b * b; } }
                    u32x4 w; w.x = pk2(v0[0], v0[1]); w.y = pk2(v0[2], v0[3]); w.z = pk2(v1[0], v1[1]); w.w = pk2(v1[2], v1[3]);
                    if (col0 + bj * 128 < ncols) *(u32x4*)(rowp + bj * 128) = w; } }
    }
};
template <bool FUSE> struct EpiResid {
    static constexpr bool PERM = false;
    const float* srcL; float* dstL; const float* srcC; float* dstC; const float* gate;
    bf16_t* A2; float* ss; const float* gain; const float* scl;
    DI void operator()(AccRef acc, const Unit& u, int wr, int wc, int fr_, int fq_) const {
        int fr = fr_, fq = fq_; asm volatile("" : "+v"(fr), "+v"(fq));
        const int row0 = u.pm * 256 + wr * 64 + fr, col0 = u.pn * 256 + wc * 32 + 4 * fq, ln = fq * 16 + fr;
        const bool isctx = (u.pm * 256) >= RL;
        const int mrt = isctx ? 16 : ((u.pm * 256) >> 12);
        const float* sbase = isctx ? srcC - (size_t)RL * 1024 : srcL; float* dbase = isctx ? dstC - (size_t)RL * 1024 : dstL;
        const float* gp = gate + (size_t)mrt * 6144;
        f32x4 gv[2][2], gs[2][2];
#pragma unroll
        for (int bj = 0; bj < 2; ++bj)
#pragma unroll
            for (int n = 0; n < 2; ++n) { const int c = col0 + bj * 128 + n * 16; gv[bj][n] = *(const f32x4*)(gp + c);
                if (FUSE) gs[bj][n] = *(const f32x4*)(gain + c) * (*(const f32x4*)(scl + (size_t)mrt * 6144 + c) + 1.0f); }
#pragma unroll
        for (int ai = 0; ai < 2; ++ai)
#pragma unroll
          for (int mp = 0; mp < 2; ++mp) {
            f32x4 xv[2][2][2];
#pragma unroll
            for (int mm = 0; mm < 2; ++mm)
#pragma unroll
                for (int bj = 0; bj < 2; ++bj)
#pragma unroll
                    for (int n = 0; n < 2; ++n) xv[mm][bj][n] = *(const f32x4*)(sbase + (size_t)(row0 + ai * 128 + (2 * mp + mm) * 16) * 1024 + col0 + bj * 128 + n * 16);
#pragma unroll
            for (int mm = 0; mm < 2; ++mm) { const int m = 2 * mp + mm; const int r = row0 + ai * 128 + m * 16;
                float part = 0.f;
#pragma unroll
                for (int bj = 0; bj < 2; ++bj)
#pragma unroll
                    for (int n = 0; n < 2; ++n) { const int c = col0 + bj * 128 + n * 16;
                        const f32x4 xn = xv[mm][bj][n] + gv[bj][n] * acc[ai][bj][m][n];
                        *(f32x4*)(dbase + (size_t)r * 1024 + c) = xn;
                        if (FUSE) { const f32x4 an = xn * gs[bj][n]; u32x2 w; w.x = pk2(an[0], an[1]); w.y = pk2(an[2], an[3]); *(u32x2*)(A2 + (size_t)r * 1024 + c) = w;
                            part += (xn[0] * xn[0] + xn[1] * xn[1]) + (xn[2] * xn[2] + xn[3] * xn[3]); } }
                if (FUSE) { part += xshfl(part, 16, ln); part += xshfl(part, 32, ln);
                    if (fq == 0) (void)__hip_atomic_fetch_add((__attribute__((address_space(1))) float*)(ss + r), part, __ATOMIC_RELAXED, __HIP_MEMORY_SCOPE_AGENT); } }
          }
    }
};
template <bool SRC_F32, bool FUSE> struct EpiResid2 {
    static constexpr bool PERM = true;
    const float* srcL; const float* srcC; bf16_t* xr; const float* gate;
    bf16_t* A2; float* ss; const float* gain; const float* scl;
    DI void operator()(AccRef acc, const Unit& u, int wr, int wc, int fr_, int fq_) const {
        int fr = fr_, fq = fq_; asm volatile("" : "+v"(fr), "+v"(fq));
        typedef __attribute__((address_space(1))) float gfloat; typedef __attribute__((address_space(1))) unsigned short gbf16;
        typedef __attribute__((address_space(1))) f32x4 gf32x4; typedef __attribute__((address_space(1))) u32x4 gu32x4;
        const int row0 = u.pm * 256 + wr * 64 + fr, col0 = u.pn * 256 + wc * 32 + 8 * fq, ln = fq * 16 + fr;
        const bool isctx = (u.pm * 256) >= RL;
        const int mrt = isctx ? 16 : ((u.pm * 256) >> 12);
        const gfloat* __restrict__ sbase = (const gfloat*)(isctx ? srcC - (size_t)RL * 1024 : srcL);
        gbf16* __restrict__ xb = (gbf16*)xr; gbf16* __restrict__ a2 = (gbf16*)A2;
        const gfloat* __restrict__ gp = (const gfloat*)(gate + (size_t)mrt * 6144);
        f32x4 gv[2][2], gs[2][2];
#pragma unroll
        for (int bj = 0; bj < 2; ++bj)
#pragma unroll
            for (int hf = 0; hf < 2; ++hf) { const int c = col0 + bj * 128 + 4 * hf; gv[bj][hf] = *(const gf32x4*)(gp + c);
                if (FUSE) gs[bj][hf] = *(const gf32x4*)((const gfloat*)gain + c) * (*(const gf32x4*)((const gfloat*)scl + (size_t)mrt * 6144 + c) + 1.0f); }
#pragma unroll
        for (int ai = 0; ai < 2; ++ai) {
            constexpr int NB_ = SRC_F32 ? 2 : 1, RB_ = SRC_F32 ? 2 : 4;
#pragma unroll
          for (int mp = 0; mp < NB_; ++mp) {
            f32x4 xf[SRC_F32 ? 2 : 1][2][2]; u32x4 xw[SRC_F32 ? 1 : 4][2];
#pragma unroll
            for (int mm = 0; mm < RB_; ++mm)
#pragma unroll
                for (int bj = 0; bj < 2; ++bj) { const size_t off = (size_t)(row0 + ai * 128 + (RB_ * mp + mm) * 16) * 1024 + col0 + bj * 128;
                    if (SRC_F32) { xf[mm][bj][0] = *(const gf32x4*)(sbase + off); xf[mm][bj][1] = *(const gf32x4*)(sbase + off + 4); }
                    else xw[mm][bj] = *(const gu32x4*)(xb + off); }
#pragma unroll
            for (int mm = 0; mm < RB_; ++mm) { const int m = RB_ * mp + mm; const int r = row0 + ai * 128 + m * 16;
                float part = 0.f;
#pragma unroll
                for (int bj = 0; bj < 2; ++bj) { const size_t off = (size_t)r * 1024 + col0 + bj * 128;
                    f32x4 x0, x1;
                    if (SRC_F32) { x0 = xf[mm][bj][0]; x1 = xf[mm][bj][1]; }
                    else { const u32x4 w = xw[mm][bj]; x0 = (f32x4){bflo(w.x), bfhi(w.x), bflo(w.y), bfhi(w.y)}; x1 = (f32x4){bflo(w.z), bfhi(w.z), bflo(w.w), bfhi(w.w)}; }
                    const f32x4 n0 = x0 + gv[bj][0] * acc[ai][bj][m][0], n1 = x1 + gv[bj][1] * acc[ai][bj][m][1];
                    u32x4 o; o.x = pk2(n0[0], n0[1]); o.y = pk2(n0[2], n0[3]); o.z = pk2(n1[0], n1[1]); o.w = pk2(n1[2], n1[3]);
                    *(gu32x4*)(xb + off) = o;
                    if (FUSE) { const f32x4 a0 = n0 * gs[bj][0], a1 = n1 * gs[bj][1];
                        u32x4 w2; w2.x = pk2(a0[0], a0[1]); w2.y = pk2(a0[2], a0[3]); w2.z = pk2(a1[0], a1[1]); w2.w = pk2(a1[2], a1[3]);
                        *(gu32x4*)(a2 + off) = w2;
                        part += ((n0[0] * n0[0] + n0[1] * n0[1]) + (n0[2] * n0[2] + n0[3] * n0[3])) + ((n1[0] * n1[0] + n1[1] * n1[1]) + (n1[2] * n1[2] + n1[3] * n1[3])); } }
                if (FUSE) { part += xshfl(part, 16, ln); part += xshfl(part, 32, ln);
                    if (fq == 0) (void)__hip_atomic_fetch_add((__attribute__((address_space(1))) float*)(ss + r), part, __ATOMIC_RELAXED, __HIP_MEMORY_SCOPE_AGENT); } }
          }
        }
    }
};
template <int ACT> struct EpiNormBf16 {
    static constexpr bool PERM = true;
    bf16_t* O; int ldc, ncols; const float* ss; const float* shw;
    DI void operator()(AccRef acc, const Unit& u, int wr, int wc, int fr_, int fq_) const {
        int fr = fr_, fq = fq_; asm volatile("" : "+v"(fr), "+v"(fq));
        const int row0 = u.pm * 256 + wr * 64 + fr, col0 = u.pn * 256 + wc * 32 + 8 * fq;
        const int mrt = (u.pm * 256 < RL) ? ((u.pm * 256) >> 12) : 16;
        f32x4 sv[2][2];
#pragma unroll
        for (int bj = 0; bj < 2; ++bj) { sv[bj][0] = *(const f32x4*)(shw + (size_t)mrt * 4096 + col0 + bj * 128); sv[bj][1] = *(const f32x4*)(shw + (size_t)mrt * 4096 + col0 + bj * 128 + 4); }
#pragma unroll
        for (int ai = 0; ai < 2; ++ai)
#pragma unroll
            for (int m = 0; m < 4; ++m) { const int r = row0 + ai * 128 + m * 16; bf16_t* rowp = O + (size_t)r * ldc + col0;
                const float rs = rsqrtf(ss[r] * (1.f / 1024.f) + EPS);
#pragma unroll
                for (int bj = 0; bj < 2; ++bj) { f32x4 v0 = acc[ai][bj][m][0] * rs + sv[bj][0], v1 = acc[ai][bj][m][1] * rs + sv[bj][1];
                    if (ACT == 1) {
#pragma unroll
                        for (int jx = 0; jx < 4; ++jx) { const float a = fmaxf(v0[jx], 0.f), b = fmaxf(v1[jx], 0.f); v0[jx] = a * a; v1[jx] = b * b; } }
                    u32x4 w; w.x = pk2(v0[0], v0[1]); w.y = pk2(v0[2], v0[3]); w.z = pk2(v1[0], v1[1]); w.w = pk2(v1[2], v1[3]);
                    if (col0 + bj * 128 < ncols) *(u32x4*)(rowp + bj * 128) = w; } }
    }
};
struct EpiPartial {
    static constexpr bool PERM = false;
    float* part;
    DI void operator()(AccRef acc, const Unit& u, int wr, int wc, int fr_, int fq_) const {
        int fr = fr_, fq = fq_; asm volatile("" : "+v"(fr), "+v"(fq));
        const int ks = u.pm >> 4, pm = u.pm & 15;
        const int row0 = pm * 256 + wr * 64 + fr, col0 = u.pn * 256 + wc * 32 + 4 * fq;
        float* base = part + ((size_t)ks * RC + row0) * 1024 + col0;
#pragma unroll
        for (int ai = 0; ai < 2; ++ai)
#pragma unroll
            for (int m = 0; m < 4; ++m)
#pragma unroll
                for (int bj = 0; bj < 2; ++bj)
#pragma unroll
                    for (int n = 0; n < 2; ++n) *(f32x4*)(base + (size_t)(ai * 128 + m * 16) * 1024 + bj * 128 + n * 16) = acc[ai][bj][m][n];
    }
};
struct EpiQ {
    static constexpr bool PERM = false;
    bf16_t* QL; bf16_t* QC; const f32x2* rope;
    DI void operator()(AccRef acc, const Unit& u, int wr, int wc, int fr_, int fq_) const {
        int fr = fr_, fq = fq_; asm volatile("" : "+v"(fr), "+v"(fq));
        const int row0 = u.pm * 256 + wr * 64 + fr, colb = u.pn * 256 + wc * 32;
        const bool isctx = (u.pm * 256) >= RL;
#pragma unroll
        for (int ai = 0; ai < 2; ++ai)
#pragma unroll
            for (int m = 0; m < 4; ++m) { const int r = row0 + ai * 128 + m * 16;
                int b, t; bf16_t* qb;
                if (!isctx) { b = r >> 12; t = r & 4095; qb = QL + ((size_t)b * 8 * SEQ + t) * 96; }
                else { const int rc = r - RL; b = rc >> 8; t = rc & 255; qb = QC + ((size_t)b * 8 * CTXL + t) * 96; }
                const size_t hstride = (size_t)(isctx ? CTXL : SEQ) * 96;
#pragma unroll
                for (int bj = 0; bj < 2; ++bj)
#pragma unroll
                    for (int n = 0; n < 2; ++n) { const int cg0 = colb + bj * 128 + n * 16;
                        const int h = cg0 / 96, cc0 = cg0 - h * 96;
                        f32x4 v = acc[ai][bj][m][n];
                        const int ln = fq * 16 + fr; f32x4 pv; pv[0] = xshfl(v[0], 32, ln); pv[1] = xshfl(v[1], 32, ln); pv[2] = xshfl(v[2], 32, ln); pv[3] = xshfl(v[3], 32, ln);
                        if (cc0 >= 64 && !isctx) { const int axis = (cc0 - 64) >> 4, half = fq >> 1, f0 = 4 * (fq & 1); const int p = axis ? (t & 63) : (t >> 6);
#pragma unroll
                            for (int i = 0; i < 4; ++i) { const f32x2 cs = rope[p * 8 + f0 + i]; v[i] = half ? (v[i] * cs.x + pv[i] * cs.y) : (v[i] * cs.x - pv[i] * cs.y); } }
                        u32x2 w; w.x = pk2(v[0] * QSCALE, v[1] * QSCALE); w.y = pk2(v[2] * QSCALE, v[3] * QSCALE);
                        *(u32x2*)(qb + (size_t)h * hstride + cc0 + 4 * fq) = w; } }
    }
};
struct EpiKn {
    static constexpr bool PERM = true;
    bf16_t* Kb;
    DI void operator()(AccRef acc, const Unit& u, int wr, int wc, int fr_, int fq_) const {
        int fr = fr_, fq = fq_; asm volatile("" : "+v"(fr), "+v"(fq));
        const int row0 = u.pm * 256 + wr * 64 + fr, col0 = u.pn * 256 + wc * 32 + 8 * fq;
#pragma unroll
        for (int ai = 0; ai < 2; ++ai)
#pragma unroll
            for (int m = 0; m < 4; ++m) { const int r = row0 + ai * 128 + m * 16; int b, pos;
                if (r < RL) { b = r >> 12; pos = CTXL + (r & 4095); } else { const int rc = r - RL; b = rc >> 8; pos = rc & 255; }
#pragma unroll
                for (int bj = 0; bj < 2; ++bj) { const int c = col0 + bj * 128, h = c >> 6, j = c & 63;
                    const f32x4 v0 = acc[ai][bj][m][0], v1 = acc[ai][bj][m][1];
                    u32x4 w; w.x = pk2(v0[0], v0[1]); w.y = pk2(v0[2], v0[3]); w.z = pk2(v1[0], v1[1]); w.w = pk2(v1[2], v1[3]);
                    *(u32x4*)(Kb + ((size_t)(b * 8 + h) * NKEY + pos) * 96 + j) = w; } }
    }
};
struct EpiVT {
    static constexpr bool PERM = true;
    bf16_t* VT;
    DI void operator()(AccRef acc, const Unit& u, int wr, int wc, int fr_, int fq_) const {
        int fr = fr_, fq = fq_; asm volatile("" : "+v"(fr), "+v"(fq));
        const int row0 = u.pm * 256 + wr * 64 + fr, col0 = u.pn * 256 + wc * 32 + 8 * fq;
#pragma unroll
        for (int ai = 0; ai < 2; ++ai)
#pragma unroll
            for (int m = 0; m < 4; ++m) { const int f = row0 + ai * 128 + m * 16, h = f >> 6, dv = f & 63;
#pragma unroll
                for (int bj = 0; bj < 2; ++bj) { const int r = col0 + bj * 128; int b, pos;
                    if (r < RL) { b = r >> 12; pos = CTXL + (r & 4095); } else { const int rc = r - RL; b = rc >> 8; pos = rc & 255; }
                    const f32x4 v0 = acc[ai][bj][m][0], v1 = acc[ai][bj][m][1];
                    const int a = (pos >> 3) & 1; bf16_t* vp = VT + ((size_t)(b * 8 + h) * 64 + dv) * NKEY + (pos & ~15) + 4 * a;
                    u32x2 wl, wh; wl.x = pk2(v0[0], v0[1]); wl.y = pk2(v0[2], v0[3]); wh.x = pk2(v1[0], v1[1]); wh.y = pk2(v1[2], v1[3]);
                    *(u32x2*)vp = wl; *(u32x2*)(vp + 8) = wh; } }
    }
};

#define XB_TMO      128
#define XB_XCNT(j)  (256  + 64 * (j))
#define XB_XSUB(j)  (1280 + 64 * (j))
#define XB_XGEN(j)  (2304 + 64 * (j))
#define XB_TOP      3328
#define XB_TOPGEN   3392
#define XCD_BAR_WORDS 3456
#define XB_SPIN_CAP (1u << 22)
DI unsigned xb_ld(unsigned* p)              { return __hip_atomic_load(p, __ATOMIC_RELAXED, __HIP_MEMORY_SCOPE_AGENT); }
DI unsigned xb_add(unsigned* p, unsigned v) { return __hip_atomic_fetch_add(p, v, __ATOMIC_RELAXED, __HIP_MEMORY_SCOPE_AGENT); }
DI unsigned xb_xcc_id() { return (unsigned)__builtin_amdgcn_s_getreg((3 << 11) | 20) & 0xFu; }
#define XB_SPIN(cond, bar) do { unsigned _sp = 0; while (cond) { __builtin_amdgcn_s_sleep(1); \
    if ((++_sp & 255u) == 0u) { if (xb_ld(&(bar)[XB_TMO])) break; if (_sp > XB_SPIN_CAP) { atomicAdd(&(bar)[XB_TMO], 1u); break; } } } } while (0)
DI void xcd_barrier_post(unsigned* bar, bool t0) { if (t0) (void)xb_add(&bar[XB_XCNT(xb_xcc_id())], 1u); }
DI void xcd_barrier_complete(unsigned* bar, unsigned x, unsigned& nloc, unsigned& nx) {
    const unsigned G = gridDim.x;
    unsigned sum, cnt, mine, sp = 0u;
    for (;;) {
        sum = 0u; cnt = 0u; mine = 0u;
#pragma unroll
        for (unsigned j = 0; j < 16; ++j) { const unsigned c = xb_ld(&bar[XB_XCNT(j)]); sum += c; cnt += (c > 0u) ? 1u : 0u; mine = (j == x) ? c : mine; }
        if (sum == G) break;
        __builtin_amdgcn_s_sleep(1);
        if ((++sp & 255u) == 0u) { if (xb_ld(&bar[XB_TMO])) break; if (sp > XB_SPIN_CAP) { atomicAdd(&bar[XB_TMO], 1u); break; } }
    }
    nloc = mine > 0u ? mine : 1u; nx = cnt > 0u ? cnt : 1u;
}
DI void xcd_barrier(unsigned* bar, volatile LAS unsigned* st, bool t0) {
    asm volatile("s_waitcnt vmcnt(0)" ::: "memory");
    __syncthreads();
    if (t0) {
        const unsigned x = xb_xcc_id();
        __builtin_amdgcn_s_waitcnt(0);
        unsigned nloc = st[0], nx = st[1];
        if (nloc == 0u) { xcd_barrier_complete(bar, x, nloc, nx); st[0] = nloc; st[1] = nx; }
        const unsigned old = xb_add(&bar[XB_XSUB(x)], 1u);
        const unsigned gen = old / nloc;
        if (old + 1u == (gen + 1u) * nloc) {
            __builtin_amdgcn_fence(__ATOMIC_RELEASE, "agent");
            asm volatile("s_waitcnt vmcnt(0)" ::: "memory");
            const unsigned og = xb_add(&bar[XB_TOP], 1u);
            const unsigned tg = og / nx;
            if (og + 1u == (tg + 1u) * nx) xb_add(&bar[XB_TOPGEN], 1u);
            else XB_SPIN(xb_ld(&bar[XB_TOPGEN]) == tg, bar);
            __builtin_amdgcn_fence(__ATOMIC_ACQUIRE, "agent");
            xb_add(&bar[XB_XGEN(x)], 1u);
            asm volatile("s_waitcnt vmcnt(0)" ::: "memory");
        } else {
            XB_SPIN(xb_ld(&bar[XB_XGEN(x)]) == gen, bar);
            __builtin_amdgcn_fence(__ATOMIC_ACQUIRE, "agent");
            asm volatile("s_waitcnt vmcnt(0)" ::: "memory");
        }
    }
    __syncthreads();
}

struct Ctx {
    LAS unsigned char* lds; int tid, lane, wave, G, bid;
};

DI void transpose_item(const float* W, int ldw, int k0, int n0, bf16_t* WT, int ldt, int orow0, LAS float* scr, int lane) {
#pragma unroll 8
    for (int i = 0; i < 32; ++i) { const int kk = 2 * i + (lane >> 5); scr[kk * 33 + (lane & 31)] = W[(size_t)(k0 + kk) * ldw + n0 + (lane & 31)]; }
    LDS_WAIT();
    const int c = lane & 7;
#pragma unroll
    for (int j = 0; j < 4; ++j) { const int n = (lane >> 3) + 8 * j; const LAS float* s = scr + (8 * c) * 33 + n;
        u32x4 o; o.x = pk2(s[0 * 33], s[1 * 33]); o.y = pk2(s[2 * 33], s[3 * 33]); o.z = pk2(s[4 * 33], s[5 * 33]); o.w = pk2(s[6 * 33], s[7 * 33]);
        *(u32x4*)(WT + (size_t)(orow0 + n) * ldt + k0 + 8 * c) = o; }
    LDS_WAIT();
}

DI void setup_adaln(const Params& P, const Ctx& C, int u) {
    const int l = u / 96, j0 = (u % 96) * 64;
    LAS float* sl = (LAS float*)C.lds;
    LAS float* part = sl + 17 * 1024;
    for (int idx = C.tid; idx < 17 * 1024; idx += 512) { const int r = idx >> 10, k = idx & 1023; const float v = (r < 16) ? P.c[r * 1024 + k] : P.c_ctx[k]; sl[idx] = v / (1.f + expf(-v)); }
    __syncthreads();
    const int ks = C.tid >> 6, jj = C.tid & 63;
    float acc[17];
#pragma unroll
    for (int r = 0; r < 17; ++r) acc[r] = 0.f;
    const float* wp = P.w_mod + ((size_t)l * 1024 + ks * 128) * 6144 + j0 + jj;
    for (int k = 0; k < 128; ++k) { const float w = wp[(size_t)k * 6144];
#pragma unroll
        for (int r = 0; r < 17; ++r) acc[r] += sl[r * 1024 + ks * 128 + k] * w; }
#pragma unroll
    for (int r = 0; r < 17; ++r) part[(ks * 17 + r) * 64 + jj] = acc[r];
    __syncthreads();
    float* mod = (float*)(P.ws + OFF_MOD);
    for (int idx = C.tid; idx < 17 * 64; idx += 512) { const int r = idx >> 6, j2 = idx & 63; float s = 0.f;
#pragma unroll
        for (int q = 0; q < 8; ++q) s += part[(q * 17 + r) * 64 + j2];
        mod[((size_t)l * 17 + r) * 6144 + j0 + j2] = s + P.b_mod[l * 6144 + j0 + j2]; }
    __syncthreads();
}

DI void setup_filter(const Params& P, const Ctx& C, int l, int n, int d0, float* H) {
    LAS float* zs = (LAS float*)C.lds;
    LAS float* h1s = zs + 16 * 33;
    LAS float* h2s = h1s + 16 * 64;
    for (int idx = C.tid; idx < 16 * 33; idx += 512) { const int p = idx / 33, e = idx - p * 33; const int d = d0 + p; float v;
        if (e == 0) v = (float)d / (float)(n - 1);
        else { const int k = (e - 1) & 15; const float fr = 1e-4f + (float)k * ((15.0f - 1e-4f) / 15.0f); const float wp = 6.283185307179586f * (float)d / (float)n; const float ang = fr * wp;
            v = (e <= 16) ? cosf(ang) : -sinf(ang); }
        zs[idx] = v; }
    __syncthreads();
    for (int idx = C.tid; idx < 1024; idx += 512) { const int p = idx >> 6, m = idx & 63; float s = P.hy_f_b1[l * 64 + m];
        for (int e = 0; e < 33; ++e) s += zs[p * 33 + e] * P.hy_f_w1[(l * 33 + e) * 64 + m];
        h1s[idx] = sinf(P.hy_f_freq1[l * 64 + m] * s); }
    __syncthreads();
    for (int idx = C.tid; idx < 1024; idx += 512) { const int p = idx >> 6, m = idx & 63; float s = P.hy_f_b2[l * 64 + m];
        for (int e = 0; e < 64; ++e) s += h1s[p * 64 + e] * P.hy_f_w2[(l * 64 + e) * 64 + m];
        h2s[idx] = sinf(P.hy_f_freq2[l * 64 + m] * s); }
    __syncthreads();
    const float la = -3.0701134573253946f, lb = -15.350567286626973f;
#pragma unroll 1
    for (int cc = 0; cc < 2; ++cc) { const int col = C.tid + 512 * cc;
        float acc[16];
#pragma unroll
        for (int p = 0; p < 16; ++p) acc[p] = 0.f;
        for (int e = 0; e < 64; ++e) { const float w = P.hy_f_w3[((size_t)l * 64 + e) * 1024 + col];
#pragma unroll
            for (int p = 0; p < 16; ++p) acc[p] += h2s[p * 64 + e] * w; }
        const int ch = col & 255; const float delta = fabsf(la + (float)ch * ((lb - la) / 255.0f));
        float* hp = H + (size_t)col * n + d0;
#pragma unroll
        for (int q = 0; q < 4; ++q) { f32x4 o;
#pragma unroll
            for (int i = 0; i < 4; ++i) { const int p = 4 * q + i; const float td = (float)(d0 + p) / (float)(n - 1); o[i] = acc[p] * expf(-td * delta); }
            *(f32x4*)(hp + 4 * q) = o; } }
    __syncthreads();
}

DI void phase_setup(const Params& P, const Ctx& C) {
    unsigned char* ws = P.ws;
    for (int u = C.bid; u < 192 + 512 + 16; u += C.G) {
        if (u < 192) setup_adaln(P, C, u);
        else if (u < 192 + 512) { const int v = u - 192, l = v >> 8, blk = v & 255; setup_filter(P, C, l, SEQ, blk * 16, (float*)(ws + OFF_HL) + (size_t)l * 1024 * 4096); }
        else { const int blk = u - 192 - 512; setup_filter(P, C, 0, CTXL, blk * 16, (float*)(ws + OFF_HC)); }
    }
    if (C.bid == 0) { f32x2* rt = (f32x2*)(ws + OFF_ROPE); const int p = C.tid >> 3, f = C.tid & 7; const float inv = exp2f(-(float)f * (13.287712379549449f / 8.0f)); const float a = (float)p * inv; rt[C.tid] = (f32x2){cosf(a), sinf(a)}; }
    LAS float* scr = (LAS float*)(C.lds + C.wave * 8448);
    const int gw = C.bid * 8 + C.wave, NGW = C.G * 8;
    constexpr int I_IN = 16 * 45, I_Q = 4 * 24, I_KV = 2 * 32, I_OUT = 16 * 32, I_M1 = 16 * 128, I_M2 = 64 * 32, I_L = I_IN + I_Q + I_KV + I_OUT + I_M1 + I_M2;
    for (int it = gw; it < 2 * I_L; it += NGW) {
        const int l = it / I_L; int r = it - l * I_L; unsigned char* wl = ws + OFF_W + (size_t)l * SZ_WLAYER;
        if (r < I_IN) { const int kb = r / 45, nb = r % 45; transpose_item(P.w_in + (size_t)l * 1024 * NIN, NIN, kb * 64, nb * 32, (bf16_t*)(wl + WO_IN), 1024, nb * 32, scr, C.lane); continue; } r -= I_IN;
        if (r < I_Q) { const int kb = r / 24, nb = r % 24; transpose_item(P.w_q_up + (size_t)l * 256 * 768, 768, kb * 64, nb * 32, (bf16_t*)(wl + WO_Q), 256, nb * 32, scr, C.lane); continue; } r -= I_Q;
        if (r < I_KV) { const int kb = r / 32, nb = r % 32, n0 = nb * 32, h = n0 >> 7, j0 = n0 & 127;
            bf16_t* dst = (bf16_t*)(wl + (j0 < 64 ? WO_KN : WO_V)); const int orow = h * 64 + (j0 & 63);
            transpose_item(P.w_kv_up + (size_t)l * 128 * 1024, 1024, kb * 64, n0, dst, 128, orow, scr, C.lane); continue; } r -= I_KV;
        if (r < I_OUT) { const int kb = r / 32, nb = r % 32; transpose_item(P.w_out + (size_t)l * 1024 * 1024, 1024, kb * 64, nb * 32, (bf16_t*)(wl + WO_OUT), 1024, nb * 32, scr, C.lane); continue; } r -= I_OUT;
        if (r < I_M1) { const int kb = r / 128, nb = r % 128; transpose_item(P.w_mlp1 + (size_t)l * 1024 * 4096, 4096, kb * 64, nb * 32, (bf16_t*)(wl + WO_M1), 1024, nb * 32, scr, C.lane); continue; } r -= I_M1;
        { const int kb = r / 32, nb = r % 32; transpose_item(P.w_mlp2 + (size_t)l * 4096 * 1024, 1024, kb * 64, nb * 32, (bf16_t*)(wl + WO_M2), 4096, nb * 32, scr, C.lane); }
    }
    const size_t gt = (size_t)C.bid * 512 + C.tid, NGT = (size_t)C.G * 512;
    for (size_t i = gt; i < (size_t)3 * RT; i += NGT) ((float*)(ws + OFF_SS))[RT + i] = 0.f;
    for (int l = 0; l < 2; ++l) { unsigned char* wl = ws + OFF_W + (size_t)l * SZ_WLAYER;
        for (size_t i = gt; i < 12288; i += NGT) *(u32x4*)(wl + WO_IN + (size_t)NIN * 2048 + i * 16) = (u32x4){0u, 0u, 0u, 0u};
        for (size_t i = gt; i < 65536; i += NGT) { const int n = (int)(i >> 8), k = (int)(i & 255), g = n >> 6;
            const float v = ((k >> 6) == g) ? P.pool_w[((l * 4 + g) * 64 + (k & 63)) * 64 + (n & 63)] * P.pool_scale[l * 256 + n] : 0.f;
            ((bf16_t*)(wl + WO_POOL))[i] = f2bf(v); }
    }
}

DI void shiftw_unit(const Params& P, const Ctx& C, int u) {
    const int l = u / 87, v = u % 87, which = (v >= 23) ? 1 : 0, j0 = (which ? v - 23 : v) * 64, N = which ? DFF : NIN;
    const float* W = which ? P.w_mlp1 + (size_t)l * 1024 * DFF : P.w_in + (size_t)l * 1024 * NIN;
    const float* mod = (const float*)(P.ws + OFF_MOD) + (size_t)l * 17 * 6144 + (which ? 3 : 0) * 1024;
    LAS float* sl = (LAS float*)C.lds;
    LAS float* part = sl + 17 * 1024;
    __syncthreads();
    for (int idx = C.tid; idx < 17 * 1024; idx += 512) { const int r = idx >> 10, k = idx & 1023; sl[idx] = mod[(size_t)r * 6144 + k]; }
    __syncthreads();
    const int ks = C.tid >> 6, jj = C.tid & 63; const bool ok = (j0 + jj) < N;
    float acc[17];
#pragma unroll
    for (int r = 0; r < 17; ++r) acc[r] = 0.f;
    const float* wp = W + (size_t)(ks * 128) * N + j0 + (ok ? jj : 0);
    for (int k = 0; k < 128; ++k) { const float w = wp[(size_t)k * N];
#pragma unroll
        for (int r = 0; r < 17; ++r) acc[r] += sl[r * 1024 + ks * 128 + k] * w; }
#pragma unroll
    for (int r = 0; r < 17; ++r) part[(ks * 17 + r) * 64 + jj] = acc[r];
    __syncthreads();
    float* shw = (float*)(P.ws + OFF_SHW) + (size_t)(l * 2 + which) * 17 * 4096;
    for (int idx = C.tid; idx < 17 * 64; idx += 512) { const int r = idx >> 6, j2 = idx & 63; float sacc = 0.f;
#pragma unroll
        for (int q = 0; q < 8; ++q) sacc += part[(q * 17 + r) * 64 + j2];
        if (j0 + j2 < N) shw[(size_t)r * 4096 + j0 + j2] = sacc; }
}
DI void phase_first(const Params& P, const Ctx& C) {
    const float* mod = (const float*)(P.ws + OFF_MOD);
    const float* gain = P.g_mix;
    bf16_t* hb = (bf16_t*)P.out; float* ss0 = (float*)(P.ws + OFF_SS);
    for (int row = C.bid * 8 + C.wave; row < RT; row += C.G * 8) {
        const float* xr = (row < RL) ? P.x + (size_t)row * 1024 : P.ctx + (size_t)(row - RL) * 1024;
        const int mr = (row < RL) ? (row >> 12) : 16;
        const float* sc = mod + (size_t)mr * 6144 + 1024;
        f32x4 v[4]; float ss = 0.f;
#pragma unroll
        for (int j = 0; j < 4; ++j) { v[j] = *(const f32x4*)(xr + 4 * C.lane + 256 * j); ss += (v[j][0] * v[j][0] + v[j][1] * v[j][1]) + (v[j][2] * v[j][2] + v[j][3] * v[j][3]); }
        ss = wave_sum(ss, C.lane);
        if (C.lane == 0) ss0[row] = ss;
#pragma unroll
        for (int j = 0; j < 4; ++j) { const int c = 4 * C.lane + 256 * j; const f32x4 g = *(const f32x4*)(gain + c), s1 = *(const f32x4*)(sc + c);
            const f32x4 y = v[j] * g * (s1 + 1.0f);
            u32x2 w; w.x = pk2(y[0], y[1]); w.y = pk2(y[2], y[3]);
            *(u32x2*)(hb + (size_t)row * 1024 + c) = w; }
    }
    for (int u = C.bid; u < 174; u += C.G) shiftw_unit(P, C, u);
}

DI float qsum16(float v, int lane) { v += xshfl(v, 1, lane); v += xshfl(v, 2, lane); v += xshfl(v, 4, lane); v += xshfl(v, 8, lane); return v; }
DI void unpack8(const u32x4 w, float (&a)[8]) { a[0] = bflo(w.x); a[1] = bfhi(w.x); a[2] = bflo(w.y); a[3] = bfhi(w.y); a[4] = bflo(w.z); a[5] = bfhi(w.z); a[6] = bflo(w.w); a[7] = bfhi(w.w); }
DI void phase_prep(const Params& P, const Ctx& C, int l) {
    unsigned char* ws = P.ws;
    const bf16_t* proj = (const bf16_t*)(ws + OFF_PROJ);
    bf16_t* NQ = (bf16_t*)(ws + OFF_NQ); bf16_t* Kb = (bf16_t*)(ws + OFF_K); bf16_t* poolA = (bf16_t*)(ws + OFF_POOLA); bf16_t* VXT = (bf16_t*)(ws + OFF_VXT);
    const f32x2* rope = (const f32x2*)(ws + OFF_ROPE);
    const float* gkv = P.g_kv + l * 128; const float* gq = P.g_q + l * 256;
    LAS bf16_t* L = (LAS bf16_t*)C.lds;
    constexpr int LS = 514;
    const int j = C.lane & 15, qw = C.lane >> 4;
    for (int u = C.bid; u < 1280; u += C.G) {
        int row0, b, t0, n, pos_off, ntok; bool isctx;
        if (u < 1024) { row0 = u * 64; b = row0 >> 12; t0 = row0 & 4095; n = SEQ; pos_off = CTXL; isctx = false; ntok = 64; }
        else { const int uc = u - 1024; row0 = RL + uc * 16; b = uc >> 4; t0 = (uc & 15) * 16; n = CTXL; pos_off = 0; isctx = true; ntok = 16; }
        const int lgt = isctx ? 1 : 3;
        const int rowseq = row0 - t0;
#pragma unroll
        for (int itk = 0; itk < 2; ++itk) { const bool act = !isctx || (itk == 0 && C.wave < 4);
            const int tok = !isctx ? (C.wave * 8 + itk * 4 + qw) : (act ? C.wave * 4 + qw : 0), row = row0 + tok, t = t0 + tok;
            const bf16_t* pr = proj + (size_t)row * NIN;
            const u32x4 wkv = *(const u32x4*)(pr + 8 * j), wq0 = *(const u32x4*)(pr + COL_Q + 8 * j), wq1 = *(const u32x4*)(pr + COL_Q + 128 + 8 * j);
            const unsigned wkr = *(const unsigned*)(pr + COL_KR + 2 * j);
            { float a[8]; unpack8(wkv, a); float ss = 0.f;
#pragma unroll
              for (int i = 0; i < 8; ++i) ss += a[i] * a[i];
              const float rs = rsqrtf(qsum16(ss, C.lane) * (1.f / 128.f) + EPS);
              const f32x4 g0 = *(const f32x4*)(gkv + 8 * j), g1 = *(const f32x4*)(gkv + 8 * j + 4);
              u32x4 o; o.x = pk2(a[0] * rs * g0[0], a[1] * rs * g0[1]); o.y = pk2(a[2] * rs * g0[2], a[3] * rs * g0[3]); o.z = pk2(a[4] * rs * g1[0], a[5] * rs * g1[1]); o.w = pk2(a[6] * rs * g1[2], a[7] * rs * g1[3]);
              if (act) *(u32x4*)(NQ + (size_t)row * 384 + 8 * j) = o; }
            { float a[8], c[8]; unpack8(wq0, a); unpack8(wq1, c); float ss = 0.f;
#pragma unroll
              for (int i = 0; i < 8; ++i) ss += a[i] * a[i] + c[i] * c[i];
              const float rs = rsqrtf(qsum16(ss, C.lane) * (1.f / 256.f) + EPS);
              const f32x4 g0 = *(const f32x4*)(gq + 8 * j), g1 = *(const f32x4*)(gq + 8 * j + 4), g2 = *(const f32x4*)(gq + 128 + 8 * j), g3 = *(const f32x4*)(gq + 128 + 8 * j + 4);
              u32x4 o; o.x = pk2(a[0] * rs * g0[0], a[1] * rs * g0[1]); o.y = pk2(a[2] * rs * g0[2], a[3] * rs * g0[3]); o.z = pk2(a[4] * rs * g1[0], a[5] * rs * g1[1]); o.w = pk2(a[6] * rs * g1[2], a[7] * rs * g1[3]);
              if (act) *(u32x4*)(NQ + (size_t)row * 384 + 128 + 8 * j) = o;
              o.x = pk2(c[0] * rs * g2[0], c[1] * rs * g2[1]); o.y = pk2(c[2] * rs * g2[2], c[3] * rs * g2[3]); o.z = pk2(c[4] * rs * g3[0], c[5] * rs * g3[1]); o.w = pk2(c[6] * rs * g3[2], c[7] * rs * g3[3]);
              if (act) *(u32x4*)(NQ + (size_t)row * 384 + 256 + 8 * j) = o; }
            { float x0 = bflo(wkr), x1 = bfhi(wkr); const float p0 = xshfl(x0, 4, C.lane), p1 = xshfl(x1, 4, C.lane);
              if (!isctx) { const int axis = j >> 3, half = (j >> 2) & 1, f = 2 * (j & 3); const int pp = axis ? (t & 63) : (t >> 6); const f32x2 c0 = rope[pp * 8 + f], c1 = rope[pp * 8 + f + 1];
                  x0 = half ? (x0 * c0.x + p0 * c0.y) : (x0 * c0.x - p0 * c0.y); x1 = half ? (x1 * c1.x + p1 * c1.y) : (x1 * c1.x - p1 * c1.y); }
              const unsigned w = pk2(x0, x1);
#pragma unroll
              for (int h = 0; h < 8; ++h) if (act) *(unsigned*)(Kb + ((size_t)(b * 8 + h) * NKEY + pos_off + t) * 96 + 64 + 2 * j) = w; }
        }
        for (int rd = 0; rd < 2; ++rd) {
            const int colbase = COL_POOL + rd * 512;
            __syncthreads();
            { u32x4 v[10];
#pragma unroll
              for (int i = 0; i < 10; ++i) { const int it = C.tid + 512 * i, rr = it >> 6, part = it & 63; const int t = t0 - 8 + rr;
                  v[i] = (u32x4){0u, 0u, 0u, 0u};
                  if (t >= 0 && t < n && rr < ntok + 16) v[i] = *(const u32x4*)(proj + (size_t)(rowseq + t) * NIN + colbase + part * 8); }
#pragma unroll
              for (int i = 0; i < 10; ++i) { const int it = C.tid + 512 * i, rr = it >> 6, part = it & 63;
                  LAS unsigned* d = (LAS unsigned*)(L + rr * LS + part * 8); if (rr < ntok + 16) d[0] = v[i].x; if (rr < ntok + 16) { d[1] = v[i].y; d[2] = v[i].z; d[3] = v[i].w; } } }
            __syncthreads();
            if (rd == 0) {
                for (int it = C.tid; it < ntok * 128; it += 512) { const int tok = it >> 7, cp = it & 127, c = 2 * cp, g = c >> 6, hw = 1 << g;
                    const int t = t0 + tok; const int lo = max(t - hw, 0), hi = min(t + hw, n);
                    float s0 = 0.f, s1 = 0.f;
                    for (int sidx = lo; sidx < hi; ++sidx) { const unsigned w = *(LAS const unsigned*)(L + (sidx - t0 + 8) * LS + c); s0 += bflo(w); s1 += bfhi(w); }
                    const unsigned wc = *(LAS const unsigned*)(L + (tok + 8) * LS + c);
                    const float inv = 1.f / (float)(hi - lo);
                    *(unsigned*)(poolA + (size_t)(row0 + tok) * 256 + c) = pk2(s0 * inv - bflo(wc), s1 * inv - bfhi(wc)); }
            }
            for (int kk = (rd == 0 ? 1 : 0); kk < 2; ++kk) { const int k = rd * 2 + kk - 1;
                const int cb = kk * 256;
                for (int it = C.tid; it < (256 << lgt); it += 512) { const int tg = it & ((1 << lgt) - 1), c = it >> lgt, ch = k * 256 + c;
                    const float w0 = P.hy_conv_w[(l * 3 + 0) * 768 + ch], w1 = P.hy_conv_w[(l * 3 + 1) * 768 + ch], w2 = P.hy_conv_w[(l * 3 + 2) * 768 + ch], bb = P.hy_conv_b[l * 768 + ch];
                    float xv[10];
#pragma unroll
                    for (int i = 0; i < 10; ++i) xv[i] = bf2f(L[(8 * tg + i + 7) * LS + cb + c]);
                    float o[8];
#pragma unroll
                    for (int i = 0; i < 8; ++i) o[i] = xv[i] * w0 + xv[i + 1] * w1 + xv[i + 2] * w2 + bb;
                    u32x4 w; w.x = pk2(o[0], o[1]); w.y = pk2(o[2], o[3]); w.z = pk2(o[4], o[5]); w.w = pk2(o[6], o[7]);
                    *(u32x4*)(VXT + (size_t)k * (SZ_XT / 2) + ((size_t)c * NB + b) * NKEY + pos_off + t0 + 8 * tg) = w; }
            }
        }
        __syncthreads();
    }
}

constexpr int KS_T = 64 * 104, VS_T = 64 * 72;
DI void attn_qk(LAS const bf16_t* Kc, const bf16x8 (&qf)[6], int r, int hh, f32x16& s0, f32x16& s1) {
#pragma unroll
    for (int i = 0; i < 16; ++i) { s0[i] = 0.f; s1[i] = 0.f; }
#pragma unroll
    for (int ks = 0; ks < 6; ++ks) {
        const bf16x8 a0 = *(LAS const bf16x8*)(Kc + r * 104 + 16 * ks + 8 * hh);
        const bf16x8 a1 = *(LAS const bf16x8*)(Kc + (32 + r) * 104 + 16 * ks + 8 * hh);
        s0 = __builtin_amdgcn_mfma_f32_32x32x16_bf16(a0, qf[ks], s0, 0, 0, 0);
        s1 = __builtin_amdgcn_mfma_f32_32x32x16_bf16(a1, qf[ks], s1, 0, 0, 0);
    }
}
struct AttnSt { f32x16 o0, o1; float mref, lsum; };
DI float vmax3(float a, float b, float c) { float d; asm("v_max3_f32 %0, %1, %2, %3" : "=v"(d) : "v"(a), "v"(b), "v"(c)); return d; }
template <bool HAS_NEXT>
DI void attn_tile(LAS const bf16_t* Kn, LAS const bf16_t* Vc, const bf16x8 (&qf)[6], int r, int hh, int lane, f32x16& s0, f32x16& s1, f32x16& n0, f32x16& n1, AttnSt& st, bool first) {
    bf16x8 kf[12], vf[8];
    __builtin_amdgcn_sched_barrier(0);
    if (HAS_NEXT) {
#pragma unroll
        for (int ks = 0; ks < 6; ++ks) { kf[2 * ks] = *(LAS const bf16x8*)(Kn + r * 104 + 16 * ks + 8 * hh); kf[2 * ks + 1] = *(LAS const bf16x8*)(Kn + (32 + r) * 104 + 16 * ks + 8 * hh); }
    }
    if (first) {
        float mx = vmax3(s0[0], s0[1], s0[2]);
#pragma unroll
        for (int i = 3; i < 15; i += 2) mx = vmax3(mx, s0[i], s0[i + 1]);
        mx = vmax3(mx, s0[15], s1[0]);
#pragma unroll
        for (int i = 1; i < 15; i += 2) mx = vmax3(mx, s1[i], s1[i + 1]);
        mx = fmaxf(mx, s1[15]);
        mx = fmaxf(mx, xshfl(mx, 32, lane));
        s0 = s0 - mx; s1 = s1 - mx; st.mref = mx;
    }
    __builtin_amdgcn_sched_barrier(0);
    if (HAS_NEXT) {
        const float nm = -st.mref;
#pragma unroll
        for (int i = 0; i < 16; ++i) { n0[i] = nm; n1[i] = nm; }
#pragma unroll
        for (int ks = 0; ks < 6; ++ks) { n0 = __builtin_amdgcn_mfma_f32_32x32x16_bf16(kf[2 * ks], qf[ks], n0, 0, 0, 0); n1 = __builtin_amdgcn_mfma_f32_32x32x16_bf16(kf[2 * ks + 1], qf[ks], n1, 0, 0, 0); }
    }
#pragma unroll
    for (int sidx = 0; sidx < 4; ++sidx) { vf[2 * sidx] = *(LAS const bf16x8*)(Vc + r * 72 + 16 * sidx + 8 * hh); vf[2 * sidx + 1] = *(LAS const bf16x8*)(Vc + (32 + r) * 72 + 16 * sidx + 8 * hh); }
#pragma unroll
    for (int i = 0; i < 16; ++i) { s0[i] = __builtin_amdgcn_exp2f(s0[i]); s1[i] = __builtin_amdgcn_exp2f(s1[i]); }
    float ps = 0.f;
    { const f32x16 sm = s0 + s1;
#pragma unroll
      for (int i = 0; i < 16; ++i) ps += sm[i]; }
    if (HAS_NEXT) {
#pragma unroll
        for (int i = 0; i < 12; ++i) { __builtin_amdgcn_sched_group_barrier(0x008, 1, 0); __builtin_amdgcn_sched_group_barrier(0x100, 1, 0); __builtin_amdgcn_sched_group_barrier(0x002, 4, 0); }
    }
    __builtin_amdgcn_sched_barrier(0);
    if (__builtin_amdgcn_ballot_w64(!(ps < 1.8446744e19f)) != 0ull) {
        const float sc = 5.421010862427522e-20f;
        s0 = s0 * sc; s1 = s1 * sc; ps *= sc; st.o0 = st.o0 * sc; st.o1 = st.o1 * sc; st.lsum *= sc; st.mref += 64.f;
        if (HAS_NEXT) { n0 = n0 - 64.f; n1 = n1 - 64.f; }
    }
    st.lsum += ps;
    u32x4 pw[4];
#pragma unroll
    for (int st4 = 0; st4 < 2; ++st4) {
        pw[st4].x = pk2(s0[8 * st4 + 0], s0[8 * st4 + 1]); pw[st4].y = pk2(s0[8 * st4 + 2], s0[8 * st4 + 3]); pw[st4].z = pk2(s0[8 * st4 + 4], s0[8 * st4 + 5]); pw[st4].w = pk2(s0[8 * st4 + 6], s0[8 * st4 + 7]);
        pw[2 + st4].x = pk2(s1[8 * st4 + 0], s1[8 * st4 + 1]); pw[2 + st4].y = pk2(s1[8 * st4 + 2], s1[8 * st4 + 3]); pw[2 + st4].z = pk2(s1[8 * st4 + 4], s1[8 * st4 + 5]); pw[2 + st4].w = pk2(s1[8 * st4 + 6], s1[8 * st4 + 7]); }
#pragma unroll
    for (int sidx = 0; sidx < 4; ++sidx) {
        const bf16x8 pf = __builtin_bit_cast(bf16x8, pw[sidx]);
        st.o0 = __builtin_amdgcn_mfma_f32_32x32x16_bf16(vf[2 * sidx], pf, st.o0, 0, 0, 0);
        st.o1 = __builtin_amdgcn_mfma_f32_32x32x16_bf16(vf[2 * sidx + 1], pf, st.o1, 0, 0, 0);
    }
    __builtin_amdgcn_sched_barrier(0);
}
constexpr int AT_NBUF = 5, AT_KB = 64 * 208, AT_VB = 64 * 144, AT_STAGE = AT_KB + AT_VB;
DI void attn_unit(const Ctx& C, const bf16_t* Qp, const bf16_t* Kp, const bf16_t* VTp, int nkeys, bf16_t* outp) {
    const int r = C.lane & 31, hh = C.lane >> 5;
    bf16x8 qf[6];
    { const bf16_t* qrow = Qp + (size_t)(C.wave * 32 + r) * 96 + 8 * hh;
#pragma unroll
      for (int ks = 0; ks < 6; ++ks) qf[ks] = *(const bf16x8*)(qrow + 16 * ks); }
    AttnSt st;
#pragma unroll
    for (int i = 0; i < 16; ++i) { st.o0[i] = 0.f; st.o1[i] = 0.f; }
    st.mref = 0.f; st.lsum = 0.f;
    const char* gb[3]; unsigned gv[3]; unsigned gstep[3]; unsigned lo[3];
#pragma unroll
    for (int k = 0; k < 3; ++k) { int pc = C.wave + 8 * k; if (pc >= 22) pc = C.wave;
        if (pc < 13) { const int q = pc * 64 + C.lane, row = q / 13, part = min(q - row * 13, 11); gb[k] = (const char*)Kp; gv[k] = (unsigned)(row * 192 + part * 16); gstep[k] = 64 * 192; lo[k] = pc * 1024; }
        else { const int q = (pc - 13) * 64 + C.lane, row = q / 9, part = min(q - row * 9, 7); gb[k] = (const char*)VTp; gv[k] = (unsigned)(row * (NKEY * 2) + part * 16); gstep[k] = 128; lo[k] = AT_KB + (pc - 13) * 1024; } }
    const int ntile = nkeys >> 6;
#define AT_ISSUE(tile, buf) do { const int _t = (tile) < ntile ? (tile) : ntile - 1; _Pragma("unroll") for (int _k = 0; _k < 3; ++_k) \
        __builtin_amdgcn_global_load_lds((const unsigned*)((gb[_k] + (size_t)_t * gstep[_k]) + gv[_k]), (LAS unsigned*)(C.lds + (buf) * AT_STAGE + lo[_k]), 16, 0, 0); } while (0)
#define AT_KPTR(buf) ((LAS const bf16_t*)(C.lds + (buf) * AT_STAGE))
#define AT_VPTR(buf) ((LAS const bf16_t*)(C.lds + (buf) * AT_STAGE + AT_KB))
#define AT_SEAM() do { asm volatile("s_waitcnt vmcnt(6)" ::: "memory"); __builtin_amdgcn_s_barrier(); asm volatile("" ::: "memory"); } while (0)
#define AT_NEXT(b) (((b) == AT_NBUF - 1) ? 0 : (b) + 1)
#define AT_PREV(b) (((b) == 0) ? AT_NBUF - 1 : (b) - 1)
    __syncthreads();
    AT_ISSUE(0, 0); AT_ISSUE(1, 1); AT_ISSUE(2, 2); AT_ISSUE(3, 3);
    AT_SEAM();
    f32x16 sa0, sa1, sb0, sb1;
    attn_qk(AT_KPTR(0), qf, r, hh, sa0, sa1);
    int bc = 0, it = 0;
    for (; it + 2 < ntile; it += 2) {
        { const int bn = AT_NEXT(bc); AT_ISSUE(it + 4, AT_PREV(bc));
          attn_tile<true>(AT_KPTR(bn), AT_VPTR(bc), qf, r, hh, C.lane, sa0, sa1, sb0, sb1, st, it == 0);
          AT_SEAM(); bc = bn; }
        { const int bn = AT_NEXT(bc); AT_ISSUE(it + 5, AT_PREV(bc));
          attn_tile<true>(AT_KPTR(bn), AT_VPTR(bc), qf, r, hh, C.lane, sb0, sb1, sa0, sa1, st, false);
          AT_SEAM(); bc = bn; }
    }
    { const int bn = AT_NEXT(bc); AT_ISSUE(ntile, AT_PREV(bc));
      attn_tile<true>(AT_KPTR(bn), AT_VPTR(bc), qf, r, hh, C.lane, sa0, sa1, sb0, sb1, st, false);
      AT_SEAM(); bc = bn; }
    attn_tile<false>(AT_KPTR(0), AT_VPTR(bc), qf, r, hh, C.lane, sb0, sb1, sa0, sa1, st, false);
    asm volatile("s_waitcnt vmcnt(0)" ::: "memory");
#undef AT_ISSUE
#undef AT_KPTR
#undef AT_VPTR
#undef AT_SEAM
#undef AT_NEXT
#undef AT_PREV
    const float ltot = st.lsum + xshfl(st.lsum, 32, C.lane);
    const float inv = 1.f / ltot;
    bf16_t* orow = outp + (size_t)(C.wave * 32 + r) * 512 + 4 * hh;
#pragma unroll
    for (int g = 0; g < 4; ++g) {
        u32x2 w0, w1;
        w0.x = pk2(st.o0[4 * g] * inv, st.o0[4 * g + 1] * inv); w0.y = pk2(st.o0[4 * g + 2] * inv, st.o0[4 * g + 3] * inv);
        w1.x = pk2(st.o1[4 * g] * inv, st.o1[4 * g + 1] * inv); w1.y = pk2(st.o1[4 * g + 2] * inv, st.o1[4 * g + 3] * inv);
        *(u32x2*)(orow + 8 * g) = w0; *(u32x2*)(orow + 32 + 8 * g) = w1;
    }
}

DI void phase_attn(const Params& P, const Ctx& C, int l) {
    unsigned char* ws = P.ws;
    const bf16_t* QL = (const bf16_t*)(ws + OFF_QL); const bf16_t* QC = (const bf16_t*)(ws + OFF_QC);
    const bf16_t* Kb = (const bf16_t*)(ws + OFF_K); const bf16_t* VT = (const bf16_t*)(ws + OFF_VT);
    bf16_t* att = (bf16_t*)(ws + OFF_ATT);
    const int nun = 2048 + (l == 0 ? 128 : 0);
    for (int u = C.bid; u < nun; u += C.G) {
        if (u < 2048) { const int j = u / C.G, w = u - j * C.G;
            const int qb = (w >> 3) & 15, bh = (C.G == 256) ? (j * 16 + (w & 7) * 2 + (w >> 7)) : (u >> 4), b = bh >> 3, h = bh & 7; const int qb2 = (C.G == 256) ? qb : (u & 15);
            attn_unit(C, QL + ((size_t)bh * SEQ + qb2 * 256) * 96, Kb + (size_t)bh * NKEY * 96, VT + (size_t)bh * 64 * NKEY, NKEY,
                      att + ((size_t)b * SEQ + qb2 * 256) * 512 + h * 64); }
        else { const int bh = u - 2048, b = bh >> 3, h = bh & 7;
            attn_unit(C, QC + (size_t)bh * CTXL * 96, Kb + (size_t)bh * NKEY * 96, VT + (size_t)bh * 64 * NKEY, CTXL,
                      att + ((size_t)RL + b * CTXL) * 512 + h * 64); }
    }
    __syncthreads();
}

DI float hval(const float* Hf, const float* Hb, int n, int m) { if (m > 2 * n - 2) return 0.f; const int d = n - 1 - m; return d >= 0 ? Hf[d] : Hb[-d]; }
DI bf16x8 lda_tile(LAS const unsigned char* p) { LAS const unsigned* q = (LAS const unsigned*)p; u32x4 v; v.x = q[0]; v.y = q[1]; v.z = q[2]; v.w = q[3]; return __builtin_bit_cast(bf16x8, v); }

DI void hyena_unit(const Ctx& C, const float* Hf, const float* Hb, int n, const bf16_t* UT, const bf16_t* XT, bf16_t* OT, int pos_off, float bias) {
    LAS bf16_t* R0 = (LAS bf16_t*)C.lds; LAS bf16_t* R1 = R0 + 8192; LAS float* red = (LAS float*)(C.lds + 32768);
    __syncthreads();
    float asum = 0.f;
    for (int m = C.tid; m < 2 * n; m += 512) { const float v0 = hval(Hf, Hb, n, m), v1 = hval(Hf, Hb, n, m + 1); R0[m] = f2bf(v0); R1[m] = f2bf(v1); asum += fabsf(v0); }
    asum = wave_sum(asum, C.lane);
    if (C.lane == 0) red[C.wave] = asum;
    __syncthreads();
    float tot = 0.f;
#pragma unroll
    for (int w = 0; w < 8; ++w) tot += red[w];
    const float invn = 1.f / tot;
    const int i = C.lane & 15, g = C.lane >> 4;
    const int npass = n >> 8, nj = n >> 5;
    for (int pass = C.wave; pass < npass; pass += 8) {
        const int I0 = 16 * pass;
        const int m0 = (n - 1) - 16 * I0 - i + 8 * g;
        LAS const unsigned char* a0 = C.lds + (m0 & 1) * 16384 + (m0 & ~1) * 2;
        f32x4 acc[16]; bf16x8 W[16];
#pragma unroll
        for (int s = 0; s < 16; ++s) { acc[s] = (f32x4){0.f, 0.f, 0.f, 0.f}; W[s] = lda_tile(a0 - 32 * s); }
        const bf16_t* ub = UT + (size_t)i * NKEY + pos_off + 8 * g;
        bf16x8 bq[4];
#pragma unroll
        for (int k = 0; k < 3; ++k) bq[k] = *(const bf16x8*)(ub + 32 * min(k, nj - 1));
        for (int j0 = 0; j0 < nj; j0 += 8) {
#pragma unroll
            for (int u = 0; u < 8; ++u) { const int j = j0 + u;
                acc[14] = __builtin_amdgcn_mfma_f32_16x16x32_bf16(W[(14 - 2 * u + 16) & 15], bq[u & 3], acc[14], 0, 0, 0);
                acc[15] = __builtin_amdgcn_mfma_f32_16x16x32_bf16(W[(15 - 2 * u + 16) & 15], bq[u & 3], acc[15], 0, 0, 0);
                __builtin_amdgcn_sched_barrier(0);
                W[(14 - 2 * u + 16) & 15] = lda_tile(a0 + 64 * (j + 1));
                W[(15 - 2 * u + 16) & 15] = lda_tile(a0 + 64 * (j + 1) - 32);
                bq[(u + 3) & 3] = *(const bf16x8*)(ub + 32 * min(j + 3, nj - 1));
                __builtin_amdgcn_sched_barrier(0);
#pragma unroll
                for (int ii = 0; ii < 14; ++ii) acc[ii] = __builtin_amdgcn_mfma_f32_16x16x32_bf16(W[(ii - 2 * u + 16) & 15], bq[u & 3], acc[ii], 0, 0, 0);
                __builtin_amdgcn_sched_barrier(0); }
        }
#pragma unroll
        for (int ii = 0; ii < 16; ++ii) { const size_t off = (size_t)i * NKEY + pos_off + 16 * (I0 + ii) + 4 * g;
            const u32x2 uu = *(const u32x2*)(UT + off), xx = *(const u32x2*)(XT + off);
            const float y0 = acc[ii][0] * invn + bflo(uu.x) * bias, y1 = acc[ii][1] * invn + bfhi(uu.x) * bias, y2 = acc[ii][2] * invn + bflo(uu.y) * bias, y3 = acc[ii][3] * invn + bfhi(uu.y) * bias;
            u32x2 w; w.x = pk2(bflo(xx.x) * y0, bfhi(xx.x) * y1); w.y = pk2(bflo(xx.y) * y2, bfhi(xx.y) * y3);
            *(u32x2*)(OT + off) = w; }
    }
}

DI void phase_hyena(const Params& P, const Ctx& C, int l, int o) {
    unsigned char* ws = P.ws;
    const bf16_t* VXT = (const bf16_t*)(ws + OFF_VXT); const size_t XS = SZ_XT / 2;
    const bf16_t* UTb = o == 0 ? VXT : (const bf16_t*)(ws + OFF_ZT);
    const bf16_t* XTb = o == 0 ? VXT + XS : VXT + 2 * XS;
    bf16_t* OTb = o == 0 ? (bf16_t*)(ws + OFF_ZT) : (bf16_t*)(ws + OFF_HYT);
    const float* HL = (const float*)(ws + OFF_HL) + (size_t)l * 1024 * 4096; const float* HC = (const float*)(ws + OFF_HC);
    const int nun = 256 + (l == 0 ? 256 : 0);
    for (int u = C.bid; u < nun; u += C.G) {
        const int c = u & 255; const size_t co = (size_t)c * NB * NKEY; const float bias = P.hy_bias[(l * 2 + o) * 256 + c];
        if (u < 256) hyena_unit(C, HL + (size_t)(o * 512 + c) * 4096, HL + (size_t)(o * 512 + 256 + c) * 4096, SEQ, UTb + co, XTb + co, OTb + co, CTXL, bias);
        else hyena_unit(C, HC + (size_t)(o * 512 + c) * 256, HC + (size_t)(o * 512 + 256 + c) * 256, CTXL, UTb + co, XTb + co, OTb + co, 0, bias);
    }
    __syncthreads();
}

DI void phase_merge(const Params& P, const Ctx& C, int l) {
    unsigned char* ws = P.ws;
    const bf16_t* att = (const bf16_t*)(ws + OFF_ATT); const bf16_t* po = (const bf16_t*)(ws + OFF_POOLO); const bf16_t* hyT = (const bf16_t*)(ws + OFF_HYT);
    bf16_t* mb = (bf16_t*)P.out;
    const float* go = P.g_out + l * 1024;
    LAS bf16_t* L = (LAS bf16_t*)C.lds;
    const int nun = (l == 0) ? 1280 : 1024;
    const int j = C.lane & 15, qw = C.lane >> 4;
    for (int u = C.bid; u < nun; u += C.G) {
        int row0, b, t0, pos_off; bool isctx;
        if (u < 1024) { row0 = u * 64; b = row0 >> 12; t0 = row0 & 4095; pos_off = CTXL; isctx = false; }
        else { const int uc = u - 1024; row0 = RL + uc * 16; b = uc >> 4; t0 = (uc & 15) * 16; pos_off = 0; isctx = true; }
        const int nparts = isctx ? 2 : 8;
        __syncthreads();
        { u32x4 v[4];
#pragma unroll
          for (int i = 0; i < 4; ++i) { const int it = C.tid + 512 * i, c = it >> 3, part = it & 7; v[i] = (u32x4){0u, 0u, 0u, 0u}; if (part < nparts) v[i] = *(const u32x4*)(hyT + ((size_t)c * NB + b) * NKEY + pos_off + t0 + part * 8); }
#pragma unroll
          for (int i = 0; i < 4; ++i) { const int it = C.tid + 512 * i, c = it >> 3, part = it & 7; LAS unsigned* d = (LAS unsigned*)(L + c * 66 + part * 8); d[0] = v[i].x; d[1] = v[i].y; d[2] = v[i].z; d[3] = v[i].w; } }
#pragma unroll
        for (int itk = 0; itk < 2; ++itk) { const bool act = !isctx || (itk == 0 && C.wave < 4);
            const int tok = !isctx ? (C.wave * 8 + itk * 4 + qw) : (act ? C.wave * 4 + qw : 0), row = row0 + tok;
            bf16_t* mr = mb + (size_t)row * 1024;
            u32x4 wa[4], wp[2];
#pragma unroll
            for (int q = 0; q < 4; ++q) wa[q] = *(const u32x4*)(att + (size_t)row * 512 + 8 * j + 128 * q);
#pragma unroll
            for (int q = 0; q < 2; ++q) wp[q] = *(const u32x4*)(po + (size_t)row * 256 + 8 * j + 128 * q);
            { float a[4][8]; float ss = 0.f;
#pragma unroll
              for (int q = 0; q < 4; ++q) { unpack8(wa[q], a[q]);
#pragma unroll
                  for (int i = 0; i < 8; ++i) ss += a[q][i] * a[q][i]; }
              const float rs = rsqrtf(qsum16(ss, C.lane) * (1.f / 512.f) + EPS);
#pragma unroll
              for (int q = 0; q < 4; ++q) { const f32x4 g0 = *(const f32x4*)(go + 8 * j + 128 * q), g1 = *(const f32x4*)(go + 8 * j + 128 * q + 4);
                  u32x4 o; o.x = pk2(a[q][0] * rs * g0[0], a[q][1] * rs * g0[1]); o.y = pk2(a[q][2] * rs * g0[2], a[q][3] * rs * g0[3]); o.z = pk2(a[q][4] * rs * g1[0], a[q][5] * rs * g1[1]); o.w = pk2(a[q][6] * rs * g1[2], a[q][7] * rs * g1[3]);
                  if (act) *(u32x4*)(mr + 8 * j + 128 * q) = o; } }
            { float a[2][8]; float ss = 0.f;
#pragma unroll
              for (int q = 0; q < 2; ++q) { unpack8(wp[q], a[q]);
#pragma unroll
                  for (int i = 0; i < 8; ++i) ss += a[q][i] * a[q][i]; }
              const float rs = rsqrtf(qsum16(ss, C.lane) * (1.f / 256.f) + EPS);
#pragma unroll
              for (int q = 0; q < 2; ++q) { const f32x4 g0 = *(const f32x4*)(go + 512 + 8 * j + 128 * q), g1 = *(const f32x4*)(go + 512 + 8 * j + 128 * q + 4);
                  u32x4 o; o.x = pk2(a[q][0] * rs * g0[0], a[q][1] * rs * g0[1]); o.y = pk2(a[q][2] * rs * g0[2], a[q][3] * rs * g0[3]); o.z = pk2(a[q][4] * rs * g1[0], a[q][5] * rs * g1[1]); o.w = pk2(a[q][6] * rs * g1[2], a[q][7] * rs * g1[3]);
                  if (act) *(u32x4*)(mr + 512 + 8 * j + 128 * q) = o; } }
        }
        __syncthreads();
#pragma unroll
        for (int itk = 0; itk < 2; ++itk) { const bool act = !isctx || (itk == 0 && C.wave < 4);
            const int tok = !isctx ? (C.wave * 8 + itk * 4 + qw) : (act ? C.wave * 4 + qw : 0), row = row0 + tok;
            bf16_t* mr = mb + (size_t)row * 1024 + 768;
            float a[8][2]; float ss = 0.f;
#pragma unroll
            for (int i = 0; i < 8; ++i) { const int c = 2 * j + 32 * i; a[i][0] = bf2f(L[c * 66 + tok]); a[i][1] = bf2f(L[(c + 1) * 66 + tok]); ss += a[i][0] * a[i][0] + a[i][1] * a[i][1]; }
            const float rs = rsqrtf(qsum16(ss, C.lane) * (1.f / 256.f) + EPS);
#pragma unroll
            for (int i = 0; i < 8; ++i) { const int c = 2 * j + 32 * i; const f32x2 g = *(const f32x2*)(go + 768 + c); if (act) *(unsigned*)(mr + c) = pk2(a[i][0] * rs * g.x, a[i][1] * rs * g.y); }
        }
    }
    __syncthreads();
}

DI void phase_ctxfin(const Params& P, const Ctx& C) {
    const float* mod0 = (const float*)(P.ws + OFF_MOD); const float* mod1 = mod0 + (size_t)17 * 6144;
    const float* gate = mod0 + (size_t)16 * 6144 + 5 * 1024;
    const float* sc = mod1 + (size_t)16 * 6144 + 1 * 1024;
    const float* gain = P.g_mix + 1024;
    bf16_t* xrb = (bf16_t*)(P.ws + OFF_XR) + (size_t)RL * 1024; const float* part = (const float*)(P.ws + OFF_PART);
    bf16_t* hb = (bf16_t*)P.out; float* ss2 = (float*)(P.ws + OFF_SS) + (size_t)2 * RT;
    for (int row = C.bid * 8 + C.wave; row < RC; row += C.G * 8) {
        bf16_t* xr = xrb + (size_t)row * 1024;
        f32x4 v[4]; float ss = 0.f;
#pragma unroll
        for (int j = 0; j < 4; ++j) { const int c = 4 * C.lane + 256 * j; f32x4 a = *(const f32x4*)(part + (size_t)row * 1024 + c);
#pragma unroll
            for (int ks = 1; ks < 4; ++ks) a = a + *(const f32x4*)(part + ((size_t)ks * RC + row) * 1024 + c);
            const u32x2 xw = *(const u32x2*)(xr + c);
            v[j] = (f32x4){bflo(xw.x), bfhi(xw.x), bflo(xw.y), bfhi(xw.y)} + *(const f32x4*)(gate + c) * a;
            u32x2 o; o.x = pk2(v[j][0], v[j][1]); o.y = pk2(v[j][2], v[j][3]); *(u32x2*)(xr + c) = o;
            ss += (v[j][0] * v[j][0] + v[j][1] * v[j][1]) + (v[j][2] * v[j][2] + v[j][3] * v[j][3]); }
        ss = wave_sum(ss, C.lane);
        if (C.lane == 0) ss2[RL + row] = ss;
#pragma unroll
        for (int j = 0; j < 4; ++j) { const int c = 4 * C.lane + 256 * j; const f32x4 y = v[j] * *(const f32x4*)(gain + c) * (*(const f32x4*)(sc + c) + 1.0f);
            u32x2 w; w.x = pk2(y[0], y[1]); w.y = pk2(y[2], y[3]);
            *(u32x2*)(hb + (size_t)(RL + row) * 1024 + c) = w; }
    }
}

DI void phase_final(const Params& P, const Ctx& C) {
    for (int row = C.bid * 8 + C.wave; row < RL; row += C.G * 8) {
        float* xr = P.out + (size_t)row * 1024; const bf16_t* xb = (const bf16_t*)(P.ws + OFF_XR) + (size_t)row * 1024;
        f32x4 v[4]; float ss = 0.f;
#pragma unroll
        for (int j = 0; j < 4; ++j) { const u32x2 w = *(const u32x2*)(xb + 4 * C.lane + 256 * j); v[j] = (f32x4){bflo(w.x), bfhi(w.x), bflo(w.y), bfhi(w.y)};
            ss += (v[j][0] * v[j][0] + v[j][1] * v[j][1]) + (v[j][2] * v[j][2] + v[j][3] * v[j][3]); }
        const float rs = rsqrtf(wave_sum(ss, C.lane) * (1.f / 1024.f) + EPS);
#pragma unroll
        for (int j = 0; j < 4; ++j) { const f32x4 g = *(const f32x4*)(P.g_final + 4 * C.lane + 256 * j); *(f32x4*)(xr + 4 * C.lane + 256 * j) = v[j] * rs * g; }
    }
}

DI Ctx make_ctx(LAS unsigned char* lds, int wave_s) {
    Ctx C; int bid = blockIdx.x, G = gridDim.x, wv = wave_s;
    int lane; asm volatile("v_mbcnt_lo_u32_b32 %0, -1, 0\n\tv_mbcnt_hi_u32_b32 %0, -1, %0" : "=v"(lane)); asm volatile("" : "+s"(bid)); asm volatile("" : "+s"(G)); asm volatile("" : "+s"(wv));
    C.lds = lds; C.tid = wv * 64 + lane; C.lane = lane; C.wave = wv; C.G = G; C.bid = bid; return C;
}
DI unsigned char* fresh_ws(const Params& P) { unsigned char* w = P.ws; asm volatile("" : "+s"(w)); return w; }

__global__ void __launch_bounds__(512, 2) mega_fwd(Params P) {
    extern __shared__ __attribute__((aligned(16))) unsigned char lds_raw[];
    cg::grid_group grid = cg::this_grid();
    LAS unsigned char* lds = (LAS unsigned char*)lds_raw;
    const int wave_s = __builtin_amdgcn_readfirstlane((int)(threadIdx.x >> 6));
#define GSYNC() do { const Ctx _c = make_ctx(lds, wave_s); xcd_barrier((unsigned*)(fresh_ws(P) + OFF_BAR), (volatile LAS unsigned*)(lds + 131072), _c.tid == 0); } while (0)
    { const Ctx C = make_ctx(lds, wave_s);
      if (C.tid < 4) ((LAS unsigned*)(lds + 131072))[C.tid] = 0u;
      xcd_barrier_post((unsigned*)(P.ws + OFF_BAR), C.tid == 0);
      phase_setup(P, C); }
    if (P.ws == nullptr) grid.sync();
    GSYNC();
    { const Ctx C = make_ctx(lds, wave_s); phase_first(P, C); }
    GSYNC();
#pragma unroll 1
    for (int li = 0; li < 2; ++li) {
        int l = li; asm volatile("" : "+s"(l));
        const bool last = (l == 1);
        const int Mrows = last ? RL : RT;
        { const Ctx C = make_ctx(lds, wave_s); unsigned char* ws = fresh_ws(P); unsigned char* wl = ws + OFF_W + (size_t)l * SZ_WLAYER; pg8::StaticOrder S;
          pg8::Gemm g{(const bf16_t*)P.out, (const bf16_t*)(wl + WO_IN), RT, NINP, 1024, 1024, 1024}; S.init(g.M, g.N, C.G, C.bid);
          EpiNormBf16<0> e{(bf16_t*)(ws + OFF_PROJ), NIN, NIN, (const float*)(ws + OFF_SS) + (size_t)(l == 0 ? 0 : 2) * RT, (const float*)(ws + OFF_SHW) + (size_t)(l * 2 + 0) * 17 * 4096};
          pg8::gemm_phase(C.lds, C.tid, g, S, e); }
        GSYNC();
        { const Ctx C = make_ctx(lds, wave_s); phase_prep(P, C, l); }
        GSYNC();
        { const Ctx C = make_ctx(lds, wave_s); unsigned char* ws = fresh_ws(P); unsigned char* wl = ws + OFF_W + (size_t)l * SZ_WLAYER; pg8::StaticOrder S;
          pg8::Gemm g{(const bf16_t*)(ws + OFF_NQ) + 128, (const bf16_t*)(wl + WO_Q), Mrows, 768, 256, 384, 256}; S.init(g.M, g.N, C.G, C.bid);
          EpiQ e{(bf16_t*)(ws + OFF_QL), (bf16_t*)(ws + OFF_QC), (const f32x2*)(ws + OFF_ROPE)}; pg8::gemm_phase(C.lds, C.tid, g, S, e); }
        __syncthreads();
        { const Ctx C = make_ctx(lds, wave_s); unsigned char* ws = fresh_ws(P); unsigned char* wl = ws + OFF_W + (size_t)l * SZ_WLAYER; pg8::StaticOrder S;
          pg8::Gemm g{(const bf16_t*)(ws + OFF_NQ), (const bf16_t*)(wl + WO_KN), RT, 512, 128, 384, 128}; S.init(g.M, g.N, C.G, C.bid);
          EpiKn e{(bf16_t*)(ws + OFF_K)}; pg8::gemm_phase(C.lds, C.tid, g, S, e); }
        __syncthreads();
        { const Ctx C = make_ctx(lds, wave_s); unsigned char* ws = fresh_ws(P); unsigned char* wl = ws + OFF_W + (size_t)l * SZ_WLAYER; pg8::StaticOrder S;
          pg8::Gemm g{(const bf16_t*)(wl + WO_V), (const bf16_t*)(ws + OFF_NQ), 512, RT, 128, 128, 384}; S.init(g.M, g.N, C.G, C.bid);
          EpiVT e{(bf16_t*)(ws + OFF_VT)}; pg8::gemm_phase(C.lds, C.tid, g, S, e); }
        __syncthreads();
        { const Ctx C = make_ctx(lds, wave_s); unsigned char* ws = fresh_ws(P); unsigned char* wl = ws + OFF_W + (size_t)l * SZ_WLAYER; pg8::StaticOrder S;
          pg8::Gemm g{(const bf16_t*)(ws + OFF_POOLA), (const bf16_t*)(wl + WO_POOL), Mrows, 256, 256, 256, 256}; S.init(g.M, g.N, C.G, C.bid);
          EpiBf16<0> e{(bf16_t*)(ws + OFF_POOLO), 256, 256}; pg8::gemm_phase(C.lds, C.tid, g, S, e); }
        GSYNC();
        { const Ctx C = make_ctx(lds, wave_s); phase_attn(P, C, l); }
        { const Ctx C = make_ctx(lds, wave_s); phase_hyena(P, C, l, 0); }
        asm volatile("s_waitcnt vmcnt(0)" ::: "memory"); __builtin_amdgcn_fence(__ATOMIC_SEQ_CST, "workgroup"); __syncthreads();
        { const Ctx C = make_ctx(lds, wave_s); phase_hyena(P, C, l, 1); }
        GSYNC();
        { const Ctx C = make_ctx(lds, wave_s); phase_merge(P, C, l); }
        GSYNC();
        { const Ctx C = make_ctx(lds, wave_s); unsigned char* ws = fresh_ws(P); unsigned char* wl = ws + OFF_W + (size_t)l * SZ_WLAYER; pg8::StaticOrder S;
          const float* modl = (const float*)(ws + OFF_MOD) + (size_t)l * 17 * 6144;
          pg8::Gemm g{(const bf16_t*)P.out, (const bf16_t*)(wl + WO_OUT), Mrows, 1024, 1024, 1024, 1024}; S.init(g.M, g.N, C.G, C.bid);
          if (l == 0) { EpiResid2<true, true> e{P.x, P.ctx, (bf16_t*)(ws + OFF_XR), modl + 2 * 1024, (bf16_t*)(ws + OFF_HBUF2), (float*)(ws + OFF_SS) + (size_t)1 * RT, P.g_mlp + l * 1024, modl + 4 * 1024};
            pg8::gemm_phase(C.lds, C.tid, g, S, e); }
          else { EpiResid2<false, true> e{nullptr, nullptr, (bf16_t*)(ws + OFF_XR), modl + 2 * 1024, (bf16_t*)(ws + OFF_HBUF2), (float*)(ws + OFF_SS) + (size_t)3 * RT, P.g_mlp + l * 1024, modl + 4 * 1024};
            pg8::gemm_phase(C.lds, C.tid, g, S, e); } }
        GSYNC();
        { const Ctx C = make_ctx(lds, wave_s); unsigned char* ws = fresh_ws(P); unsigned char* wl = ws + OFF_W + (size_t)l * SZ_WLAYER; pg8::StaticOrder S;
          pg8::Gemm g{(const bf16_t*)(ws + OFF_HBUF2), (const bf16_t*)(wl + WO_M1), Mrows, DFF, 1024, 1024, 1024}; S.init(g.M, g.N, C.G, C.bid);
          EpiNormBf16<1> e{(bf16_t*)(ws + OFF_ACT), DFF, DFF, (const float*)(ws + OFF_SS) + (size_t)(l == 0 ? 1 : 3) * RT, (const float*)(ws + OFF_SHW) + (size_t)(l * 2 + 1) * 17 * 4096};
          pg8::gemm_phase(C.lds, C.tid, g, S, e); }
        GSYNC();
        if (!last) {
          { const Ctx C = make_ctx(lds, wave_s); unsigned char* ws = fresh_ws(P); unsigned char* wl = ws + OFF_W + (size_t)l * SZ_WLAYER; pg8::StaticOrder S;
            const float* modl = (const float*)(ws + OFF_MOD) + (size_t)l * 17 * 6144; const float* modn = modl + (size_t)17 * 6144;
            pg8::Gemm g{(const bf16_t*)(ws + OFF_ACT), (const bf16_t*)(wl + WO_M2), RL, 1024, DFF, DFF, DFF}; S.init(g.M, g.N, C.G, C.bid);
            EpiResid2<false, true> e{nullptr, nullptr, (bf16_t*)(ws + OFF_XR), modl + 5 * 1024,
                             (bf16_t*)P.out, (float*)(ws + OFF_SS) + (size_t)2 * RT, P.g_mix + 1024, modn + 1 * 1024};
            pg8::gemm_phase(C.lds, C.tid, g, S, e); }
          __syncthreads();
          { const Ctx C = make_ctx(lds, wave_s); unsigned char* ws = fresh_ws(P); unsigned char* wl = ws + OFF_W + (size_t)l * SZ_WLAYER; pg8::StaticOrder S;
            pg8::Gemm g{(const bf16_t*)(ws + OFF_ACT) + (size_t)RL * DFF, (const bf16_t*)(wl + WO_M2), 4 * RC, 1024, 1024, DFF, DFF, 16, (size_t)1024 * 2}; S.init(g.M, g.N, C.G, C.bid);
            EpiPartial e{(float*)(ws + OFF_PART)};
            pg8::gemm_phase(C.lds, C.tid, g, S, e); }
          GSYNC();
          { const Ctx C = make_ctx(lds, wave_s); phase_ctxfin(P, C); }
        }
        else { const Ctx C = make_ctx(lds, wave_s); unsigned char* ws = fresh_ws(P); unsigned char* wl = ws + OFF_W + (size_t)l * SZ_WLAYER; pg8::StaticOrder S;
          const float* modl = (const float*)(ws + OFF_MOD) + (size_t)l * 17 * 6144;
          pg8::Gemm g{(const bf16_t*)(ws + OFF_ACT), (const bf16_t*)(wl + WO_M2), Mrows, 1024, DFF, DFF, DFF}; S.init(g.M, g.N, C.G, C.bid);
          EpiResid2<false, false> e{nullptr, nullptr, (bf16_t*)(ws + OFF_XR), modl + 5 * 1024, nullptr, nullptr, nullptr, nullptr};
          pg8::gemm_phase(C.lds, C.tid, g, S, e); }
        GSYNC();
    }
    { const Ctx C = make_ctx(lds, wave_s); phase_final(P, C); }
}

extern "C" void kernel_launch(void* const* d_in, const int* in_sizes, int n_in, void* d_out, int out_size, void* d_ws, size_t ws_size, hipStream_t stream) {
    static int grid = 0;
    if (grid == 0) {
        if (n_in != 30 || ws_size < WS_END) { fprintf(stderr, "kernel_launch: unexpected n_in %d / ws %zu (need %zu)\n", n_in, ws_size, (size_t)WS_END); grid = -1; return; }
        int dev = 0, cus = 0, per_cu = 0;
        (void)hipGetDevice(&dev);
        (void)hipDeviceGetAttribute(&cus, hipDeviceAttributeMultiprocessorCount, dev);
        if (hipFuncSetAttribute((const void*)mega_fwd, hipFuncAttributeMaxDynamicSharedMemorySize, LDS_BYTES) != hipSuccess) fprintf(stderr, "kernel_launch: hipFuncSetAttribute failed\n");
        if (hipOccupancyMaxActiveBlocksPerMultiprocessor(&per_cu, (const void*)mega_fwd, 512, LDS_BYTES) != hipSuccess || per_cu < 1) { fprintf(stderr, "kernel_launch: occupancy query gave %d\n", per_cu); per_cu = 1; }
        (void)hipGetLastError();
        grid = cus * 1;
    }
    if (grid < 0) return;
    Params p{};
    const float** pp = (const float**)&p;
    for (int i = 0; i < 30; ++i) pp[i] = (const float*)d_in[i];
    p.out = (float*)d_out; p.ws = (unsigned char*)d_ws;
    if (hipMemsetAsync((unsigned char*)d_ws + OFF_BAR, 0, XCD_BAR_WORDS * 4, stream) != hipSuccess) { fprintf(stderr, "kernel_launch: hipMemsetAsync of the barrier words failed\n"); return; }
    void* args[] = {&p};
    hipError_t e = hipLaunchCooperativeKernel((const void*)mega_fwd, dim3(grid), dim3(512), args, LDS_BYTES, stream);
    if (e != hipSuccess) fprintf(stderr, "cooperative launch failed: %s (grid %d)\n", hipGetErrorString(e), grid);
}
```
